# Optimizing an MI355X kernel written in HIP

```python
import math
import jax, jax.numpy as jnp
from jax import lax
import numpy as np

D_MODEL = 1024
BATCH = 4
SEQ = 8192
DEPTH = 1

GRID_W = 64
CTX_LEN = 256

D_S5 = D_MODEL // 2
S5_GROUP_CH = 16
S5_GROUPS = D_S5 // S5_GROUP_CH
S5_STATE = 64

D_SGU = D_MODEL // 2
SGU_GROUPS = 8
SGU_GROUP_CH = D_SGU // SGU_GROUPS
CHUNK = 128
CHUNK_ROWS = CHUNK // GRID_W

D_IN_PROJ = D_S5 + 2 * D_SGU + 2 * D_MODEL
IN_SPLITS = [D_S5, D_S5 + D_SGU, D_S5 + 2 * D_SGU, D_S5 + 2 * D_SGU + D_MODEL]

N_EXPERTS = 256
TOP_K = 8
N_EXPERT_GROUPS = 8
TOPK_GROUPS = 4
D_EXPERT = D_MODEL // 4
D_SHARED = D_EXPERT
ROUTE_SCALE = 2.5
MOE_BLOCK = 128

EPS = 1e-6

kernel_name = "hybrid_s5_sgu_moe_dit_block"


def rmsnorm(x, g):
    xf = x.astype(jnp.float32)
    y = xf * lax.rsqrt(jnp.mean(xf * xf, axis=-1, keepdims=True) + EPS) * g.astype(jnp.float32)
    return y.astype(x.dtype)


def modulate(h, shift, scale):
    return h * (1.0 + scale) + shift


def _linear_recurrence(e1, e2):
    a1, b1 = e1
    a2, b2 = e2
    return a1 * a2, a2 * b1 + b2


def s5_discretise(a_re, a_im, log_dt, b_re, b_im, c_re, c_im):
    f32 = jnp.float32
    a = lax.complex(a_re.astype(f32), a_im.astype(f32))
    dt = jnp.exp(log_dt.astype(f32))[..., None]
    a_bar = jnp.exp(dt * a)
    b_bar = ((a_bar - 1.0) / a)[..., None] * lax.complex(b_re.astype(f32), b_im.astype(f32))
    c_mat = lax.complex(c_re.astype(f32), c_im.astype(f32))
    return a_bar, b_bar, c_mat


def s5_scan(u, a_bar, b_bar, c_mat, init, with_readout):
    bsz, t, _ = u.shape
    ug = u.astype(jnp.float32).reshape(bsz, t, S5_GROUPS, S5_GROUP_CH)
    uc = ug.astype(jnp.complex64)
    y = None
    finals = []
    for d in range(2):
        reverse = d == 1
        bu = jnp.einsum('btgj,gpj->btgp', uc, b_bar[d])
        a = jnp.broadcast_to(a_bar[d], (1, t) + a_bar.shape[1:])
        a_cum, s = lax.associative_scan(_linear_recurrence, (a, bu), reverse=reverse, axis=1)
        if init is not None:
            s = s + a_cum * init[d][:, None]
        finals.append(s[:, 0] if reverse else s[:, -1])
        if with_readout:
            y_d = jnp.real(jnp.einsum('btgp,gjp->btgj', s, c_mat[d]))
            y = y_d if y is None else y + y_d
    return ug, y, finals


def spatial_gating(u, v, n_chunks, norm_g, w_s, b_s):
    bsz, t, _ = u.shape
    u = jax.nn.gelu(u)
    v = rmsnorm(jax.nn.gelu(v), norm_g)
    vc = v.reshape(bsz, n_chunks, CHUNK, SGU_GROUPS, SGU_GROUP_CH)
    mixed = jnp.einsum('hts,bnshc->bnthc', w_s, vc) + b_s.T[:, :, None]
    return u * mixed.reshape(bsz, t, D_SGU)


def token_mixer(z, a_bar, b_bar, c_mat, init, n_chunks, s5_d, w_glu, b_glu,
                sgu_norm, sgu_w, sgu_b, w_branch_s5, w_branch_sgu, w_out):
    u_s5, u_sgu, v_sgu, g_s5, g_sgu = jnp.split(z, IN_SPLITS, axis=-1)
    ug, y, finals = s5_scan(u_s5, a_bar, b_bar, c_mat, init, True)
    y = y + s5_d.astype(jnp.float32).reshape(S5_GROUPS, S5_GROUP_CH) * ug
    y = jax.nn.gelu(y.reshape(z.shape[:2] + (D_S5,))).astype(z.dtype)
    y_s5 = y * jax.nn.sigmoid(y @ w_glu + b_glu)
    y_sgu = spatial_gating(u_sgu, v_sgu, n_chunks, sgu_norm, sgu_w, sgu_b)
    merged = (jax.nn.sigmoid(g_s5) * (y_s5 @ w_branch_s5)
              + jax.nn.sigmoid(g_sgu) * (y_sgu @ w_branch_sgu))
    return merged @ w_out, finals


def route(h, w_router, router_bias):
    n = h.shape[0]
    scores = jax.nn.sigmoid((h @ w_router).astype(jnp.float32))
    sel = scores + router_bias.astype(jnp.float32)
    per_group = N_EXPERTS // N_EXPERT_GROUPS
    grp_score = lax.top_k(sel.reshape(n, N_EXPERT_GROUPS, per_group), 2)[0].sum(-1)
    _, top_g = lax.top_k(grp_score, TOPK_GROUPS)
    gmask = jax.nn.one_hot(top_g, N_EXPERT_GROUPS, dtype=jnp.float32).sum(1) > 0
    sel = jnp.where(jnp.repeat(gmask, per_group, axis=1), sel, -jnp.inf)
    _, idx = lax.top_k(sel, TOP_K)
    w = jnp.take_along_axis(scores, idx, axis=1)
    w = w / jnp.sum(w, axis=-1, keepdims=True) * ROUTE_SCALE
    return idx, w


def routed_experts(h, idx, wts, w_gate, w_up, w_down):
    n, d = h.shape
    nk = n * TOP_K
    flat_e = idx.reshape(-1)
    flat_tok = (jnp.arange(nk, dtype=jnp.int32) // TOP_K)
    flat_w = wts.reshape(-1).astype(h.dtype)
    order = jnp.argsort(flat_e)
    e_sorted = flat_e[order]
    counts = jnp.bincount(flat_e, length=N_EXPERTS)
    starts = jnp.cumsum(counts) - counts
    padded = (counts + MOE_BLOCK - 1) // MOE_BLOCK * MOE_BLOCK
    pends = jnp.cumsum(padded)
    pstarts = pends - padded
    dest = pstarts[e_sorted] + (jnp.arange(nk) - starts[e_sorted])
    n_blocks = -(-nk // MOE_BLOCK) + N_EXPERTS
    cap = n_blocks * MOE_BLOCK
    tok_buf = jnp.full((cap,), n, jnp.int32).at[dest].set(flat_tok[order])
    w_buf = jnp.zeros((cap,), h.dtype).at[dest].set(flat_w[order])
    blk_expert = jnp.minimum(
        jnp.searchsorted(pends, jnp.arange(n_blocks) * MOE_BLOCK, side='right'), N_EXPERTS - 1)
    h_pad = jnp.concatenate([h, jnp.zeros((1, d), h.dtype)], axis=0)

    def expert_block(args):
        tok, w, e = args
        xb = h_pad[tok]
        hidden = jax.nn.silu(xb @ w_gate[e]) * (xb @ w_up[e])
        return (hidden @ w_down[e]) * w[:, None]

    out = lax.map(expert_block, (tok_buf.reshape(n_blocks, MOE_BLOCK),
                                 w_buf.reshape(n_blocks, MOE_BLOCK), blk_expert))
    return jax.ops.segment_sum(out.reshape(cap, d), tok_buf, num_segments=n + 1)[:n]


def moe_ffn(h, w_router, router_bias, w_exp_gate, w_exp_up, w_exp_down, w_sh_gate, w_sh_up, w_sh_down):
    idx, wts = route(h, w_router, router_bias)
    routed = routed_experts(h, idx, wts, w_exp_gate, w_exp_up, w_exp_down)
    shared = (jax.nn.silu(h @ w_sh_gate) * (h @ w_sh_up)) @ w_sh_down
    return routed + shared


def setup_inputs(seed: int = 0) -> dict:
    key = jax.random.key(seed)
    kit = iter(jax.random.split(key, 40))
    f32 = jnp.float32
    L = DEPTH

    def nrm(shape, scale):
        return jax.random.normal(next(kit), shape, f32) * scale

    n_idx = jnp.arange(S5_STATE, dtype=f32)
    return {
        "x": nrm((BATCH, SEQ, D_MODEL), 1.0),
        "c": nrm((BATCH, D_MODEL), 1.0),
        "ctx": nrm((BATCH, CTX_LEN, D_MODEL), 1.0),
        "c_ctx": nrm((D_MODEL,), 1.0),
        "w_mod": nrm((L, D_MODEL, 6 * D_MODEL), 0.5 * D_MODEL ** -0.5),
        "b_mod": nrm((L, 6 * D_MODEL), 0.02),
        "norm_pre_mix": 1.0 + nrm((L, D_MODEL), 0.05),
        "norm_post_mix": 1.0 + nrm((L, D_MODEL), 0.05),
        "norm_pre_ffn": 1.0 + nrm((L, D_MODEL), 0.05),
        "norm_post_ffn": 1.0 + nrm((L, D_MODEL), 0.05),
        "w_in": nrm((L, D_MODEL, D_IN_PROJ), D_MODEL ** -0.5),
        "s5_a_re": -0.5 + nrm((L, 2, S5_GROUPS, S5_STATE), 0.01),
        "s5_a_im": math.pi * n_idx + nrm((L, 2, S5_GROUPS, S5_STATE), 0.01),
        "s5_log_dt": jax.random.uniform(next(kit), (L, 2, S5_GROUPS), f32, math.log(1e-3), math.log(1e-1)),
        "s5_b_re": nrm((L, 2, S5_GROUPS, S5_STATE, S5_GROUP_CH), (2.0 * S5_GROUP_CH) ** -0.5),
        "s5_b_im": nrm((L, 2, S5_GROUPS, S5_STATE, S5_GROUP_CH), (2.0 * S5_GROUP_CH) ** -0.5),
        "s5_c_re": nrm((L, 2, S5_GROUPS, S5_GROUP_CH, S5_STATE), 0.5),
        "s5_c_im": nrm((L, 2, S5_GROUPS, S5_GROUP_CH, S5_STATE), 0.5),
        "s5_d": nrm((L, D_S5), 1.0),
        "w_glu": nrm((L, D_S5, D_S5), D_S5 ** -0.5),
        "b_glu": nrm((L, D_S5), 0.02),
        "sgu_norm": 1.0 + nrm((L, D_SGU), 0.05),
        "sgu_w": nrm((L, SGU_GROUPS, CHUNK, CHUNK), CHUNK ** -0.5),
        "sgu_b": 1.0 + nrm((L, SGU_GROUPS, CHUNK), 0.02),
        "w_branch_s5": nrm((L, D_S5, D_MODEL), D_S5 ** -0.5),
        "w_branch_sgu": nrm((L, D_SGU, D_MODEL), D_SGU ** -0.5),
        "w_out": nrm((L, D_MODEL, D_MODEL), D_MODEL ** -0.5),
        "w_router": nrm((L, D_MODEL, N_EXPERTS), D_MODEL ** -0.5),
        "router_bias": nrm((L, N_EXPERTS), 0.01),
        "w_exp_gate": nrm((L, N_EXPERTS, D_MODEL, D_EXPERT), D_MODEL ** -0.5),
        "w_exp_up": nrm((L, N_EXPERTS, D_MODEL, D_EXPERT), D_MODEL ** -0.5),
        "w_exp_down": nrm((L, N_EXPERTS, D_EXPERT, D_MODEL), D_EXPERT ** -0.5),
        "w_sh_gate": nrm((L, D_MODEL, D_SHARED), D_MODEL ** -0.5),
        "w_sh_up": nrm((L, D_MODEL, D_SHARED), D_MODEL ** -0.5),
        "w_sh_down": nrm((L, D_SHARED, D_MODEL), D_SHARED ** -0.5),
    }


def reference(x, c, ctx, c_ctx, w_mod, b_mod, norm_pre_mix, norm_post_mix, norm_pre_ffn, norm_post_ffn,
              w_in, s5_a_re, s5_a_im, s5_log_dt, s5_b_re, s5_b_im, s5_c_re, s5_c_im, s5_d, w_glu, b_glu,
              sgu_norm, sgu_w, sgu_b, w_branch_s5, w_branch_sgu, w_out,
              w_router, router_bias, w_exp_gate, w_exp_up, w_exp_down, w_sh_gate, w_sh_up, w_sh_down):
    rows = x.shape[1] // GRID_W
    lat_chunks = rows // CHUNK_ROWS
    ctx_chunks = ctx.shape[1] // CHUNK
    for l in range(DEPTH):
        last = l == DEPTH - 1
        mod_x = (jax.nn.silu(c) @ w_mod[l] + b_mod[l])[:, None, :]
        mod_c = jax.nn.silu(c_ctx) @ w_mod[l] + b_mod[l]
        sh_m, sc_m, gt_m, sh_f, sc_f, gt_f = jnp.split(mod_x, 6, axis=-1)
        csh_m, csc_m, cgt_m, csh_f, csc_f, cgt_f = jnp.split(mod_c, 6, axis=-1)
        a_bar, b_bar, c_mat = s5_discretise(s5_a_re[l], s5_a_im[l], s5_log_dt[l],
                                            s5_b_re[l], s5_b_im[l], s5_c_re[l], s5_c_im[l])
        mix_w = (s5_d[l], w_glu[l], b_glu[l], sgu_norm[l], sgu_w[l], sgu_b[l],
                 w_branch_s5[l], w_branch_sgu[l], w_out[l])
        moe_w = (w_router[l], router_bias[l], w_exp_gate[l], w_exp_up[l], w_exp_down[l],
                 w_sh_gate[l], w_sh_up[l], w_sh_down[l])

        hc = modulate(rmsnorm(ctx, norm_pre_mix[l]), csh_m, csc_m)
        if last:
            _, _, ctx_final = s5_scan(hc @ w_in[l][:, :D_S5], a_bar, b_bar, c_mat, None, False)
        else:
            mc, ctx_final = token_mixer(hc @ w_in[l], a_bar, b_bar, c_mat, None, ctx_chunks, *mix_w)
            ctx = ctx + cgt_m * rmsnorm(mc, norm_post_mix[l])

        hx = modulate(rmsnorm(x, norm_pre_mix[l]), sh_m, sc_m)
        mx, _ = token_mixer(hx @ w_in[l], a_bar, b_bar, c_mat, ctx_final, lat_chunks, *mix_w)
        x = x + gt_m * rmsnorm(mx, norm_post_mix[l])

        hx = modulate(rmsnorm(x, norm_pre_ffn[l]), sh_f, sc_f)
        if last:
            fx = moe_ffn(hx.reshape(-1, D_MODEL), *moe_w).reshape(x.shape)
        else:
            hc = modulate(rmsnorm(ctx, norm_pre_ffn[l]), csh_f, csc_f)
            n_lat = hx.shape[0] * hx.shape[1]
            f = moe_ffn(jnp.concatenate([hx.reshape(-1, D_MODEL), hc.reshape(-1, D_MODEL)], axis=0), *moe_w)
            fx = f[:n_lat].reshape(x.shape)
            ctx = ctx + cgt_f * rmsnorm(f[n_lat:].reshape(ctx.shape), norm_post_ffn[l])
        x = x + gt_f * rmsnorm(fx, norm_post_ffn[l])
    return x
```

```cpp
#include <hip/hip_runtime.h>
#include <hip/hip_cooperative_groups.h>
#include <cstdio>
namespace cg = cooperative_groups;

#ifndef N_LAUNCH_MODE
#define N_LAUNCH_MODE 1
#endif

#define LAS __attribute__((address_space(3)))
typedef unsigned short bf16_t;
typedef short bf16x8 __attribute__((ext_vector_type(8)));
typedef float f32x4 __attribute__((ext_vector_type(4)));
typedef float f32x2 __attribute__((ext_vector_type(2)));
typedef unsigned u32x4 __attribute__((ext_vector_type(4)));
typedef unsigned u32x2 __attribute__((ext_vector_type(2)));
typedef LAS unsigned char* ldsp_t;

constexpr int NT = 512;
constexpr int DM = 1024;
constexpr int NTOK = 32768;
constexpr int NCTXR = 1024;
constexpr int NROWS = NTOK + NCTXR;
constexpr int DIN = 3584;
constexpr int UC_ROWS = 2304;
constexpr int NEXP = 256;
constexpr int MAXSLOT = 360448;
constexpr float EPS = 1e-6f;

constexpr size_t MiB = 1u << 20;
constexpr size_t WS_MODP = 1 * MiB;
constexpr size_t WS_MOD = 3 * MiB;
constexpr size_t WS_APL = 3 * MiB + 256 * 1024;
constexpr size_t WS_SGUW = 3 * MiB + 512 * 1024;
constexpr size_t WS_WGLU_T = 4 * MiB;
constexpr size_t WS_WR_T = 4 * MiB + 512 * 1024;
constexpr size_t WS_WB5_T = 5 * MiB;
constexpr size_t WS_WBS_T = 6 * MiB;
constexpr size_t WS_WOUT_T = 7 * MiB;
constexpr size_t WS_WIN_T = 9 * MiB;
constexpr size_t WS_BCAT_T = 16 * MiB;
constexpr size_t WS_WEND_T = 24 * MiB;
constexpr size_t WS_SSQV = 28 * MiB;
constexpr size_t WS_SSQM = 29 * MiB;
constexpr size_t WS_IDX = 31 * MiB;
constexpr size_t WS_WT = 32 * MiB;
constexpr size_t WS_SLOT = 33 * MiB;
constexpr size_t WS_BLKCNT = 34 * MiB;
constexpr size_t WS_BLKOFF = 34 * MiB + 256 * 1024;
constexpr size_t WS_TOTAL = 34 * MiB + 512 * 1024;
constexpr size_t WS_TILEEXP = 34 * MiB + 768 * 1024;
constexpr size_t WS_TOKSLOT = 35 * MiB;
constexpr size_t WS_WSLOT = 36 * MiB + 512 * 1024;
constexpr size_t WS_WD_T = 48 * MiB;
constexpr size_t WS_WGU_T = 177 * MiB;
constexpr size_t WS_XN = 434 * MiB;
constexpr size_t WS_UCAT = 500 * MiB;
constexpr size_t WS_E = 572 * MiB;
constexpr size_t WS_GU = 644 * MiB;
constexpr size_t WS_GV = 676 * MiB;
constexpr size_t WS_SG5 = 708 * MiB;
constexpr size_t WS_SGS = 772 * MiB;
constexpr size_t WS_YS = 836 * MiB;
constexpr size_t WS_YS5 = 868 * MiB;
constexpr size_t WS_YSGU = 900 * MiB;
constexpr size_t WS_MX = 932 * MiB;
constexpr size_t WS_MERGED = 500 * MiB;
constexpr size_t WS_LOGITS = 564 * MiB;
constexpr size_t WS_H = 596 * MiB;
constexpr size_t WS_YSLOT = 177 * MiB;
constexpr size_t WS_NEED = 996 * MiB;

constexpr int LDS_BYTES = 147456;

struct Params { const float* in[35]; float* out; unsigned char* ws; int ph_lo, ph_hi; };

__device__ __forceinline__ unsigned f2bf(float f) { unsigned u = __builtin_bit_cast(unsigned, f); return (u + 0x7fffu + ((u >> 16) & 1u)) >> 16; }
__device__ __forceinline__ unsigned pk2(float lo, float hi) { return f2bf(lo) | (f2bf(hi) << 16); }
__device__ __forceinline__ float bflo(unsigned w) { return __builtin_bit_cast(float, w << 16); }
__device__ __forceinline__ float bfhi(unsigned w) { return __builtin_bit_cast(float, w & 0xffff0000u); }
__device__ __forceinline__ float bf2f(bf16_t b) { return __builtin_bit_cast(float, ((unsigned)b) << 16); }
__device__ __forceinline__ float sigmoid_f(float x) { return 1.0f / (1.0f + __expf(-x)); }
__device__ __forceinline__ float silu_f(float x) { return x * sigmoid_f(x); }
__device__ __forceinline__ float gelu_f(float x) { const float z = 1.5957691216057308f * (x + 0.044715f * x * x * x); return x * sigmoid_f(z); }
__device__ __forceinline__ float wave_sum(float v) {
#pragma unroll
    for (int o = 1; o < 64; o <<= 1) v += __shfl_xor(v, o);
    return v;
}
#define LDS_WAIT() asm volatile("s_waitcnt lgkmcnt(0)" ::: "memory")

__device__ __forceinline__ double dexp_(double x) {
    const double r = x * (1.0 / 32.0); double t = 1.0, s = 1.0;
#pragma unroll 1
    for (int i = 1; i <= 14; ++i) { t *= r / (double)i; s += t; }
#pragma unroll 1
    for (int i = 0; i < 5; ++i) s *= s;
    return s;
}
__device__ __forceinline__ void dsincos_(double th, double& sn, double& cs) {
    const double TWO_PI_HI = 6.283185307179586232, TWO_PI_LO = 2.4492935982947064e-16;
    const double k = __builtin_rint(th * 0.15915494309189535);
    double r = (th - k * TWO_PI_HI) - k * TWO_PI_LO;
    r *= 0.125;
    const double r2 = r * r; double ts = r, tc = 1.0, s = r, c = 1.0;
#pragma unroll 1
    for (int i = 1; i <= 9; ++i) { tc *= -r2 / (double)((2 * i - 1) * (2 * i)); c += tc; ts *= -r2 / (double)((2 * i) * (2 * i + 1)); s += ts; }
#pragma unroll 1
    for (int i = 0; i < 3; ++i) { const double s2 = 2.0 * s * c, c2 = c * c - s * s; s = s2; c = c2; }
    sn = s; cs = c;
}

namespace pg8 {
constexpr int BM = 256, BK = 64, HALF = 128, HTB = HALF * BK * 2, STAGE_BYTES = 8 * HTB;
__device__ __forceinline__ int lds_byte(int r, int c) { const int st = (r >> 4) * 2 + (c >> 5), rr = r & 15, cc = c & 31, ob = rr * 64 + cc * 2; return st * 1024 + (ob ^ (((ob >> 9) & 1) << 5)); }
__device__ __forceinline__ void stage_rc(int b, int& R, int& C) { const int st = b / 1024, sb = b % 1024, swz = sb ^ (((sb >> 9) & 1) << 5); R = (st >> 1) * 16 + swz / 64; C = (st & 1) * 32 + (swz % 64) / 2; }
__device__ __forceinline__ int perm32(int rho) { const int n = rho >> 4, i = rho & 15; return 8 * (i >> 2) + 4 * n + (i & 3); }

struct Unit { const char* A; const char* B; const int* arow; int pm, pn, x0, x1; };

template <class Epi, class Sched, bool GATHER>
__device__ __forceinline__ void gemm_phase(ldsp_t lds, const int K, const unsigned lda, const unsigned ldb, const Sched& S, const Epi& E) {
    const int tid = threadIdx.x, wid = __builtin_amdgcn_readfirstlane(tid >> 6), lane = tid & 63, wr = wid >> 2, wc = wid & 3, fr = lane & 15, fq = lane >> 4;
    const int nt = K / BK;
    int RA[2], CA[2]; unsigned voffB[2][2];
#pragma unroll
    for (int i = 0; i < 2; ++i) { int R, C; stage_rc(tid * 16 + i * 8192, R, C); RA[i] = R; CA[i] = C; const int Rb = Epi::PERM ? ((R & ~31) + perm32(R & 31)) : R;
        voffB[0][i] = (unsigned)Rb * ldb + (unsigned)C * 2u; voffB[1][i] = (unsigned)(Rb + HALF) * ldb + (unsigned)C * 2u; }
    unsigned vA[2][2], vN[2][2];
#define PG8_SETA(v, u) do { _Pragma("unroll") for (int _h = 0; _h < 2; ++_h) _Pragma("unroll") for (int _i = 0; _i < 2; ++_i) { \
        const int _row = _h * HALF + RA[_i]; const unsigned _src = GATHER ? (unsigned)(u).arow[_row] : (unsigned)_row; (v)[_h][_i] = _src * lda + (unsigned)CA[_i] * 2u; } } while (0)
    const size_t kstep = (size_t)(BK * 2);
    const unsigned ldsw = (unsigned)wid * 1024u;
    const int aoff = lds_byte(wr * 64 + fr, fq * 8), boff = lds_byte(wc * 32 + fr, fq * 8);
#define PG8_SA(b, h) (((b) * 2 + (h)) * HTB)
#define PG8_SB(b, h) ((4 + (b) * 2 + (h)) * HTB)
#define PG8_STAGE(bufoff, gbase, o0, o1) do { \
        __builtin_amdgcn_global_load_lds((const unsigned*)((const char*)(gbase) + (o0)), (LAS unsigned*)(lds + (bufoff) + ldsw), 16, 0, 0); \
        __builtin_amdgcn_global_load_lds((const unsigned*)((const char*)(gbase) + (o1)), (LAS unsigned*)(lds + (bufoff) + ldsw + 8192), 16, 0, 0); } while (0)
#define PG8_LDA(dst, b, h) do { _Pragma("unroll") for (int m = 0; m < 4; ++m) _Pragma("unroll") for (int k = 0; k < 2; ++k) dst[m][k] = *(const LAS bf16x8*)(lds + PG8_SA(b, h) + aoff + m * 2048 + k * 1024); } while (0)
#define PG8_LDB(dst, b, h) do { _Pragma("unroll") for (int n = 0; n < 2; ++n) _Pragma("unroll") for (int k = 0; k < 2; ++k) dst[n][k] = *(const LAS bf16x8*)(lds + PG8_SB(b, h) + boff + n * 2048 + k * 1024); } while (0)
#define PG8_MMA(ai, bj, At, Bt) do { __builtin_amdgcn_s_setprio(1); _Pragma("unroll") for (int m = 0; m < 4; ++m) _Pragma("unroll") for (int n = 0; n < 2; ++n) _Pragma("unroll") for (int k = 0; k < 2; ++k) \
        acc[ai][bj][m][n] = __builtin_amdgcn_mfma_f32_16x16x32_bf16(Bt[n][k], At[m][k], acc[ai][bj][m][n], 0, 0, 0); __builtin_amdgcn_s_setprio(0); } while (0)
#define PG8_WAIT_V(n) asm volatile("s_waitcnt vmcnt(" #n ")" ::: "memory")
#define PG8_WAIT_L(n) asm volatile("s_waitcnt lgkmcnt(" #n ")" ::: "memory")
#define PG8_BAR __builtin_amdgcn_s_barrier()
#define PG8_SCHED __builtin_amdgcn_sched_barrier(0)
    Unit cur, nxt; int ui = 0;
    if (!S.next(0, cur)) return;
    PG8_SETA(vA, cur);
    f32x4 acc[2][2][4][2];
#pragma unroll
    for (int a = 0; a < 2; ++a)
#pragma unroll
        for (int b = 0; b < 2; ++b)
#pragma unroll
            for (int m = 0; m < 4; ++m)
#pragma unroll
                for (int n = 0; n < 2; ++n) acc[a][b][m][n] = (f32x4){0.f, 0.f, 0.f, 0.f};
    bf16x8 At[4][2], B0[2][2], B1[2][2];
    const char* cA = cur.A; const char* cB = cur.B;
    PG8_STAGE(PG8_SB(0, 0), cB, voffB[0][0], voffB[0][1]); PG8_STAGE(PG8_SA(0, 0), cA, vA[0][0], vA[0][1]);
    PG8_STAGE(PG8_SB(0, 1), cB, voffB[1][0], voffB[1][1]); PG8_STAGE(PG8_SA(0, 1), cA, vA[1][0], vA[1][1]);
    if (wr == 1) PG8_BAR;
    PG8_WAIT_V(4); PG8_BAR;
    PG8_STAGE(PG8_SB(1, 0), cB + kstep, voffB[0][0], voffB[0][1]); PG8_STAGE(PG8_SA(1, 0), cA + kstep, vA[0][0], vA[0][1]);
    PG8_STAGE(PG8_SB(1, 1), cB + kstep, voffB[1][0], voffB[1][1]);
    PG8_WAIT_V(6); PG8_BAR;
    for (;;) {
        const bool has_next = S.next(ui + 1, nxt);
        const char* nA = has_next ? nxt.A : cA; const char* nB = has_next ? nxt.B : cB;
        if (GATHER) { if (has_next) { PG8_SETA(vN, nxt); } else { vN[0][0] = vA[0][0]; vN[0][1] = vA[0][1]; vN[1][0] = vA[1][0]; vN[1][1] = vA[1][1]; } }
#pragma nounroll
        for (int t = 0; t < nt; t += 2) {
            const bool last = (t == nt - 2);
            const char* a1 = cA + (size_t)(t + 1) * kstep;
            const char* a2 = last ? nA : cA + (size_t)(t + 2) * kstep; const char* b2 = last ? nB : cB + (size_t)(t + 2) * kstep;
            const char* a3 = a2 + kstep; const char* b3 = b2 + kstep;
            unsigned o00, o01, o10, o11;
            if (GATHER && last) { o00 = vN[0][0]; o01 = vN[0][1]; o10 = vN[1][0]; o11 = vN[1][1]; } else { o00 = vA[0][0]; o01 = vA[0][1]; o10 = vA[1][0]; o11 = vA[1][1]; }
            PG8_LDB(B0, 0, 0); PG8_SCHED; PG8_LDA(At, 0, 0); PG8_STAGE(PG8_SA(1, 1), a1, vA[1][0], vA[1][1]);
            PG8_WAIT_L(8); PG8_BAR; PG8_WAIT_L(0); PG8_MMA(0, 0, At, B0); PG8_BAR; PG8_SCHED;
            PG8_LDB(B1, 0, 1); PG8_STAGE(PG8_SB(0, 0), b2, voffB[0][0], voffB[0][1]);
            PG8_BAR; PG8_WAIT_L(0); PG8_MMA(0, 1, At, B1); PG8_BAR;
            PG8_LDA(At, 0, 1); PG8_STAGE(PG8_SA(0, 0), a2, o00, o01);
            PG8_BAR; PG8_WAIT_L(0); PG8_MMA(1, 0, At, B0); PG8_BAR; PG8_SCHED;
            PG8_STAGE(PG8_SB(0, 1), b2, voffB[1][0], voffB[1][1]);
            PG8_WAIT_V(6); PG8_BAR; PG8_MMA(1, 1, At, B1); PG8_BAR;
            PG8_LDB(B0, 1, 0); PG8_SCHED; PG8_LDA(At, 1, 0); PG8_STAGE(PG8_SA(0, 1), a2, o10, o11);
            PG8_WAIT_L(8); PG8_BAR; PG8_WAIT_L(0); PG8_MMA(0, 0, At, B0); PG8_BAR; PG8_SCHED;
            PG8_LDB(B1, 1, 1); PG8_STAGE(PG8_SB(1, 0), b3, voffB[0][0], voffB[0][1]);
            PG8_BAR; PG8_WAIT_L(0); PG8_MMA(0, 1, At, B1); PG8_BAR;
            PG8_LDA(At, 1, 1); PG8_STAGE(PG8_SA(1, 0), a3, o00, o01);
            PG8_BAR; PG8_WAIT_L(0); PG8_MMA(1, 0, At, B0); PG8_BAR; PG8_SCHED;
            PG8_STAGE(PG8_SB(1, 1), b3, voffB[1][0], voffB[1][1]);
            PG8_WAIT_V(6); PG8_BAR; PG8_MMA(1, 1, At, B1); PG8_BAR;
        }
        E(acc, cur, wr, wc, fr, fq);
        if (!has_next) break;
#pragma unroll
        for (int a = 0; a < 2; ++a)
#pragma unroll
            for (int b = 0; b < 2; ++b)
#pragma unroll
                for (int m = 0; m < 4; ++m)
#pragma unroll
                    for (int n = 0; n < 2; ++n) acc[a][b][m][n] = (f32x4){0.f, 0.f, 0.f, 0.f};
        cur = nxt; cA = nA; cB = nB; ++ui;
        if (GATHER) { vA[0][0] = vN[0][0]; vA[0][1] = vN[0][1]; vA[1][0] = vN[1][0]; vA[1][1] = vN[1][1]; }
    }
    PG8_WAIT_V(0);
    if (wr == 0) PG8_BAR;
    PG8_BAR;
#undef PG8_SETA
#undef PG8_SA
#undef PG8_SB
#undef PG8_STAGE
#undef PG8_LDA
#undef PG8_LDB
#undef PG8_MMA
#undef PG8_WAIT_V
#undef PG8_WAIT_L
#undef PG8_BAR
#undef PG8_SCHED
}
}
using pg8::Unit;
typedef f32x4 acc_t[2][2][4][2];

#define EPI_ROWS(ai, m, rowl) _Pragma("unroll") for (int ai = 0; ai < 2; ++ai) _Pragma("unroll") for (int m = 0; m < 4; ++m) { const int rowl = ai * 128 + wr * 64 + m * 16 + fr;
#define EPI_END }

__device__ __forceinline__ void transpose_item(const float* W, int ldw, int k0, int n0, bf16_t* WT, size_t drow0, int ldt, LAS float* scr, int lane) {
#pragma unroll 4
    for (int it = 0; it < 16; ++it) {
        const int kk = it * 4 + (lane >> 4), nn = (lane & 15) * 4;
        const f32x4 v = *(const f32x4*)(W + (size_t)(k0 + kk) * ldw + n0 + nn);
        LAS float* s = scr + kk * 65 + nn; s[0] = v.x; s[1] = v.y; s[2] = v.z; s[3] = v.w;
    }
    LDS_WAIT();
#pragma unroll 2
    for (int it = 0; it < 8; ++it) {
        const int n = it * 8 + (lane >> 3), c = lane & 7;
        const LAS float* s = scr + (8 * c) * 65 + n;
        u32x4 o; o.x = pk2(s[0], s[65]); o.y = pk2(s[130], s[195]); o.z = pk2(s[260], s[325]); o.w = pk2(s[390], s[455]);
        *(u32x4*)(WT + (drow0 + n) * (size_t)ldt + k0 + 8 * c) = o;
    }
    LDS_WAIT();
}

__device__ __forceinline__ void s5_tables(const Params& p, int g, ldsp_t lds) {
    LAS f32x2* apow = (LAS f32x2*)lds;
    LAS f32x2* bbar = (LAS f32x2*)(lds + 17408);
    LAS f32x2* cm = (LAS f32x2*)(lds + 17408 + 16384);
    LAS float* Kt = (LAS float*)(lds + 17408 + 32768);
    const int tid = threadIdx.x;
    const float *a_re = p.in[11], *a_im = p.in[12], *log_dt = p.in[13], *b_re = p.in[14], *b_im = p.in[15], *c_re = p.in[16], *c_im = p.in[17], *dsk = p.in[18];
    float* APL = (float*)(p.ws + WS_APL);
    if (tid < 128) {
        const int d = tid >> 6, pp = tid & 63, idx = (d * 32 + g) * 64 + pp;
        const double are = (double)a_re[idx], aim = (double)a_im[idx];
        const double dt = dexp_((double)log_dt[d * 32 + g]);
        const double mag = dexp_(dt * are); double sn, cs; dsincos_(dt * aim, sn, cs);
        const double abr = mag * cs, abi = mag * sn;
        double pr = 1.0, pi = 0.0;
#pragma unroll 1
        for (int m = 0; m <= 16; ++m) { apow[(d * 17 + m) * 64 + pp] = (f32x2){(float)pr, (float)pi}; const double nr = pr * abr - pi * abi, ni = pr * abi + pi * abr; pr = nr; pi = ni; }
        { const f32x2 aL = apow[(d * 17 + 16) * 64 + pp]; APL[idx * 2 + 0] = aL.x; APL[idx * 2 + 1] = aL.y; }
        const double nr = abr - 1.0, ni = abi, den = are * are + aim * aim;
        const double qr = (nr * are + ni * aim) / den, qi = (ni * are - nr * aim) / den;
#pragma unroll 1
        for (int i = 0; i < 16; ++i) { const double br = (double)b_re[idx * 16 + i], bi = (double)b_im[idx * 16 + i];
            bbar[(d * 64 + pp) * 16 + i] = (f32x2){(float)(qr * br - qi * bi), (float)(qr * bi + qi * br)}; }
    }
    for (int e = tid; e < 2048; e += NT) { const int d = e >> 10, j = (e >> 6) & 15, pp = e & 63; const int gi = ((d * 32 + g) * 16 + j) * 64 + pp; cm[e] = (f32x2){c_re[gi], c_im[gi]}; }
    __syncthreads();
    for (int e = tid; e < 8192; e += NT) {
        const int d = e >> 12, m = (e >> 8) & 15, j = (e >> 4) & 15, i = e & 15; float s = 0.f;
#pragma unroll 4
        for (int pp = 0; pp < 64; ++pp) { const f32x2 a = apow[(d * 17 + m) * 64 + pp], b = bbar[(d * 64 + pp) * 16 + i], c = cm[(d * 16 + j) * 64 + pp];
            const float tr = a.x * b.x - a.y * b.y, ti = a.x * b.y + a.y * b.x; s += c.x * tr - c.y * ti; }
        Kt[e] = s;
    }
    __syncthreads();
    unsigned* BC = (unsigned*)(p.ws + WS_BCAT_T) + (size_t)g * 256 * 256;
    for (int e2 = tid; e2 < 65536; e2 += NT) {
        const int n = e2 >> 8, kk0 = (e2 & 255) * 2, tau = n >> 4, j = n & 15; float v[2];
#pragma unroll
        for (int q = 0; q < 2; ++q) { const int kk = kk0 + q; float r;
            if (kk < 256) { const int k = kk >> 4, i = kk & 15; r = 0.f;
                if (tau >= k) r += Kt[((0 * 16 + (tau - k)) * 16 + j) * 16 + i];
                if (k >= tau) r += Kt[((1 * 16 + (k - tau)) * 16 + j) * 16 + i];
                if (k == tau && i == j) r += dsk[16 * g + j];
            } else { const int qq = kk - 256, part = qq >> 6, pp = qq & 63, d = part >> 1, m = (d == 0) ? (tau + 1) : (16 - tau);
                const f32x2 c = cm[(d * 16 + j) * 64 + pp], a = apow[(d * 17 + m) * 64 + pp];
                r = (part & 1) ? -(c.x * a.y + c.y * a.x) : (c.x * a.x - c.y * a.y); }
            v[q] = r; }
        BC[e2] = pk2(v[0], v[1]);
    }
    unsigned* WE = (unsigned*)(p.ws + WS_WEND_T) + (size_t)g * 256 * 128;
    for (int e2 = tid; e2 < 32768; e2 += NT) {
        const int n = e2 >> 7, kk0 = (e2 & 127) * 2, d = n >> 7, ri = (n >> 6) & 1, pp = n & 63; float v[2];
#pragma unroll
        for (int q = 0; q < 2; ++q) { const int kk = kk0 + q, k = kk >> 4, i = kk & 15, m = (d == 0) ? (15 - k) : k;
            const f32x2 a = apow[(d * 17 + m) * 64 + pp], b = bbar[(d * 64 + pp) * 16 + i];
            v[q] = ri ? (a.x * b.y + a.y * b.x) : (a.x * b.x - a.y * b.y); }
        WE[e2] = pk2(v[0], v[1]);
    }
    __syncthreads();
}

__device__ __forceinline__ void phase_prep(const Params& p, ldsp_t lds) {
    const int tid = threadIdx.x, lane = tid & 63, wave = tid >> 6, G = gridDim.x, bx = blockIdx.x;
    for (int g = bx; g < 32; g += G) s5_tables(p, g, lds);
    { const float* sw = p.in[22]; unsigned* dst = (unsigned*)(p.ws + WS_SGUW);
      for (size_t e = (size_t)bx * NT + tid; e < 65536; e += (size_t)G * NT) dst[e] = pk2(sw[2 * e], sw[2 * e + 1]);
      u32x4* uc = (u32x4*)(p.ws + WS_UCAT);
      for (size_t e = (size_t)bx * NT + tid; e < (size_t)32 * 12288; e += (size_t)G * NT) { const size_t g = e / 12288, r = e % 12288; uc[(g * UC_ROWS + 2112) * 64 + r] = (u32x4){0u, 0u, 0u, 0u}; } }
    const int gw = bx * 8 + wave, NGW = G * 8;
    LAS float* scr = (LAS float*)(lds + wave * 16640);
    constexpr int I_MODP = 1536, I_IN = 16 * 56, I_GLU = 64, I_B5 = 128, I_BS = 128, I_OUT = 256, I_R = 64, I_SMALL = I_IN + I_GLU + I_B5 + I_BS + I_OUT + I_R, I_EXP = 257 * 192;
    for (int it = gw; it < I_MODP + I_SMALL + I_EXP; it += NGW) {
        int r = it;
        if (r < I_MODP) {
            const int cb = r % 96, ks = r / 96, n = cb * 64 + lane; const float* wm = p.in[4];
            float a0 = 0.f, a1 = 0.f, a2 = 0.f, a3 = 0.f, a4 = 0.f;
#pragma unroll 8
            for (int kk = 0; kk < 64; ++kk) { const int k = ks * 64 + kk; const float w = wm[(size_t)k * 6144 + n];
                a0 += silu_f(p.in[1][k]) * w; a1 += silu_f(p.in[1][1024 + k]) * w; a2 += silu_f(p.in[1][2048 + k]) * w; a3 += silu_f(p.in[1][3072 + k]) * w; a4 += silu_f(p.in[3][k]) * w; }
            float* mp = (float*)(p.ws + WS_MODP) + (size_t)ks * 5 * 6144 + n;
            mp[0] = a0; mp[6144] = a1; mp[2 * 6144] = a2; mp[3 * 6144] = a3; mp[4 * 6144] = a4;
            continue; }
        r -= I_MODP;
        if (r < I_IN) { transpose_item(p.in[10], DIN, (r / 56) * 64, (r % 56) * 64, (bf16_t*)(p.ws + WS_WIN_T), (size_t)(r % 56) * 64, 1024, scr, lane); continue; } r -= I_IN;
        if (r < I_GLU) { transpose_item(p.in[19], 512, (r / 8) * 64, (r % 8) * 64, (bf16_t*)(p.ws + WS_WGLU_T), (size_t)(r % 8) * 64, 512, scr, lane); continue; } r -= I_GLU;
        if (r < I_B5) { transpose_item(p.in[24], 1024, (r / 16) * 64, (r % 16) * 64, (bf16_t*)(p.ws + WS_WB5_T), (size_t)(r % 16) * 64, 512, scr, lane); continue; } r -= I_B5;
        if (r < I_BS) { transpose_item(p.in[25], 1024, (r / 16) * 64, (r % 16) * 64, (bf16_t*)(p.ws + WS_WBS_T), (size_t)(r % 16) * 64, 512, scr, lane); continue; } r -= I_BS;
        if (r < I_OUT) { transpose_item(p.in[26], 1024, (r / 16) * 64, (r % 16) * 64, (bf16_t*)(p.ws + WS_WOUT_T), (size_t)(r % 16) * 64, 1024, scr, lane); continue; } r -= I_OUT;
        if (r < I_R) { transpose_item(p.in[27], 256, (r / 4) * 64, (r % 4) * 64, (bf16_t*)(p.ws + WS_WR_T), (size_t)(r % 4) * 64, 1024, scr, lane); continue; } r -= I_R;
        { const int e = r / 192, q = r % 192;
          if (q < 128) {
              const int up = q >> 6, qq = q & 63, k0 = (qq / 4) * 64, n0 = (qq % 4) * 64;
              const float* W = (e < 256) ? p.in[up ? 30 : 29] + (size_t)e * 262144 : p.in[up ? 33 : 32];
              transpose_item(W, 256, k0, n0, (bf16_t*)(p.ws + WS_WGU_T), (size_t)e * 512 + (size_t)(n0 >> 7) * 256 + up * 128 + (n0 & 127), 1024, scr, lane);
          } else {
              const int qq = q - 128, k0 = (qq / 16) * 64, n0 = (qq % 16) * 64;
              const float* W = (e < 256) ? p.in[31] + (size_t)e * 262144 : p.in[34];
              transpose_item(W, 1024, k0, n0, (bf16_t*)(p.ws + WS_WD_T), (size_t)e * 1024 + n0, 256, scr, lane);
          } }
    }
}

__device__ __forceinline__ void phase_xn(const Params& p, ldsp_t lds) {
    const int tid = threadIdx.x, lane = tid & 63, wave = tid >> 6, G = gridDim.x, bx = blockIdx.x;
    const float* modp = (const float*)(p.ws + WS_MODP); const float* bmod = p.in[5];
    { float* mod = (float*)(p.ws + WS_MOD);
      for (int e = bx * NT + tid; e < 5 * 6144; e += G * NT) { const int n = e % 6144; float s = bmod[n];
#pragma unroll
          for (int ks = 0; ks < 16; ++ks) s += modp[(size_t)ks * 5 * 6144 + e];
          mod[e] = s; } }
    LAS float* shv = (LAS float*)lds; LAS float* gsc = (LAS float*)(lds + 4096);
    const float* gpre = p.in[6];
    for (int tile = bx; tile < NROWS / 128; tile += G) {
        const int mr = tile < 256 ? (tile >> 6) : 4;
        __syncthreads();
        for (int col = tid; col < 1024; col += NT) { float sh = bmod[col], sc = bmod[1024 + col];
#pragma unroll
            for (int ks = 0; ks < 16; ++ks) { sh += modp[((size_t)ks * 5 + mr) * 6144 + col]; sc += modp[((size_t)ks * 5 + mr) * 6144 + 1024 + col]; }
            shv[col] = sh; gsc[col] = gpre[col] * (1.0f + sc); }
        __syncthreads();
        for (int rr = wave; rr < 128; rr += 8) {
            const int row = tile * 128 + rr;
            const float* src = (row < NTOK) ? p.in[0] + (size_t)row * DM : p.in[2] + (size_t)(row - NTOK) * DM;
            f32x4 v[4]; float s = 0.f;
#pragma unroll
            for (int j = 0; j < 4; ++j) { v[j] = *(const f32x4*)(src + 4 * lane + 256 * j); s += (v[j].x * v[j].x + v[j].y * v[j].y) + (v[j].z * v[j].z + v[j].w * v[j].w); }
            const float rstd = rsqrtf(wave_sum(s) * (1.0f / DM) + EPS);
            bf16_t* dst = (bf16_t*)(p.ws + WS_XN) + (size_t)row * DM;
#pragma unroll
            for (int j = 0; j < 4; ++j) { const int c = 4 * lane + 256 * j; const f32x4 gs = *(const LAS f32x4*)(gsc + c), sh = *(const LAS f32x4*)(shv + c);
                u32x2 o; o.x = pk2(v[j].x * rstd * gs.x + sh.x, v[j].y * rstd * gs.y + sh.y); o.y = pk2(v[j].z * rstd * gs.z + sh.z, v[j].w * rstd * gs.w + sh.w);
                *(u32x2*)(dst + c) = o; }
        }
    }
    __syncthreads();
}

struct SchedG1 { const unsigned char* ws; int G, c;
    __device__ __forceinline__ bool next(int i, Unit& u) const { const int L = i * G + c; if (L >= 1800) return false;
        if (L < 1792) { u.pm = L / 14; u.pn = L % 14; } else { const int q = L - 1792; u.pm = 128 + (q >> 1); u.pn = q & 1; }
        u.A = (const char*)ws + WS_XN + (size_t)u.pm * 256 * 2048; u.B = (const char*)ws + WS_WIN_T + (size_t)u.pn * 256 * 2048; u.arow = nullptr; u.x0 = 0; u.x1 = 0; return true; } };
struct EpiG1 { static constexpr bool PERM = true; unsigned char* ws;
    __device__ __forceinline__ void operator()(const acc_t& acc, const Unit& u, int wr, int wc, int fr, int fq) const {
        const int pn = u.pn;
        EPI_ROWS(ai, m, rowl)
            const int row = u.pm * 256 + rowl; float ssq = 0.f;
#pragma unroll
            for (int bj = 0; bj < 2; ++bj) {
                const int col = pn * 256 + bj * 128 + wc * 32 + 8 * fq; const f32x4 v0 = acc[ai][bj][m][0], v1 = acc[ai][bj][m][1]; u32x4 o;
                if (pn < 2) {
                    const int g = col >> 4, i0 = col & 15; int crow, k;
                    if (row < NTOK) { crow = row >> 4; k = row & 15; } else { const int rc = row - NTOK; crow = 2048 + (rc >> 8) * 16 + ((rc & 255) >> 4); k = rc & 15; }
                    o.x = pk2(v0.x, v0.y); o.y = pk2(v0.z, v0.w); o.z = pk2(v1.x, v1.y); o.w = pk2(v1.z, v1.w);
                    *(u32x4*)((bf16_t*)(ws + WS_UCAT) + ((size_t)(g * UC_ROWS + crow) * 512 + k * 16 + i0)) = o;
                } else if (pn < 6) {
                    const float g0 = gelu_f(v0.x), g1 = gelu_f(v0.y), g2 = gelu_f(v0.z), g3 = gelu_f(v0.w), g4 = gelu_f(v1.x), g5 = gelu_f(v1.y), g6 = gelu_f(v1.z), g7 = gelu_f(v1.w);
                    o.x = pk2(g0, g1); o.y = pk2(g2, g3); o.z = pk2(g4, g5); o.w = pk2(g6, g7);
                    if (pn < 4) *(u32x4*)((bf16_t*)(ws + WS_GU) + (size_t)row * 512 + (col - 512)) = o;
                    else { *(u32x4*)((bf16_t*)(ws + WS_GV) + (size_t)row * 512 + (col - 1024)) = o; ssq += (g0 * g0 + g1 * g1) + (g2 * g2 + g3 * g3) + (g4 * g4 + g5 * g5) + (g6 * g6 + g7 * g7); }
                } else {
                    o.x = pk2(sigmoid_f(v0.x), sigmoid_f(v0.y)); o.y = pk2(sigmoid_f(v0.z), sigmoid_f(v0.w)); o.z = pk2(sigmoid_f(v1.x), sigmoid_f(v1.y)); o.w = pk2(sigmoid_f(v1.z), sigmoid_f(v1.w));
                    if (pn < 10) *(u32x4*)((bf16_t*)(ws + WS_SG5) + (size_t)row * 1024 + (col - 1536)) = o;
                    else *(u32x4*)((bf16_t*)(ws + WS_SGS) + (size_t)row * 1024 + (col - 2560)) = o;
                }
            }
            if (pn == 4 || pn == 5) { ssq += __shfl_xor(ssq, 16); ssq += __shfl_xor(ssq, 32); if (fq == 0) ((float*)(ws + WS_SSQV))[(size_t)row * 8 + (pn - 4) * 4 + wc] = ssq; }
        EPI_END
    } };
struct SchedG2 { const unsigned char* ws; int G, c;
    __device__ __forceinline__ bool next(int i, Unit& u) const { const int L = i * G + c; if (L >= 288) return false; const int g = L / 9; u.pm = L % 9; u.pn = 0; u.x0 = g; u.x1 = 0; u.arow = nullptr;
        u.A = (const char*)ws + WS_UCAT + ((size_t)g * UC_ROWS + (size_t)u.pm * 256) * 1024; u.B = (const char*)ws + WS_WEND_T + (size_t)g * 256 * 512; return true; } };
struct EpiG2 { static constexpr bool PERM = false; unsigned char* ws;
    __device__ __forceinline__ void operator()(const acc_t& acc, const Unit& u, int wr, int wc, int fr, int fq) const {
        float* Eo = (float*)(ws + WS_E) + (size_t)u.x0 * UC_ROWS * 256;
        EPI_ROWS(ai, m, rowl)
            float* rp = Eo + (size_t)(u.pm * 256 + rowl) * 256 + wc * 32 + 4 * fq;
#pragma unroll
            for (int bj = 0; bj < 2; ++bj)
#pragma unroll
                for (int n = 0; n < 2; ++n) *(f32x4*)(rp + bj * 128 + n * 16) = acc[ai][bj][m][n];
        EPI_END
    } };
struct SchedG3 { const unsigned char* ws; int G, c;
    __device__ __forceinline__ bool next(int i, Unit& u) const { const int L = i * G + c; if (L >= 256) return false; const int g = L >> 3; u.pm = L & 7; u.pn = 0; u.x0 = g; u.x1 = 0; u.arow = nullptr;
        u.A = (const char*)ws + WS_UCAT + ((size_t)g * UC_ROWS + (size_t)u.pm * 256) * 1024; u.B = (const char*)ws + WS_BCAT_T + (size_t)g * 256 * 1024; return true; } };
struct EpiG3 { static constexpr bool PERM = true; unsigned char* ws;
    __device__ __forceinline__ void operator()(const acc_t& acc, const Unit& u, int wr, int wc, int fr, int fq) const {
        bf16_t* ys = (bf16_t*)(ws + WS_YS);
        EPI_ROWS(ai, m, rowl)
            const int crow = u.pm * 256 + rowl;
#pragma unroll
            for (int bj = 0; bj < 2; ++bj) { const int col = bj * 128 + wc * 32 + 8 * fq; const f32x4 v0 = acc[ai][bj][m][0], v1 = acc[ai][bj][m][1]; u32x4 o;
                o.x = pk2(gelu_f(v0.x), gelu_f(v0.y)); o.y = pk2(gelu_f(v0.z), gelu_f(v0.w)); o.z = pk2(gelu_f(v1.x), gelu_f(v1.y)); o.w = pk2(gelu_f(v1.z), gelu_f(v1.w));
                *(u32x4*)(ys + ((size_t)crow * 16 + (col >> 4)) * 512 + u.x0 * 16 + (col & 15)) = o; }
        EPI_END
    } };
struct SchedG4 { const unsigned char* ws; int G, c;
    __device__ __forceinline__ bool next(int i, Unit& u) const { const int L = i * G + c; if (L >= 256) return false; u.pm = L >> 1; u.pn = L & 1; u.x0 = 0; u.x1 = 0; u.arow = nullptr;
        u.A = (const char*)ws + WS_YS + (size_t)u.pm * 256 * 1024; u.B = (const char*)ws + WS_WGLU_T + (size_t)u.pn * 256 * 1024; return true; } };
struct EpiG4 { static constexpr bool PERM = true; unsigned char* ws; const float* bglu;
    __device__ __forceinline__ void operator()(const acc_t& acc, const Unit& u, int wr, int wc, int fr, int fq) const {
        EPI_ROWS(ai, m, rowl)
            const size_t row = (size_t)u.pm * 256 + rowl;
#pragma unroll
            for (int bj = 0; bj < 2; ++bj) { const int col = u.pn * 256 + bj * 128 + wc * 32 + 8 * fq; const f32x4 v0 = acc[ai][bj][m][0], v1 = acc[ai][bj][m][1];
                const f32x4 b0 = *(const f32x4*)(bglu + col), b1 = *(const f32x4*)(bglu + col + 4);
                const u32x4 y = *(const u32x4*)((const bf16_t*)(ws + WS_YS) + row * 512 + col); u32x4 o;
                o.x = pk2(bflo(y.x) * sigmoid_f(v0.x + b0.x), bfhi(y.x) * sigmoid_f(v0.y + b0.y)); o.y = pk2(bflo(y.y) * sigmoid_f(v0.z + b0.z), bfhi(y.y) * sigmoid_f(v0.w + b0.w));
                o.z = pk2(bflo(y.z) * sigmoid_f(v1.x + b1.x), bfhi(y.z) * sigmoid_f(v1.y + b1.y)); o.w = pk2(bflo(y.w) * sigmoid_f(v1.z + b1.z), bfhi(y.w) * sigmoid_f(v1.w + b1.w));
                *(u32x4*)((bf16_t*)(ws + WS_YS5) + row * 512 + col) = o; }
        EPI_END
    } };
struct SchedG5 { const unsigned char* ws; int G, c;
    __device__ __forceinline__ bool next(int i, Unit& u) const { const int tile = (i >> 1) * G + c; if (tile >= 512) return false; const int which = i & 1; u.pm = tile >> 2; u.pn = tile & 3; u.x0 = which; u.x1 = 0; u.arow = nullptr;
        u.A = (const char*)ws + (which ? WS_YSGU : WS_YS5) + (size_t)u.pm * 256 * 1024; u.B = (const char*)ws + (which ? WS_WBS_T : WS_WB5_T) + (size_t)u.pn * 256 * 1024; return true; } };
struct EpiG5 { static constexpr bool PERM = true; unsigned char* ws;
    __device__ __forceinline__ void operator()(const acc_t& acc, const Unit& u, int wr, int wc, int fr, int fq) const {
        const bf16_t* gate = (const bf16_t*)(ws + (u.x0 ? WS_SGS : WS_SG5)); bf16_t* mg = (bf16_t*)(ws + WS_MERGED);
        EPI_ROWS(ai, m, rowl)
            const size_t row = (size_t)u.pm * 256 + rowl;
#pragma unroll
            for (int bj = 0; bj < 2; ++bj) { const int col = u.pn * 256 + bj * 128 + wc * 32 + 8 * fq; const f32x4 v0 = acc[ai][bj][m][0], v1 = acc[ai][bj][m][1];
                const u32x4 s = *(const u32x4*)(gate + row * 1024 + col);
                float r0 = v0.x * bflo(s.x), r1 = v0.y * bfhi(s.x), r2 = v0.z * bflo(s.y), r3 = v0.w * bfhi(s.y), r4 = v1.x * bflo(s.z), r5 = v1.y * bfhi(s.z), r6 = v1.z * bflo(s.w), r7 = v1.w * bfhi(s.w);
                if (u.x0) { const u32x4 q = *(const u32x4*)(mg + row * 1024 + col);
                    r0 += bflo(q.x); r1 += bfhi(q.x); r2 += bflo(q.y); r3 += bfhi(q.y); r4 += bflo(q.z); r5 += bfhi(q.z); r6 += bflo(q.w); r7 += bfhi(q.w); }
                u32x4 o; o.x = pk2(r0, r1); o.y = pk2(r2, r3); o.z = pk2(r4, r5); o.w = pk2(r6, r7);
                *(u32x4*)(mg + row * 1024 + col) = o; }
        EPI_END
    } };
struct SchedG6 { const unsigned char* ws; int G, c;
    __device__ __forceinline__ bool next(int i, Unit& u) const { const int L = i * G + c; if (L >= 512) return false; u.pm = L >> 2; u.pn = L & 3; u.x0 = 0; u.x1 = 0; u.arow = nullptr;
        u.A = (const char*)ws + WS_MERGED + (size_t)u.pm * 256 * 2048; u.B = (const char*)ws + WS_WOUT_T + (size_t)u.pn * 256 * 2048; return true; } };
struct EpiG6 { static constexpr bool PERM = true; unsigned char* ws;
    __device__ __forceinline__ void operator()(const acc_t& acc, const Unit& u, int wr, int wc, int fr, int fq) const {
        EPI_ROWS(ai, m, rowl)
            const size_t row = (size_t)u.pm * 256 + rowl; float ssq = 0.f;
#pragma unroll
            for (int bj = 0; bj < 2; ++bj) { const int col = u.pn * 256 + bj * 128 + wc * 32 + 8 * fq; const f32x4 v0 = acc[ai][bj][m][0], v1 = acc[ai][bj][m][1]; u32x4 o;
                o.x = pk2(v0.x, v0.y); o.y = pk2(v0.z, v0.w); o.z = pk2(v1.x, v1.y); o.w = pk2(v1.z, v1.w);
                ssq += (v0.x * v0.x + v0.y * v0.y) + (v0.z * v0.z + v0.w * v0.w) + (v1.x * v1.x + v1.y * v1.y) + (v1.z * v1.z + v1.w * v1.w);
                *(u32x4*)((bf16_t*)(ws + WS_MX) + row * 1024 + col) = o; }
            ssq += __shfl_xor(ssq, 16); ssq += __shfl_xor(ssq, 32); if (fq == 0) ((float*)(ws + WS_SSQM))[row * 16 + u.pn * 4 + wc] = ssq;
        EPI_END
    } };
struct SchedG7 { const unsigned char* ws; int G, c;
    __device__ __forceinline__ bool next(int i, Unit& u) const { const int L = i * G + c; if (L >= 128) return false; u.pm = L; u.pn = 0; u.x0 = 0; u.x1 = 0; u.arow = nullptr;
        u.A = (const char*)ws + WS_XN + (size_t)u.pm * 256 * 2048; u.B = (const char*)ws + WS_WR_T; return true; } };
struct EpiG7 { static constexpr bool PERM = false; unsigned char* ws;
    __device__ __forceinline__ void operator()(const acc_t& acc, const Unit& u, int wr, int wc, int fr, int fq) const {
        EPI_ROWS(ai, m, rowl)
            float* rp = (float*)(ws + WS_LOGITS) + ((size_t)u.pm * 256 + rowl) * 256 + wc * 32 + 4 * fq;
#pragma unroll
            for (int bj = 0; bj < 2; ++bj)
#pragma unroll
                for (int n = 0; n < 2; ++n) *(f32x4*)(rp + bj * 128 + n * 16) = acc[ai][bj][m][n];
        EPI_END
    } };
struct SchedG8 { const unsigned char* ws; int G, c;
    __device__ __forceinline__ bool next(int i, Unit& u) const { const int* te = (const int*)(ws + WS_TILEEXP); const int ntile = te[1500]; const int L = i * G + c; if (L >= ntile * 2) return false;
        const int t = L >> 1; u.pm = t; u.pn = L & 1; const int e = te[t]; u.x0 = e; u.x1 = 0; u.arow = (const int*)(ws + WS_TOKSLOT) + (size_t)t * 256;
        u.A = (const char*)ws + WS_XN; u.B = (const char*)ws + WS_WGU_T + ((size_t)e * 512 + (size_t)u.pn * 256) * 2048; return true; } };
struct EpiG8 { static constexpr bool PERM = true; unsigned char* ws;
    __device__ __forceinline__ void operator()(const acc_t& acc, const Unit& u, int wr, int wc, int fr, int fq) const {
        EPI_ROWS(ai, m, rowl)
            const size_t slot = (size_t)u.pm * 256 + rowl; const int col = u.pn * 128 + wc * 32 + 8 * fq;
            const f32x4 g0 = acc[ai][0][m][0], g1 = acc[ai][0][m][1], u0 = acc[ai][1][m][0], u1 = acc[ai][1][m][1]; u32x4 o;
            o.x = pk2(silu_f(g0.x) * u0.x, silu_f(g0.y) * u0.y); o.y = pk2(silu_f(g0.z) * u0.z, silu_f(g0.w) * u0.w);
            o.z = pk2(silu_f(g1.x) * u1.x, silu_f(g1.y) * u1.y); o.w = pk2(silu_f(g1.z) * u1.z, silu_f(g1.w) * u1.w);
            *(u32x4*)((bf16_t*)(ws + WS_H) + slot * 256 + col) = o;
        EPI_END
    } };
struct SchedG9 { const unsigned char* ws; int G, c, hf;
    __device__ __forceinline__ bool next(int i, Unit& u) const { const int* te = (const int*)(ws + WS_TILEEXP); const int ntr = te[1500] - 128; const int L = i * G + c; if (L >= ntr * 2) return false;
        const int t = L >> 1; u.pm = t; u.pn = L & 1; const int e = te[t]; u.x0 = e; u.x1 = 0; u.arow = nullptr;
        u.A = (const char*)ws + WS_H + (size_t)t * 256 * 512; u.B = (const char*)ws + WS_WD_T + ((size_t)e * 1024 + (size_t)(hf * 2 + u.pn) * 256) * 512; return true; } };
struct EpiG9 { static constexpr bool PERM = true; unsigned char* ws;
    __device__ __forceinline__ void operator()(const acc_t& acc, const Unit& u, int wr, int wc, int fr, int fq) const {
        const float* wslot = (const float*)(ws + WS_WSLOT);
        EPI_ROWS(ai, m, rowl)
            const size_t slot = (size_t)u.pm * 256 + rowl; const float w = wslot[slot];
            bf16_t* yp = (bf16_t*)(ws + WS_YSLOT) + slot * 512 + u.pn * 256 + wc * 32 + 8 * fq;
#pragma unroll
            for (int bj = 0; bj < 2; ++bj) { const f32x4 v0 = acc[ai][bj][m][0], v1 = acc[ai][bj][m][1]; u32x4 o;
                o.x = pk2(v0.x * w, v0.y * w); o.y = pk2(v0.z * w, v0.w * w); o.z = pk2(v1.x * w, v1.y * w); o.w = pk2(v1.z * w, v1.w * w);
                *(u32x4*)(yp + bj * 128) = o; }
        EPI_END
    } };
struct SchedG10 { const unsigned char* ws; int G, c;
    __device__ __forceinline__ bool next(int i, Unit& u) const { const int* te = (const int*)(ws + WS_TILEEXP); const int ntr = te[1500] - 128; const int L = i * G + c; if (L >= 512) return false;
        const int t = L >> 2; u.pm = t; u.pn = L & 3; u.x0 = ntr; u.x1 = 0; u.arow = nullptr;
        u.A = (const char*)ws + WS_H + (size_t)(ntr + t) * 256 * 512; u.B = (const char*)ws + WS_WD_T + ((size_t)NEXP * 1024 + (size_t)u.pn * 256) * 512; return true; } };
struct EpiG10 { static constexpr bool PERM = true; float* out;
    __device__ __forceinline__ void operator()(const acc_t& acc, const Unit& u, int wr, int wc, int fr, int fq) const {
        EPI_ROWS(ai, m, rowl)
            float* dp = out + ((size_t)u.pm * 256 + rowl) * 1024 + u.pn * 256 + wc * 32 + 8 * fq;
            *(f32x4*)dp = acc[ai][0][m][0]; *(f32x4*)(dp + 4) = acc[ai][0][m][1]; *(f32x4*)(dp + 128) = acc[ai][1][m][0]; *(f32x4*)(dp + 132) = acc[ai][1][m][1];
        EPI_END
    } };

__device__ __forceinline__ void phase_sgu(const Params& p, ldsp_t lds) {
    const int tid = threadIdx.x, lane = tid & 63, wave = tid >> 6, fr = lane & 15, fq = lane >> 4, G = gridDim.x;
    constexpr int PITCH = 272;
    ldsp_t Wl = lds; ldsp_t VT = lds + 128 * PITCH; LAS float* rs = (LAS float*)(lds + 128 * PITCH + 64 * PITCH);
    const bf16_t* sguw = (const bf16_t*)(p.ws + WS_SGUW); const bf16_t* gv = (const bf16_t*)(p.ws + WS_GV); const bf16_t* gu = (const bf16_t*)(p.ws + WS_GU);
    const float* ssq = (const float*)(p.ws + WS_SSQV); const float* gn = p.in[21]; const float* bs = p.in[23];
    bf16_t* yo = (bf16_t*)(p.ws + WS_YSGU);
    for (int it = blockIdx.x; it < 2048; it += G) {
        const int chunk = it & 255, h = it >> 8; const size_t tok0 = (size_t)chunk * 128;
        __syncthreads();
        if (tid < 128) { const float* q = ssq + (tok0 + tid) * 8; const f32x4 a = *(const f32x4*)q, b = *(const f32x4*)(q + 4);
            rs[tid] = rsqrtf(((a.x + a.y) + (a.z + a.w) + (b.x + b.y) + (b.z + b.w)) * (1.0f / 512.0f) + EPS); }
#pragma unroll
        for (int i = 0; i < 4; ++i) { const int pc = tid + i * NT, row = pc >> 4, cp = pc & 15;
            *(LAS u32x4*)(Wl + row * PITCH + cp * 16) = *(const u32x4*)(sguw + ((size_t)h * 128 + row) * 128 + cp * 8); }
        __syncthreads();
#pragma unroll
        for (int i = 0; i < 2; ++i) { const int pc = tid + i * NT, s = pc >> 3, c8 = (pc & 7) * 8; const float r = rs[s];
            const u32x4 v = *(const u32x4*)(gv + (tok0 + s) * 512 + h * 64 + c8);
            LAS bf16_t* d = (LAS bf16_t*)(VT + c8 * PITCH + s * 2);
            d[0 * (PITCH / 2)] = (bf16_t)f2bf(bflo(v.x) * r); d[1 * (PITCH / 2)] = (bf16_t)f2bf(bfhi(v.x) * r); d[2 * (PITCH / 2)] = (bf16_t)f2bf(bflo(v.y) * r); d[3 * (PITCH / 2)] = (bf16_t)f2bf(bfhi(v.y) * r);
            d[4 * (PITCH / 2)] = (bf16_t)f2bf(bflo(v.z) * r); d[5 * (PITCH / 2)] = (bf16_t)f2bf(bfhi(v.z) * r); d[6 * (PITCH / 2)] = (bf16_t)f2bf(bflo(v.w) * r); d[7 * (PITCH / 2)] = (bf16_t)f2bf(bfhi(v.w) * r); }
        __syncthreads();
        f32x4 acc[4] = {(f32x4){0.f, 0.f, 0.f, 0.f}, (f32x4){0.f, 0.f, 0.f, 0.f}, (f32x4){0.f, 0.f, 0.f, 0.f}, (f32x4){0.f, 0.f, 0.f, 0.f}};
        const int t0 = wave * 16;
#pragma unroll
        for (int ks = 0; ks < 4; ++ks) {
            const bf16x8 bfr = *(const LAS bf16x8*)(Wl + (t0 + fr) * PITCH + (ks * 32 + 8 * fq) * 2);
#pragma unroll
            for (int mb = 0; mb < 4; ++mb) { const bf16x8 afr = *(const LAS bf16x8*)(VT + (mb * 16 + fr) * PITCH + (ks * 32 + 8 * fq) * 2);
                acc[mb] = __builtin_amdgcn_mfma_f32_16x16x32_bf16(afr, bfr, acc[mb], 0, 0, 0); }
        }
        const int t = t0 + fr; const float bt = bs[h * 128 + t];
#pragma unroll
        for (int mb = 0; mb < 4; ++mb) { const int c = h * 64 + mb * 16 + 4 * fq; const f32x4 gg = *(const f32x4*)(gn + c);
            const u32x2 uu = *(const u32x2*)(gu + (tok0 + t) * 512 + c); u32x2 o;
            o.x = pk2(bflo(uu.x) * (acc[mb].x * gg.x + bt), bfhi(uu.x) * (acc[mb].y * gg.y + bt)); o.y = pk2(bflo(uu.y) * (acc[mb].z * gg.z + bt), bfhi(uu.y) * (acc[mb].w * gg.w + bt));
            *(u32x2*)(yo + (tok0 + t) * 512 + c) = o; }
    }
    __syncthreads();
}

__device__ __forceinline__ void phase_carry(const Params& p) {
    const int tid = threadIdx.x, lane = tid & 63, wave = tid >> 6, G = gridDim.x;
    const float* APL = (const float*)(p.ws + WS_APL);
    for (int s = blockIdx.x + G * wave; s < 256; s += G * 8) {
        const int d = s & 1, g = (s >> 1) & 31, b = s >> 6;
        const float ar = APL[((d * 32 + g) * 64 + lane) * 2], ai = APL[((d * 32 + g) * 64 + lane) * 2 + 1];
        const float* Eg = (const float*)(p.ws + WS_E) + (size_t)g * UC_ROWS * 256 + d * 128 + lane;
        bf16_t* Ug = (bf16_t*)(p.ws + WS_UCAT) + (size_t)g * UC_ROWS * 512 + 256 + d * 128 + lane;
        float cr = 0.f, ci = 0.f;
#pragma unroll 16
        for (int q = 0; q < 16; ++q) { const int cc = d ? (15 - q) : q; const size_t row = 2048 + b * 16 + cc; const float er = Eg[row * 256], ei = Eg[row * 256 + 64];
            const float nr = ar * cr - ai * ci + er, ni = ar * ci + ai * cr + ei; cr = nr; ci = ni; }
#pragma unroll 16
        for (int q = 0; q < 512; ++q) { const int c = d ? (511 - q) : q; const size_t row = (size_t)b * 512 + c; const float er = Eg[row * 256], ei = Eg[row * 256 + 64];
            Ug[row * 512] = (bf16_t)f2bf(cr); Ug[row * 512 + 64] = (bf16_t)f2bf(ci);
            const float nr = ar * cr - ai * ci + er, ni = ar * ci + ai * cr + ei; cr = nr; ci = ni; }
    }
}

__device__ __forceinline__ void phase_r1(const Params& p) {
    const int tid = threadIdx.x, lane = tid & 63, wave = tid >> 6, G = gridDim.x;
    const float* mod = (const float*)(p.ws + WS_MOD); const float* gpm = p.in[7]; const float* gpf = p.in[8];
    for (int row = blockIdx.x * 8 + wave; row < NTOK; row += G * 8) {
        const int b = row >> 13; const float* mb = mod + (size_t)b * 6144;
        const float* sq = (const float*)(p.ws + WS_SSQM) + (size_t)row * 16; float s0 = 0.f;
#pragma unroll
        for (int j = 0; j < 4; ++j) { const f32x4 q = *(const f32x4*)(sq + 4 * j); s0 += (q.x + q.y) + (q.z + q.w); }
        const float rm = rsqrtf(s0 * (1.0f / DM) + EPS);
        f32x4 x1[4]; float s = 0.f;
#pragma unroll
        for (int j = 0; j < 4; ++j) { const int c = 4 * lane + 256 * j; const f32x4 xv = *(const f32x4*)(p.in[0] + (size_t)row * DM + c);
            const u32x2 mv = *(const u32x2*)((const bf16_t*)(p.ws + WS_MX) + (size_t)row * DM + c); const f32x4 gt = *(const f32x4*)(mb + 2048 + c), gg = *(const f32x4*)(gpm + c);
            x1[j].x = xv.x + gt.x * (bflo(mv.x) * rm * gg.x); x1[j].y = xv.y + gt.y * (bfhi(mv.x) * rm * gg.y); x1[j].z = xv.z + gt.z * (bflo(mv.y) * rm * gg.z); x1[j].w = xv.w + gt.w * (bfhi(mv.y) * rm * gg.w);
            s += (x1[j].x * x1[j].x + x1[j].y * x1[j].y) + (x1[j].z * x1[j].z + x1[j].w * x1[j].w); }
        const float r1 = rsqrtf(wave_sum(s) * (1.0f / DM) + EPS);
        bf16_t* dst = (bf16_t*)(p.ws + WS_XN) + (size_t)row * DM;
#pragma unroll
        for (int j = 0; j < 4; ++j) { const int c = 4 * lane + 256 * j; const f32x4 gg = *(const f32x4*)(gpf + c), sh = *(const f32x4*)(mb + 3072 + c), sc = *(const f32x4*)(mb + 4096 + c); u32x2 o;
            o.x = pk2(x1[j].x * r1 * gg.x * (1.f + sc.x) + sh.x, x1[j].y * r1 * gg.y * (1.f + sc.y) + sh.y); o.y = pk2(x1[j].z * r1 * gg.z * (1.f + sc.z) + sh.z, x1[j].w * r1 * gg.w * (1.f + sc.w) + sh.w);
            *(u32x2*)(dst + c) = o; }
    }
}

__device__ __forceinline__ void phase_route(const Params& p, ldsp_t lds) {
    const int tid = threadIdx.x, lane = tid & 63, wave = tid >> 6, G = gridDim.x;
    LAS int* hist = (LAS int*)lds;
    const float* rb = p.in[28]; const f32x4 bias = *(const f32x4*)(rb + 4 * lane);
    for (int tile = blockIdx.x; tile < 256; tile += G) {
        __syncthreads();
        if (tid < 256) hist[tid] = 0;
        __syncthreads();
        for (int rr = wave; rr < 128; rr += 8) {
            const int row = tile * 128 + rr;
            const f32x4 lg = *(const f32x4*)((const float*)(p.ws + WS_LOGITS) + (size_t)row * 256 + 4 * lane);
            float sc[4] = {sigmoid_f(lg.x), sigmoid_f(lg.y), sigmoid_f(lg.z), sigmoid_f(lg.w)};
            float sel[4] = {sc[0] + bias.x, sc[1] + bias.y, sc[2] + bias.z, sc[3] + bias.w};
            float m1 = fmaxf(sel[0], sel[1]), m2 = fminf(sel[0], sel[1]);
            { const float a = fmaxf(sel[2], sel[3]), b = fminf(sel[2], sel[3]); const float n1 = fmaxf(m1, a); const float n2 = fmaxf(fminf(m1, a), fmaxf(m2, b)); m1 = n1; m2 = n2; }
#pragma unroll
            for (int o = 1; o < 8; o <<= 1) { const float a = __shfl_xor(m1, o), b = __shfl_xor(m2, o); const float n1 = fmaxf(m1, a); const float n2 = fmaxf(fminf(m1, a), fmaxf(m2, b)); m1 = n1; m2 = n2; }
            const float gs = m1 + m2; const int mygrp = lane >> 3; int rank = 0;
#pragma unroll
            for (int g2 = 0; g2 < 8; ++g2) { const float o = __shfl(gs, g2 * 8); rank += (o > gs || (o == gs && g2 < mygrp)) ? 1 : 0; }
            const bool gsel = rank < 4;
#pragma unroll
            for (int j = 0; j < 4; ++j) if (!gsel) sel[j] = -__builtin_inff();
            float wk = 0.f; int ek = 0; float wsum = 0.f;
#pragma unroll 1
            for (int k = 0; k < 8; ++k) {
                float bv = sel[0]; int bi = 0;
#pragma unroll
                for (int j = 1; j < 4; ++j) if (sel[j] > bv) { bv = sel[j]; bi = j; }
                int be = 4 * lane + bi; float v = bv; int e = be;
#pragma unroll
                for (int o = 1; o < 64; o <<= 1) { const float ov = __shfl_xor(v, o); const int oe = __shfl_xor(e, o); if (ov > v || (ov == v && oe < e)) { v = ov; e = oe; } }
                float s_w = 0.f;
                if ((e >> 2) == lane) { const int j = e & 3; s_w = sc[j];
#pragma unroll
                    for (int jj = 0; jj < 4; ++jj) if (jj == j) sel[jj] = -__builtin_inff(); }
                s_w = __shfl(s_w, e >> 2);
                wsum += s_w; if (lane == k) { wk = s_w; ek = e; }
            }
            if (lane < 8) { const float w = wk / wsum * 2.5f; ((int*)(p.ws + WS_IDX))[(size_t)row * 8 + lane] = ek; ((float*)(p.ws + WS_WT))[(size_t)row * 8 + lane] = w; __hip_atomic_fetch_add(&hist[ek], 1, __ATOMIC_RELAXED, __HIP_MEMORY_SCOPE_WORKGROUP); }
        }
        __syncthreads();
        if (tid < 256) ((int*)(p.ws + WS_BLKCNT))[tile * 256 + tid] = hist[tid];
    }
    __syncthreads();
}
__device__ __forceinline__ void phase_scan(const Params& p, ldsp_t lds) {
    const int tid = threadIdx.x, G = gridDim.x; LAS int* sm = (LAS int*)lds;
    for (int e = blockIdx.x; e < 256; e += G) {
        __syncthreads();
        int v = 0; if (tid < 256) { v = ((const int*)(p.ws + WS_BLKCNT))[tid * 256 + e]; sm[tid] = v; }
        __syncthreads();
        for (int o = 1; o < 256; o <<= 1) { int t = 0; if (tid < 256 && tid >= o) t = sm[tid - o]; __syncthreads(); if (tid < 256) sm[tid] += t; __syncthreads(); }
        if (tid < 256) { ((int*)(p.ws + WS_BLKOFF))[tid * 256 + e] = sm[tid] - v; if (tid == 255) ((int*)(p.ws + WS_TOTAL))[e] = sm[255]; }
    }
    __syncthreads();
}
__device__ __forceinline__ void phase_scatter(const Params& p, ldsp_t lds) {
    const int tid = threadIdx.x, G = gridDim.x; LAS int* pst = (LAS int*)lds; LAS int* cnt = (LAS int*)(lds + 2048); LAS int* tot = (LAS int*)(lds + 4096);
    int* tokslot = (int*)(p.ws + WS_TOKSLOT); float* wslot = (float*)(p.ws + WS_WSLOT); int* te = (int*)(p.ws + WS_TILEEXP);
    int mytot = 0, mypad = 0;
    if (tid < 256) { mytot = ((const int*)(p.ws + WS_TOTAL))[tid]; mypad = (mytot + 255) & ~255; pst[tid] = mypad; tot[tid] = mytot; }
    __syncthreads();
    for (int o = 1; o < 256; o <<= 1) { int t = 0; if (tid < 256 && tid >= o) t = pst[tid - o]; __syncthreads(); if (tid < 256) pst[tid] += t; __syncthreads(); }
    const int pend_all = pst[255];
    __syncthreads();
    if (tid < 256) pst[tid] -= mypad;
    __syncthreads();
    const int ntr = pend_all >> 8;
    if (blockIdx.x == 0 && tid == 0) te[1500] = ntr + 128;
    for (int e = blockIdx.x; e < 256; e += G) { const int s0 = pst[e], n = tot[e], pe = s0 + ((n + 255) & ~255);
        for (int t = (s0 >> 8) + tid; t < (pe >> 8); t += NT) te[t] = e;
        for (int s = s0 + n + tid; s < pe; s += NT) { tokslot[s] = 0; wslot[s] = 0.f; } }
    for (int t = blockIdx.x * NT + tid; t < NTOK; t += G * NT) { tokslot[pend_all + t] = t; wslot[pend_all + t] = 1.0f; if (t < 128) te[ntr + t] = NEXP; }
    for (int tile = blockIdx.x; tile < 256; tile += G) {
        __syncthreads();
        if (tid < 256) cnt[tid] = 0;
        __syncthreads();
        for (int q = tid; q < 1024; q += NT) { const int row = tile * 128 + (q >> 3), k = q & 7; const int e = ((const int*)(p.ws + WS_IDX))[(size_t)row * 8 + k];
            const int r = __hip_atomic_fetch_add(&cnt[e], 1, __ATOMIC_RELAXED, __HIP_MEMORY_SCOPE_WORKGROUP); const int slot = pst[e] + ((const int*)(p.ws + WS_BLKOFF))[tile * 256 + e] + r;
            tokslot[slot] = row; wslot[slot] = ((const float*)(p.ws + WS_WT))[(size_t)row * 8 + k]; ((int*)(p.ws + WS_SLOT))[(size_t)row * 8 + k] = slot; }
    }
    __syncthreads();
}

__device__ __forceinline__ void phase_r3a(const Params& p) {
    const int tid = threadIdx.x, lane = tid & 63, wave = tid >> 6, G = gridDim.x;
    const bf16_t* ys = (const bf16_t*)(p.ws + WS_YSLOT);
    for (int row = blockIdx.x * 8 + wave; row < NTOK; row += G * 8) {
        const int* sl = (const int*)(p.ws + WS_SLOT) + (size_t)row * 8; float* dp = p.out + (size_t)row * DM + 8 * lane;
        f32x4 a0 = *(const f32x4*)dp, a1 = *(const f32x4*)(dp + 4);
#pragma unroll
        for (int k = 0; k < 8; ++k) { const u32x4 v = *(const u32x4*)(ys + (size_t)sl[k] * 512 + 8 * lane);
            a0.x += bflo(v.x); a0.y += bfhi(v.x); a0.z += bflo(v.y); a0.w += bfhi(v.y); a1.x += bflo(v.z); a1.y += bfhi(v.z); a1.z += bflo(v.w); a1.w += bfhi(v.w); }
        *(f32x4*)dp = a0; *(f32x4*)(dp + 4) = a1;
    }
}
__device__ __forceinline__ void phase_r3b(const Params& p) {
    const int tid = threadIdx.x, lane = tid & 63, wave = tid >> 6, G = gridDim.x;
    const bf16_t* ys = (const bf16_t*)(p.ws + WS_YSLOT); const float* mod = (const float*)(p.ws + WS_MOD); const float* gpm = p.in[7]; const float* gpo = p.in[9];
    for (int row = blockIdx.x * 8 + wave; row < NTOK; row += G * 8) {
        const int b = row >> 13; const float* mb = mod + (size_t)b * 6144;
        const int* sl = (const int*)(p.ws + WS_SLOT) + (size_t)row * 8; float* orow = p.out + (size_t)row * DM;
        f32x4 f0 = *(const f32x4*)(orow + 8 * lane), f1 = *(const f32x4*)(orow + 8 * lane + 4), f2 = *(const f32x4*)(orow + 512 + 8 * lane), f3 = *(const f32x4*)(orow + 512 + 8 * lane + 4);
#pragma unroll
        for (int k = 0; k < 8; ++k) { const u32x4 v = *(const u32x4*)(ys + (size_t)sl[k] * 512 + 8 * lane);
            f2.x += bflo(v.x); f2.y += bfhi(v.x); f2.z += bflo(v.y); f2.w += bfhi(v.y); f3.x += bflo(v.z); f3.y += bfhi(v.z); f3.z += bflo(v.w); f3.w += bfhi(v.w); }
        float s = (f0.x * f0.x + f0.y * f0.y) + (f0.z * f0.z + f0.w * f0.w) + (f1.x * f1.x + f1.y * f1.y) + (f1.z * f1.z + f1.w * f1.w)
                + (f2.x * f2.x + f2.y * f2.y) + (f2.z * f2.z + f2.w * f2.w) + (f3.x * f3.x + f3.y * f3.y) + (f3.z * f3.z + f3.w * f3.w);
        const float rf = rsqrtf(wave_sum(s) * (1.0f / DM) + EPS);
        const float* sq = (const float*)(p.ws + WS_SSQM) + (size_t)row * 16; float s0 = 0.f;
#pragma unroll
        for (int j = 0; j < 4; ++j) { const f32x4 q = *(const f32x4*)(sq + 4 * j); s0 += (q.x + q.y) + (q.z + q.w); }
        const float rm = rsqrtf(s0 * (1.0f / DM) + EPS);
#pragma unroll
        for (int hh = 0; hh < 2; ++hh) { const int c = hh * 512 + 8 * lane; const f32x4 fa = hh ? f2 : f0, fb = hh ? f3 : f1;
            const f32x4 xa = *(const f32x4*)(p.in[0] + (size_t)row * DM + c), xb = *(const f32x4*)(p.in[0] + (size_t)row * DM + c + 4);
            const u32x4 mv = *(const u32x4*)((const bf16_t*)(p.ws + WS_MX) + (size_t)row * DM + c);
            const f32x4 gma = *(const f32x4*)(mb + 2048 + c), gmb = *(const f32x4*)(mb + 2048 + c + 4), gfa = *(const f32x4*)(mb + 5120 + c), gfb = *(const f32x4*)(mb + 5120 + c + 4);
            const f32x4 pma = *(const f32x4*)(gpm + c), pmb = *(const f32x4*)(gpm + c + 4), poa = *(const f32x4*)(gpo + c), pob = *(const f32x4*)(gpo + c + 4);
            f32x4 oa, ob;
            oa.x = xa.x + gma.x * (bflo(mv.x) * rm * pma.x) + gfa.x * (fa.x * rf * poa.x); oa.y = xa.y + gma.y * (bfhi(mv.x) * rm * pma.y) + gfa.y * (fa.y * rf * poa.y);
            oa.z = xa.z + gma.z * (bflo(mv.y) * rm * pma.z) + gfa.z * (fa.z * rf * poa.z); oa.w = xa.w + gma.w * (bfhi(mv.y) * rm * pma.w) + gfa.w * (fa.w * rf * poa.w);
            ob.x = xb.x + gmb.x * (bflo(mv.z) * rm * pmb.x) + gfb.x * (fb.x * rf * pob.x); ob.y = xb.y + gmb.y * (bfhi(mv.z) * rm * pmb.y) + gfb.y * (fb.y * rf * pob.y);
            ob.z = xb.z + gmb.z * (bflo(mv.w) * rm * pmb.z) + gfb.z * (fb.z * rf * pob.z); ob.w = xb.w + gmb.w * (bfhi(mv.w) * rm * pmb.w) + gfb.w * (fb.w * rf * pob.w);
            *(f32x4*)(orow + c) = oa; *(f32x4*)(orow + c + 4) = ob; }
    }
}

constexpr int N_PHASES = 21;
__global__ void __launch_bounds__(NT, 2) fwd_kernel(Params p) {
    extern __shared__ __attribute__((aligned(16))) unsigned char lds_raw[];
    ldsp_t lds = (ldsp_t)lds_raw;
    const int G = gridDim.x, c = blockIdx.x;
    const int lo = p.ph_lo, hi = p.ph_hi;
#ifdef ONLY_PHASE
#define IN(k) ((k) == ONLY_PHASE && lo <= (k) && (k) < hi)
#else
#define IN(k) (lo <= (k) && (k) < hi)
#endif
#define SEAM(k) do { if (IN((k) + 1)) { cg::this_grid().sync(); } } while (0)
    if (IN(0)) { phase_prep(p, lds); SEAM(0); }
    if (IN(1)) { phase_xn(p, lds); SEAM(1); }
    if (IN(2)) { SchedG1 S{p.ws, G, c}; EpiG1 E{p.ws}; pg8::gemm_phase<EpiG1, SchedG1, false>(lds, 1024, 2048u, 2048u, S, E); SEAM(2); }
    if (IN(3)) { SchedG2 S{p.ws, G, c}; EpiG2 E{p.ws}; pg8::gemm_phase<EpiG2, SchedG2, false>(lds, 256, 1024u, 512u, S, E); SEAM(3); }
    if (IN(4)) { phase_carry(p); phase_sgu(p, lds); SEAM(4); }
    if (IN(5)) { SchedG3 S{p.ws, G, c}; EpiG3 E{p.ws}; pg8::gemm_phase<EpiG3, SchedG3, false>(lds, 512, 1024u, 1024u, S, E); SEAM(5); }
    if (IN(6)) { SchedG4 S{p.ws, G, c}; EpiG4 E{p.ws, p.in[20]}; pg8::gemm_phase<EpiG4, SchedG4, false>(lds, 512, 1024u, 1024u, S, E); SEAM(6); }
    if (IN(7)) { SchedG5 S{p.ws, G, c}; EpiG5 E{p.ws}; pg8::gemm_phase<EpiG5, SchedG5, false>(lds, 512, 1024u, 1024u, S, E); SEAM(7); }
    if (IN(8)) { SchedG6 S{p.ws, G, c}; EpiG6 E{p.ws}; pg8::gemm_phase<EpiG6, SchedG6, false>(lds, 1024, 2048u, 2048u, S, E); SEAM(8); }
    if (IN(9)) { phase_r1(p); SEAM(9); }
    if (IN(10)) { SchedG7 S{p.ws, G, c}; EpiG7 E{p.ws}; pg8::gemm_phase<EpiG7, SchedG7, false>(lds, 1024, 2048u, 2048u, S, E); SEAM(10); }
    if (IN(11)) { phase_route(p, lds); SEAM(11); }
    if (IN(12)) { phase_scan(p, lds); SEAM(12); }
    if (IN(13)) { phase_scatter(p, lds); SEAM(13); }
    if (IN(14)) { SchedG8 S{p.ws, G, c}; EpiG8 E{p.ws}; pg8::gemm_phase<EpiG8, SchedG8, true>(lds, 1024, 2048u, 2048u, S, E); SEAM(14); }
    if (IN(15)) { { SchedG9 S{p.ws, G, c, 0}; EpiG9 E{p.ws}; pg8::gemm_phase<EpiG9, SchedG9, false>(lds, 256, 512u, 512u, S, E); }
                  { SchedG10 S{p.ws, G, c}; EpiG10 E{p.out}; pg8::gemm_phase<EpiG10, SchedG10, false>(lds, 256, 512u, 512u, S, E); } SEAM(15); }
    if (IN(16)) { phase_r3a(p); SEAM(16); }
    if (IN(17)) { SchedG9 S{p.ws, G, c, 1}; EpiG9 E{p.ws}; pg8::gemm_phase<EpiG9, SchedG9, false>(lds, 256, 512u, 512u, S, E); SEAM(17); }
    if (IN(18)) { phase_r3b(p); }
#undef IN
#undef SEAM
}

extern "C" void kernel_launch(void* const* d_in, const int* in_sizes, int n_in, void* d_out, int out_size, void* d_ws, size_t ws_size, hipStream_t stream) {
    static int grid = 0;
    if (grid == 0) {
        if (n_in != 35 || out_size != NTOK * DM || ws_size < WS_NEED) { fprintf(stderr, "kernel_launch: unexpected shapes / workspace (%d inputs, out %d, ws %zu)\n", n_in, out_size, ws_size); grid = -1; return; }
        int dev = 0, cus = 0, per_cu = 0;
        hipGetDevice(&dev); hipDeviceGetAttribute(&cus, hipDeviceAttributeMultiprocessorCount, dev);
        hipFuncSetAttribute((const void*)fwd_kernel, hipFuncAttributeMaxDynamicSharedMemorySize, LDS_BYTES);
        hipOccupancyMaxActiveBlocksPerMultiprocessor(&per_cu, (const void*)fwd_kernel, NT, LDS_BYTES);
        if (per_cu < 1) { fprintf(stderr, "kernel_launch: occupancy query says %d blocks per CU\n", per_cu); per_cu = 1; }
        grid = cus * 1;
        (void)hipGetLastError();
    }
    if (grid < 0) return;
    Params p{};
    for (int i = 0; i < 35; ++i) p.in[i] = (const float*)d_in[i];
    p.out = (float*)d_out; p.ws = (unsigned char*)d_ws;
#if N_LAUNCH_MODE == 1
    p.ph_lo = 0; p.ph_hi = N_PHASES;
    void* args[] = {&p};
    hipError_t e = hipLaunchCooperativeKernel((const void*)fwd_kernel, dim3(grid), dim3(NT), args, LDS_BYTES, stream);
    if (e != hipSuccess) fprintf(stderr, "cooperative launch failed: %s (grid %d)\n", hipGetErrorString(e), grid);
#else
    for (int k = 0; k < 19; ++k) { p.ph_lo = k; p.ph_hi = k + 1; hipLaunchKernelGGL(fwd_kernel, dim3(grid), dim3(NT), LDS_BYTES, stream, p); }
#endif
}
```

```cpp
#include <hip/hip_runtime.h>
#include <hip/hip_cooperative_groups.h>
#include <cstdio>
namespace cg = cooperative_groups;

#ifndef DUP_PHASE
#define DUP_PHASE -1
#define DUP_REPS 1
#define DUP_SUB -1
#define SPIN_PHASE -1
#define SPIN_MULT 9
#endif
#ifndef N_LAUNCH_MODE
#define N_LAUNCH_MODE 1
#endif

#define LAS __attribute__((address_space(3)))
typedef unsigned short bf16_t;
typedef short bf16x8 __attribute__((ext_vector_type(8)));
typedef float f32x4 __attribute__((ext_vector_type(4)));
typedef float f32x2 __attribute__((ext_vector_type(2)));
typedef unsigned u32x4 __attribute__((ext_vector_type(4)));
typedef unsigned u32x2 __attribute__((ext_vector_type(2)));
typedef LAS unsigned char* ldsp_t;

constexpr int NT = 512;
constexpr int DM = 1024;
constexpr int NTOK = 32768;
constexpr int NCTXR = 1024;
constexpr int NROWS = NTOK + NCTXR;
constexpr int DIN = 3584;
constexpr int UC_ROWS = 2304;
constexpr int NEXP = 256;
constexpr int MAXSLOT = 360448;
constexpr float EPS = 1e-6f;

constexpr size_t MiB = 1u << 20;
constexpr size_t WS_MODP = 1 * MiB;
constexpr size_t WS_MOD = 3 * MiB;
constexpr size_t WS_APL = 3 * MiB + 256 * 1024;
constexpr size_t WS_SGUW = 3 * MiB + 512 * 1024;
constexpr size_t WS_WGLU_T = 4 * MiB;
constexpr size_t WS_WR_T = 4 * MiB + 512 * 1024;
constexpr size_t WS_WB5_T = 5 * MiB;
constexpr size_t WS_WBS_T = 6 * MiB;
constexpr size_t WS_WOUT_T = 7 * MiB;
constexpr size_t WS_WIN_T = 9 * MiB;
constexpr size_t WS_BCAT_T = 16 * MiB;
constexpr size_t WS_WEND_T = 24 * MiB;
constexpr size_t WS_SSQV = 28 * MiB;
constexpr size_t WS_SSQM = 29 * MiB;
constexpr size_t WS_IDX = 31 * MiB;
constexpr size_t WS_WT = 32 * MiB;
constexpr size_t WS_SLOT = 33 * MiB;
constexpr size_t WS_BLKCNT = 34 * MiB;
constexpr size_t WS_BLKOFF = 34 * MiB + 256 * 1024;
constexpr size_t WS_TOTAL = 34 * MiB + 512 * 1024;
constexpr size_t WS_TILEEXP = 34 * MiB + 768 * 1024;
constexpr size_t WS_TOKSLOT = 35 * MiB;
constexpr size_t WS_WSLOT = 36 * MiB + 512 * 1024;
constexpr size_t WS_WD_T = 48 * MiB;
constexpr size_t WS_WGU_T = 177 * MiB;
constexpr size_t WS_XN = 434 * MiB;
constexpr size_t WS_UCAT = 500 * MiB;
constexpr size_t WS_E = 572 * MiB;
constexpr size_t WS_GU = 644 * MiB;
constexpr size_t WS_GV = 676 * MiB;
constexpr size_t WS_SG5 = 708 * MiB;
constexpr size_t WS_SGS = 772 * MiB;
constexpr size_t WS_YS = 836 * MiB;
constexpr size_t WS_YS5 = 868 * MiB;
constexpr size_t WS_YSGU = 900 * MiB;
constexpr size_t WS_MX = 932 * MiB;
constexpr size_t WS_MERGED = 500 * MiB;
constexpr size_t WS_LOGITS = 564 * MiB;
constexpr size_t WS_H = 596 * MiB;
constexpr size_t WS_YSLOT = 177 * MiB;
constexpr size_t WS_NEED = 996 * MiB;

constexpr int LDS_BYTES = 147456;

struct Params { const float* in[35]; float* out; unsigned char* ws; int ph_lo, ph_hi; };

__device__ __forceinline__ unsigned f2bf(float f) { unsigned u = __builtin_bit_cast(unsigned, f); return (u + 0x7fffu + ((u >> 16) & 1u)) >> 16; }
typedef __bf16 bf16v2_t __attribute__((ext_vector_type(2)));
__device__ __forceinline__ unsigned pk2(float lo, float hi) { bf16v2_t v; v.x = (__bf16)lo; v.y = (__bf16)hi; return __builtin_bit_cast(unsigned, v); }
__device__ __forceinline__ float bflo(unsigned w) { return __builtin_bit_cast(float, w << 16); }
__device__ __forceinline__ float bfhi(unsigned w) { return __builtin_bit_cast(float, w & 0xffff0000u); }
__device__ __forceinline__ float bf2f(bf16_t b) { return __builtin_bit_cast(float, ((unsigned)b) << 16); }
__device__ __forceinline__ float sigmoid_f(float x) { return __builtin_amdgcn_rcpf(1.0f + __expf(-x)); }
__device__ __forceinline__ float silu_f(float x) { return x * sigmoid_f(x); }
__device__ __forceinline__ float gelu_f(float x) { const float z = 1.5957691216057308f * (x + 0.044715f * x * x * x); return x * sigmoid_f(z); }
__device__ __forceinline__ float wave_sum(float v) {
#pragma unroll
    for (int o = 1; o < 64; o <<= 1) v += __shfl_xor(v, o);
    return v;
}
template <int CTRL, int RM = 0xf, int BM = 0xf> __device__ __forceinline__ float dpp_f(float oldv, float x) {
    return __builtin_bit_cast(float, __builtin_amdgcn_update_dpp(__builtin_bit_cast(int, oldv), __builtin_bit_cast(int, x), CTRL, RM, BM, false)); }
__device__ __forceinline__ float wave_max_dpp(float v) {
    v = fmaxf(v, dpp_f<0xB1>(v, v)); v = fmaxf(v, dpp_f<0x4E>(v, v)); v = fmaxf(v, dpp_f<0x124>(v, v)); v = fmaxf(v, dpp_f<0x128>(v, v));
    v = fmaxf(v, dpp_f<0x142, 0xa>(v, v)); v = fmaxf(v, dpp_f<0x143, 0xc>(v, v));
    return __builtin_bit_cast(float, __builtin_amdgcn_readlane(__builtin_bit_cast(int, v), 63)); }
#define LDS_WAIT() asm volatile("s_waitcnt lgkmcnt(0)" ::: "memory")

__device__ __forceinline__ double dexp_(double x) {
    const double r = x * (1.0 / 32.0); double t = 1.0, s = 1.0;
#pragma unroll 1
    for (int i = 1; i <= 14; ++i) { t *= r / (double)i; s += t; }
#pragma unroll 1
    for (int i = 0; i < 5; ++i) s *= s;
    return s;
}
__device__ __forceinline__ void dsincos_(double th, double& sn, double& cs) {
    const double TWO_PI_HI = 6.283185307179586232, TWO_PI_LO = 2.4492935982947064e-16;
    const double k = __builtin_rint(th * 0.15915494309189535);
    double r = (th - k * TWO_PI_HI) - k * TWO_PI_LO;
    r *= 0.125;
    const double r2 = r * r; double ts = r, tc = 1.0, s = r, c = 1.0;
#pragma unroll 1
    for (int i = 1; i <= 9; ++i) { tc *= -r2 / (double)((2 * i - 1) * (2 * i)); c += tc; ts *= -r2 / (double)((2 * i) * (2 * i + 1)); s += ts; }
#pragma unroll 1
    for (int i = 0; i < 3; ++i) { const double s2 = 2.0 * s * c, c2 = c * c - s * s; s = s2; c = c2; }
    sn = s; cs = c;
}

namespace pg8 {
constexpr int BM = 256, BK = 64, HALF = 128, HTB = HALF * BK * 2, STAGE_BYTES = 8 * HTB;
__device__ __forceinline__ int lds_byte(int r, int c) { const int st = (r >> 4) * 2 + (c >> 5), rr = r & 15, cc = c & 31, ob = rr * 64 + cc * 2; return st * 1024 + (ob ^ (((ob >> 9) & 1) << 5)); }
__device__ __forceinline__ void stage_rc(int b, int& R, int& C) { const int st = b / 1024, sb = b % 1024, swz = sb ^ (((sb >> 9) & 1) << 5); R = (st >> 1) * 16 + swz / 64; C = (st & 1) * 32 + (swz % 64) / 2; }
__device__ __forceinline__ int perm32(int rho) { const int n = rho >> 4, i = rho & 15; return 8 * (i >> 2) + 4 * n + (i & 3); }

struct Unit { const char* A; const char* B; const int* arow; int pm, pn, x0, x1; };

template <class Epi, class Sched, bool GATHER>
__device__ __forceinline__ void gemm_phase(ldsp_t lds, const int K, const unsigned lda, const unsigned ldb, const Sched& S, const Epi& E) {
    const int tid = threadIdx.x, wid = __builtin_amdgcn_readfirstlane(tid >> 6), lane = tid & 63, wr = wid >> 2, wc = wid & 3, fr = lane & 15, fq = lane >> 4;
    const int nt = K / BK;
    int RA[2], CA[2]; unsigned voffB[2][2];
#pragma unroll
    for (int i = 0; i < 2; ++i) { int R, C; stage_rc(tid * 16 + i * 8192, R, C); RA[i] = R; CA[i] = C; const int Rb = Epi::PERM ? ((R & ~31) + perm32(R & 31)) : R;
        voffB[0][i] = (unsigned)Rb * ldb + (unsigned)C * 2u; voffB[1][i] = (unsigned)(Rb + HALF) * ldb + (unsigned)C * 2u; }
    unsigned vA[2][2], vN[2][2];
#define PG8_SETA(v, u) do { _Pragma("unroll") for (int _h = 0; _h < 2; ++_h) _Pragma("unroll") for (int _i = 0; _i < 2; ++_i) { \
        const int _row = _h * HALF + RA[_i]; const unsigned _src = GATHER ? (unsigned)(u).arow[_row] : (unsigned)_row; (v)[_h][_i] = _src * lda + (unsigned)CA[_i] * 2u; } } while (0)
    const size_t kstep = (size_t)(BK * 2);
    const unsigned ldsw = (unsigned)wid * 1024u;
    const int aoff = lds_byte(wr * 64 + fr, fq * 8), boff = lds_byte(wc * 32 + fr, fq * 8);
#define PG8_SA(b, h) (((b) * 2 + (h)) * HTB)
#define PG8_SB(b, h) ((4 + (b) * 2 + (h)) * HTB)
#define PG8_STAGE(bufoff, gbase, o0, o1) do { \
        __builtin_amdgcn_global_load_lds((const unsigned*)((const char*)(gbase) + (o0)), (LAS unsigned*)(lds + (bufoff) + ldsw), 16, 0, 0); \
        __builtin_amdgcn_global_load_lds((const unsigned*)((const char*)(gbase) + (o1)), (LAS unsigned*)(lds + (bufoff) + ldsw + 8192), 16, 0, 0); } while (0)
#define PG8_LDA(dst, b, h) do { _Pragma("unroll") for (int m = 0; m < 4; ++m) _Pragma("unroll") for (int k = 0; k < 2; ++k) dst[m][k] = *(const LAS bf16x8*)(lds + PG8_SA(b, h) + aoff + m * 2048 + k * 1024); } while (0)
#define PG8_LDB(dst, b, h) do { _Pragma("unroll") for (int n = 0; n < 2; ++n) _Pragma("unroll") for (int k = 0; k < 2; ++k) dst[n][k] = *(const LAS bf16x8*)(lds + PG8_SB(b, h) + boff + n * 2048 + k * 1024); } while (0)
#define PG8_MMA(ai, bj, At, Bt) do { __builtin_amdgcn_s_setprio(1); _Pragma("unroll") for (int m = 0; m < 4; ++m) _Pragma("unroll") for (int n = 0; n < 2; ++n) _Pragma("unroll") for (int k = 0; k < 2; ++k) \
        acc[ai][bj][m][n] = __builtin_amdgcn_mfma_f32_16x16x32_bf16(Bt[n][k], At[m][k], acc[ai][bj][m][n], 0, 0, 0); __builtin_amdgcn_s_setprio(0); } while (0)
#define PG8_WAIT_V(n) asm volatile("s_waitcnt vmcnt(" #n ")" ::: "memory")
#define PG8_WAIT_L(n) asm volatile("s_waitcnt lgkmcnt(" #n ")" ::: "memory")
#define PG8_BAR __builtin_amdgcn_s_barrier()
#define PG8_SCHED __builtin_amdgcn_sched_barrier(0)
    Unit cur, nxt; int ui = 0;
    if (!S.next(0, cur)) return;
    PG8_SETA(vA, cur);
    f32x4 acc[2][2][4][2];
#pragma unroll
    for (int a = 0; a < 2; ++a)
#pragma unroll
        for (int b = 0; b < 2; ++b)
#pragma unroll
            for (int m = 0; m < 4; ++m)
#pragma unroll
                for (int n = 0; n < 2; ++n) acc[a][b][m][n] = (f32x4){0.f, 0.f, 0.f, 0.f};
    bf16x8 At[4][2], B0[2][2], B1[2][2];
    const char* cA = cur.A; const char* cB = cur.B;
    PG8_STAGE(PG8_SB(0, 0), cB, voffB[0][0], voffB[0][1]); PG8_STAGE(PG8_SA(0, 0), cA, vA[0][0], vA[0][1]);
    PG8_STAGE(PG8_SB(0, 1), cB, voffB[1][0], voffB[1][1]); PG8_STAGE(PG8_SA(0, 1), cA, vA[1][0], vA[1][1]);
    if (wr == 1) PG8_BAR;
    PG8_WAIT_V(4); PG8_BAR;
    PG8_STAGE(PG8_SB(1, 0), cB + kstep, voffB[0][0], voffB[0][1]); PG8_STAGE(PG8_SA(1, 0), cA + kstep, vA[0][0], vA[0][1]);
    PG8_STAGE(PG8_SB(1, 1), cB + kstep, voffB[1][0], voffB[1][1]);
    PG8_WAIT_V(6); PG8_BAR;
    for (;;) {
        const bool has_next = S.next(ui + 1, nxt);
        const char* nA = has_next ? nxt.A : cA; const char* nB = has_next ? nxt.B : cB;
        if (GATHER) { if (has_next) { PG8_SETA(vN, nxt); } else { vN[0][0] = vA[0][0]; vN[0][1] = vA[0][1]; vN[1][0] = vA[1][0]; vN[1][1] = vA[1][1]; } }
#pragma nounroll
        for (int t = 0; t < nt; t += 2) {
            const bool last = (t == nt - 2);
            const char* a1 = cA + (size_t)(t + 1) * kstep;
            const char* a2 = last ? nA : cA + (size_t)(t + 2) * kstep; const char* b2 = last ? nB : cB + (size_t)(t + 2) * kstep;
            const char* a3 = a2 + kstep; const char* b3 = b2 + kstep;
            unsigned o00, o01, o10, o11;
            if (GATHER && last) { o00 = vN[0][0]; o01 = vN[0][1]; o10 = vN[1][0]; o11 = vN[1][1]; } else { o00 = vA[0][0]; o01 = vA[0][1]; o10 = vA[1][0]; o11 = vA[1][1]; }
            PG8_LDB(B0, 0, 0); PG8_SCHED; PG8_LDA(At, 0, 0); PG8_STAGE(PG8_SA(1, 1), a1, vA[1][0], vA[1][1]);
            PG8_WAIT_L(8); PG8_BAR; PG8_WAIT_L(0); PG8_MMA(0, 0, At, B0); PG8_BAR; PG8_SCHED;
            PG8_LDB(B1, 0, 1); PG8_STAGE(PG8_SB(0, 0), b2, voffB[0][0], voffB[0][1]);
            PG8_BAR; PG8_WAIT_L(0); PG8_MMA(0, 1, At, B1); PG8_BAR;
            PG8_LDA(At, 0, 1); PG8_STAGE(PG8_SA(0, 0), a2, o00, o01);
            PG8_BAR; PG8_WAIT_L(0); PG8_MMA(1, 0, At, B0); PG8_BAR; PG8_SCHED;
            PG8_STAGE(PG8_SB(0, 1), b2, voffB[1][0], voffB[1][1]);
            PG8_WAIT_V(6); PG8_BAR; PG8_MMA(1, 1, At, B1); PG8_BAR;
            PG8_LDB(B0, 1, 0); PG8_SCHED; PG8_LDA(At, 1, 0); PG8_STAGE(PG8_SA(0, 1), a2, o10, o11);
            PG8_WAIT_L(8); PG8_BAR; PG8_WAIT_L(0); PG8_MMA(0, 0, At, B0); PG8_BAR; PG8_SCHED;
            PG8_LDB(B1, 1, 1); PG8_STAGE(PG8_SB(1, 0), b3, voffB[0][0], voffB[0][1]);
            PG8_BAR; PG8_WAIT_L(0); PG8_MMA(0, 1, At, B1); PG8_BAR;
            PG8_LDA(At, 1, 1); PG8_STAGE(PG8_SA(1, 0), a3, o00, o01);
            PG8_BAR; PG8_WAIT_L(0); PG8_MMA(1, 0, At, B0); PG8_BAR; PG8_SCHED;
            PG8_STAGE(PG8_SB(1, 1), b3, voffB[1][0], voffB[1][1]);
            PG8_WAIT_V(6); PG8_BAR; PG8_MMA(1, 1, At, B1); PG8_BAR;
        }
        E(acc, cur, wr, wc, fr, fq);
        if (!has_next) break;
#pragma unroll
        for (int a = 0; a < 2; ++a)
#pragma unroll
            for (int b = 0; b < 2; ++b)
#pragma unroll
                for (int m = 0; m < 4; ++m)
#pragma unroll
                    for (int n = 0; n < 2; ++n) acc[a][b][m][n] = (f32x4){0.f, 0.f, 0.f, 0.f};
        cur = nxt; cA = nA; cB = nB; ++ui;
        if (GATHER) { vA[0][0] = vN[0][0]; vA[0][1] = vN[0][1]; vA[1][0] = vN[1][0]; vA[1][1] = vN[1][1]; }
    }
    PG8_WAIT_V(0);
    if (wr == 0) PG8_BAR;
    PG8_BAR;
#undef PG8_SETA
#undef PG8_SA
#undef PG8_SB
#undef PG8_STAGE
#undef PG8_LDA
#undef PG8_LDB
#undef PG8_MMA
#undef PG8_WAIT_V
#undef PG8_WAIT_L
#undef PG8_BAR
#undef PG8_SCHED
}
}
using pg8::Unit;
typedef f32x4 acc_t[2][2][4][2];

#define EPI_ROWS(ai, m, rowl) _Pragma("unroll") for (int ai = 0; ai < 2; ++ai) _Pragma("unroll") for (int m = 0; m < 4; ++m) { const int rowl = ai * 128 + wr * 64 + m * 16 + fr;
#define EPI_END }

__device__ __forceinline__ void transpose_item(const float* W, int ldw, int k0, int n0, bf16_t* WT, size_t drow0, int ldt, LAS float* scr, int lane) {
    f32x4 v[16];
#pragma unroll
    for (int it = 0; it < 16; ++it) v[it] = *(const f32x4*)(W + (size_t)(k0 + it * 4 + (lane >> 4)) * ldw + n0 + (lane & 15) * 4);
#pragma unroll
    for (int it = 0; it < 16; ++it) { LAS float* s = scr + (it * 4 + (lane >> 4)) * 65 + (lane & 15) * 4; s[0] = v[it].x; s[1] = v[it].y; s[2] = v[it].z; s[3] = v[it].w; }
    LDS_WAIT();
#pragma unroll
    for (int it = 0; it < 8; ++it) {
        const int n = it * 8 + (lane >> 3), c = lane & 7;
        const LAS float* s = scr + (8 * c) * 65 + n;
        u32x4 o; o.x = pk2(s[0], s[65]); o.y = pk2(s[130], s[195]); o.z = pk2(s[260], s[325]); o.w = pk2(s[390], s[455]);
        *(u32x4*)(WT + (drow0 + n) * (size_t)ldt + k0 + 8 * c) = o;
    }
    LDS_WAIT();
}

__device__ __forceinline__ void s5_tables(const Params& p, int g, ldsp_t lds) {
    LAS f32x2* apow = (LAS f32x2*)lds;
    LAS f32x2* bbar = (LAS f32x2*)(lds + 17408);
    LAS f32x2* cm = (LAS f32x2*)(lds + 17408 + 16384);
    LAS float* Kt = (LAS float*)(lds + 17408 + 32768);
    const int tid = threadIdx.x;
    const float *a_re = p.in[11], *a_im = p.in[12], *log_dt = p.in[13], *b_re = p.in[14], *b_im = p.in[15], *c_re = p.in[16], *c_im = p.in[17], *dsk = p.in[18];
    float* APL = (float*)(p.ws + WS_APL);
    if (tid < 128) {
        const int d = tid >> 6, pp = tid & 63, idx = (d * 32 + g) * 64 + pp;
        const double are = (double)a_re[idx], aim = (double)a_im[idx];
        const double dt = dexp_((double)log_dt[d * 32 + g]);
        const double mag = dexp_(dt * are); double sn, cs; dsincos_(dt * aim, sn, cs);
        const double abr = mag * cs, abi = mag * sn;
        double pr = 1.0, pi = 0.0;
#pragma unroll 1
        for (int m = 0; m <= 16; ++m) { apow[(d * 17 + m) * 64 + pp] = (f32x2){(float)pr, (float)pi}; const double nr = pr * abr - pi * abi, ni = pr * abi + pi * abr; pr = nr; pi = ni; }
        { const f32x2 aL = apow[(d * 17 + 16) * 64 + pp]; APL[idx * 2 + 0] = aL.x; APL[idx * 2 + 1] = aL.y; }
        const double nr = abr - 1.0, ni = abi, den = are * are + aim * aim;
        const double qr = (nr * are + ni * aim) / den, qi = (ni * are - nr * aim) / den;
#pragma unroll 1
        for (int i = 0; i < 16; ++i) { const double br = (double)b_re[idx * 16 + i], bi = (double)b_im[idx * 16 + i];
            bbar[(d * 64 + pp) * 16 + i] = (f32x2){(float)(qr * br - qi * bi), (float)(qr * bi + qi * br)}; }
    }
    for (int e = tid; e < 2048; e += NT) { const int d = e >> 10, j = (e >> 6) & 15, pp = e & 63; const int gi = ((d * 32 + g) * 16 + j) * 64 + pp; cm[e] = (f32x2){c_re[gi], c_im[gi]}; }
    __syncthreads();
    for (int e = tid; e < 8192; e += NT) {
        const int d = e >> 12, m = (e >> 8) & 15, j = (e >> 4) & 15, i = e & 15; float s = 0.f;
#pragma unroll 4
        for (int pp = 0; pp < 64; ++pp) { const f32x2 a = apow[(d * 17 + m) * 64 + pp], b = bbar[(d * 64 + pp) * 16 + i], c = cm[(d * 16 + j) * 64 + pp];
            const float tr = a.x * b.x - a.y * b.y, ti = a.x * b.y + a.y * b.x; s += c.x * tr - c.y * ti; }
        Kt[e] = s;
    }
    __syncthreads();
    unsigned* BC = (unsigned*)(p.ws + WS_BCAT_T) + (size_t)g * 256 * 256;
    for (int e2 = tid; e2 < 65536; e2 += NT) {
        const int n = e2 >> 8, kk0 = (e2 & 255) * 2, tau = n >> 4, j = n & 15; float v[2];
#pragma unroll
        for (int q = 0; q < 2; ++q) { const int kk = kk0 + q; float r;
            if (kk < 256) { const int k = kk >> 4, i = kk & 15; r = 0.f;
                if (tau >= k) r += Kt[((0 * 16 + (tau - k)) * 16 + j) * 16 + i];
                if (k >= tau) r += Kt[((1 * 16 + (k - tau)) * 16 + j) * 16 + i];
                if (k == tau && i == j) r += dsk[16 * g + j];
            } else { const int qq = kk - 256, part = qq >> 6, pp = qq & 63, d = part >> 1, m = (d == 0) ? (tau + 1) : (16 - tau);
                const f32x2 c = cm[(d * 16 + j) * 64 + pp], a = apow[(d * 17 + m) * 64 + pp];
                r = (part & 1) ? -(c.x * a.y + c.y * a.x) : (c.x * a.x - c.y * a.y); }
            v[q] = r; }
        BC[e2] = pk2(v[0], v[1]);
    }
    unsigned* WE = (unsigned*)(p.ws + WS_WEND_T) + (size_t)g * 256 * 128;
    for (int e2 = tid; e2 < 32768; e2 += NT) {
        const int n = e2 >> 7, kk0 = (e2 & 127) * 2, d = n >> 7, ri = (n >> 6) & 1, pp = n & 63; float v[2];
#pragma unroll
        for (int q = 0; q < 2; ++q) { const int kk = kk0 + q, k = kk >> 4, i = kk & 15, m = (d == 0) ? (15 - k) : k;
            const f32x2 a = apow[(d * 17 + m) * 64 + pp], b = bbar[(d * 64 + pp) * 16 + i];
            v[q] = ri ? (a.x * b.y + a.y * b.x) : (a.x * b.x - a.y * b.y); }
        WE[e2] = pk2(v[0], v[1]);
    }
    __syncthreads();
}

__device__ __forceinline__ void phase_prep(const Params& p, ldsp_t lds) {
    const int tid = threadIdx.x, lane = tid & 63, wave = tid >> 6, G = gridDim.x, bx = blockIdx.x;
    for (int g = bx; g < 32; g += G) s5_tables(p, g, lds);
    { const float* sw = p.in[22]; unsigned* dst = (unsigned*)(p.ws + WS_SGUW);
      for (size_t e = (size_t)bx * NT + tid; e < 65536; e += (size_t)G * NT) dst[e] = pk2(sw[2 * e], sw[2 * e + 1]);
      u32x4* uc = (u32x4*)(p.ws + WS_UCAT);
      for (size_t e = (size_t)bx * NT + tid; e < (size_t)32 * 12288; e += (size_t)G * NT) { const size_t g = e / 12288, r = e % 12288; uc[(g * UC_ROWS + 2112) * 64 + r] = (u32x4){0u, 0u, 0u, 0u}; } }
    const int gw = bx * 8 + wave, NGW = G * 8;
    LAS float* scr = (LAS float*)(lds + wave * 16640);
    constexpr int I_MODP = 1536, I_IN = 16 * 56, I_GLU = 64, I_B5 = 128, I_BS = 128, I_OUT = 256, I_R = 64, I_SMALL = I_IN + I_GLU + I_B5 + I_BS + I_OUT + I_R, I_EXP = 257 * 192;
    for (int it = gw; it < I_MODP + I_SMALL + I_EXP; it += NGW) {
        int r = it;
        if (r < I_MODP) {
            const int cb = r % 96, ks = r / 96, n = cb * 64 + lane; const float* wm = p.in[4];
            float a0 = 0.f, a1 = 0.f, a2 = 0.f, a3 = 0.f, a4 = 0.f;
#pragma unroll 8
            for (int kk = 0; kk < 64; ++kk) { const int k = ks * 64 + kk; const float w = wm[(size_t)k * 6144 + n];
                a0 += silu_f(p.in[1][k]) * w; a1 += silu_f(p.in[1][1024 + k]) * w; a2 += silu_f(p.in[1][2048 + k]) * w; a3 += silu_f(p.in[1][3072 + k]) * w; a4 += silu_f(p.in[3][k]) * w; }
            float* mp = (float*)(p.ws + WS_MODP) + (size_t)ks * 5 * 6144 + n;
            mp[0] = a0; mp[6144] = a1; mp[2 * 6144] = a2; mp[3 * 6144] = a3; mp[4 * 6144] = a4;
            continue; }
        r -= I_MODP;
        if (r < I_IN) { transpose_item(p.in[10], DIN, (r / 56) * 64, (r % 56) * 64, (bf16_t*)(p.ws + WS_WIN_T), (size_t)(r % 56) * 64, 1024, scr, lane); continue; } r -= I_IN;
        if (r < I_GLU) { transpose_item(p.in[19], 512, (r / 8) * 64, (r % 8) * 64, (bf16_t*)(p.ws + WS_WGLU_T), (size_t)(r % 8) * 64, 512, scr, lane); continue; } r -= I_GLU;
        if (r < I_B5) { transpose_item(p.in[24], 1024, (r / 16) * 64, (r % 16) * 64, (bf16_t*)(p.ws + WS_WB5_T), (size_t)(r % 16) * 64, 512, scr, lane); continue; } r -= I_B5;
        if (r < I_BS) { transpose_item(p.in[25], 1024, (r / 16) * 64, (r % 16) * 64, (bf16_t*)(p.ws + WS_WBS_T), (size_t)(r % 16) * 64, 512, scr, lane); continue; } r -= I_BS;
        if (r < I_OUT) { transpose_item(p.in[26], 1024, (r / 16) * 64, (r % 16) * 64, (bf16_t*)(p.ws + WS_WOUT_T), (size_t)(r % 16) * 64, 1024, scr, lane); continue; } r -= I_OUT;
        if (r < I_R) { transpose_item(p.in[27], 256, (r / 4) * 64, (r % 4) * 64, (bf16_t*)(p.ws + WS_WR_T), (size_t)(r % 4) * 64, 1024, scr, lane); continue; } r -= I_R;
        { const int e = r / 192, q = r % 192;
          if (q < 128) {
              const int up = q >> 6, qq = q & 63, k0 = (qq / 4) * 64, n0 = (qq % 4) * 64;
              const float* W = (e < 256) ? p.in[up ? 30 : 29] + (size_t)e * 262144 : p.in[up ? 33 : 32];
              transpose_item(W, 256, k0, n0, (bf16_t*)(p.ws + WS_WGU_T), (size_t)e * 512 + (size_t)(n0 >> 7) * 256 + up * 128 + (n0 & 127), 1024, scr, lane);
          } else {
              const int qq = q - 128, k0 = (qq / 16) * 64, n0 = (qq % 16) * 64;
              const float* W = (e < 256) ? p.in[31] + (size_t)e * 262144 : p.in[34];
              transpose_item(W, 1024, k0, n0, (bf16_t*)(p.ws + WS_WD_T), (size_t)e * 1024 + n0, 256, scr, lane);
          } }
    }
}

__device__ __forceinline__ void phase_xn(const Params& p, ldsp_t lds) {
    const int tid = threadIdx.x, lane = tid & 63, wave = tid >> 6, G = gridDim.x, bx = blockIdx.x;
    const float* modp = (const float*)(p.ws + WS_MODP); const float* bmod = p.in[5];
    { float* mod = (float*)(p.ws + WS_MOD);
      for (int e = bx * NT + tid; e < 5 * 6144; e += G * NT) { const int n = e % 6144; float s = bmod[n];
#pragma unroll
          for (int ks = 0; ks < 16; ++ks) s += modp[(size_t)ks * 5 * 6144 + e];
          mod[e] = s; } }
    LAS float* shv = (LAS float*)lds; LAS float* gsc = (LAS float*)(lds + 4096);
    const float* gpre = p.in[6];
    for (int tile = bx; tile < NROWS / 128; tile += G) {
        const int mr = tile < 256 ? (tile >> 6) : 4;
        __syncthreads();
        for (int col = tid; col < 1024; col += NT) { float sh = bmod[col], sc = bmod[1024 + col];
#pragma unroll
            for (int ks = 0; ks < 16; ++ks) { sh += modp[((size_t)ks * 5 + mr) * 6144 + col]; sc += modp[((size_t)ks * 5 + mr) * 6144 + 1024 + col]; }
            shv[col] = sh; gsc[col] = gpre[col] * (1.0f + sc); }
        __syncthreads();
        for (int rr = wave; rr < 128; rr += 8) {
            const int row = tile * 128 + rr;
            const float* src = (row < NTOK) ? p.in[0] + (size_t)row * DM : p.in[2] + (size_t)(row - NTOK) * DM;
            f32x4 v[4]; float s = 0.f;
#pragma unroll
            for (int j = 0; j < 4; ++j) { v[j] = *(const f32x4*)(src + 4 * lane + 256 * j); s += (v[j].x * v[j].x + v[j].y * v[j].y) + (v[j].z * v[j].z + v[j].w * v[j].w); }
            const float rstd = rsqrtf(wave_sum(s) * (1.0f / DM) + EPS);
            bf16_t* dst = (bf16_t*)(p.ws + WS_XN) + (size_t)row * DM;
#pragma unroll
            for (int j = 0; j < 4; ++j) { const int c = 4 * lane + 256 * j; const f32x4 gs = *(const LAS f32x4*)(gsc + c), sh = *(const LAS f32x4*)(shv + c);
                u32x2 o; o.x = pk2(v[j].x * rstd * gs.x + sh.x, v[j].y * rstd * gs.y + sh.y); o.y = pk2(v[j].z * rstd * gs.z + sh.z, v[j].w * rstd * gs.w + sh.w);
                *(u32x2*)(dst + c) = o; }
        }
    }
    __syncthreads();
}

struct SchedG1 { const unsigned char* ws; int G, c, mult;
    __device__ __forceinline__ bool next(int i, Unit& u) const { int L = i * G + c; if (L >= 1800 * mult) return false; if (mult > 1) L %= 1800;
        if (L < 1792) { u.pm = L / 14; u.pn = L % 14; } else { const int q = L - 1792; u.pm = 128 + (q >> 1); u.pn = q & 1; }
        u.A = (const char*)ws + WS_XN + (size_t)u.pm * 256 * 2048; u.B = (const char*)ws + WS_WIN_T + (size_t)u.pn * 256 * 2048; u.arow = nullptr; u.x0 = 0; u.x1 = 0; return true; } };
struct EpiG1 { static constexpr bool PERM = true; unsigned char* ws;
    __device__ __forceinline__ void operator()(const acc_t& acc, const Unit& u, int wr, int wc, int fr, int fq) const {
        const int pn = u.pn;
        EPI_ROWS(ai, m, rowl)
            const int row = u.pm * 256 + rowl; float ssq = 0.f;
#pragma unroll
            for (int bj = 0; bj < 2; ++bj) {
                const int col = pn * 256 + bj * 128 + wc * 32 + 8 * fq; const f32x4 v0 = acc[ai][bj][m][0], v1 = acc[ai][bj][m][1]; u32x4 o;
                if (pn < 2) {
                    const int g = col >> 4, i0 = col & 15; int crow, k;
                    if (row < NTOK) { crow = row >> 4; k = row & 15; } else { const int rc = row - NTOK; crow = 2048 + (rc >> 8) * 16 + ((rc & 255) >> 4); k = rc & 15; }
                    o.x = pk2(v0.x, v0.y); o.y = pk2(v0.z, v0.w); o.z = pk2(v1.x, v1.y); o.w = pk2(v1.z, v1.w);
                    *(u32x4*)((bf16_t*)(ws + WS_UCAT) + ((size_t)(g * UC_ROWS + crow) * 512 + k * 16 + i0)) = o;
                } else if (pn < 6) {
                    const float g0 = gelu_f(v0.x), g1 = gelu_f(v0.y), g2 = gelu_f(v0.z), g3 = gelu_f(v0.w), g4 = gelu_f(v1.x), g5 = gelu_f(v1.y), g6 = gelu_f(v1.z), g7 = gelu_f(v1.w);
                    o.x = pk2(g0, g1); o.y = pk2(g2, g3); o.z = pk2(g4, g5); o.w = pk2(g6, g7);
                    if (pn < 4) *(u32x4*)((bf16_t*)(ws + WS_GU) + (size_t)row * 512 + (col - 512)) = o;
                    else { *(u32x4*)((bf16_t*)(ws + WS_GV) + (size_t)row * 512 + (col - 1024)) = o; ssq += (g0 * g0 + g1 * g1) + (g2 * g2 + g3 * g3) + (g4 * g4 + g5 * g5) + (g6 * g6 + g7 * g7); }
                } else {
                    o.x = pk2(sigmoid_f(v0.x), sigmoid_f(v0.y)); o.y = pk2(sigmoid_f(v0.z), sigmoid_f(v0.w)); o.z = pk2(sigmoid_f(v1.x), sigmoid_f(v1.y)); o.w = pk2(sigmoid_f(v1.z), sigmoid_f(v1.w));
                    if (pn < 10) *(u32x4*)((bf16_t*)(ws + WS_SG5) + (size_t)row * 1024 + (col - 1536)) = o;
                    else *(u32x4*)((bf16_t*)(ws + WS_SGS) + (size_t)row * 1024 + (col - 2560)) = o;
                }
            }
            if (pn == 4 || pn == 5) { ssq += __shfl_xor(ssq, 16); ssq += __shfl_xor(ssq, 32); if (fq == 0) ((float*)(ws + WS_SSQV))[(size_t)row * 8 + (pn - 4) * 4 + wc] = ssq; }
        EPI_END
    } };
struct SchedG2 { const unsigned char* ws; int G, c, mult;
    __device__ __forceinline__ bool next(int i, Unit& u) const { int L = i * G + c; if (L >= 288 * mult) return false; if (mult > 1) L %= 288; const int g = L / 9; u.pm = L % 9; u.pn = 0; u.x0 = g; u.x1 = 0; u.arow = nullptr;
        u.A = (const char*)ws + WS_UCAT + ((size_t)g * UC_ROWS + (size_t)u.pm * 256) * 1024; u.B = (const char*)ws + WS_WEND_T + (size_t)g * 256 * 512; return true; } };
struct EpiG2 { static constexpr bool PERM = false; unsigned char* ws;
    __device__ __forceinline__ void operator()(const acc_t& acc, const Unit& u, int wr, int wc, int fr, int fq) const {
        float* Eo = (float*)(ws + WS_E) + (size_t)u.x0 * UC_ROWS * 256;
        EPI_ROWS(ai, m, rowl)
            float* rp = Eo + (size_t)(u.pm * 256 + rowl) * 256 + wc * 32 + 4 * fq;
#pragma unroll
            for (int bj = 0; bj < 2; ++bj)
#pragma unroll
                for (int n = 0; n < 2; ++n) *(f32x4*)(rp + bj * 128 + n * 16) = acc[ai][bj][m][n];
        EPI_END
    } };
struct SchedG3 { const unsigned char* ws; int G, c, mult;
    __device__ __forceinline__ bool next(int i, Unit& u) const { int L = i * G + c; if (L >= 256 * mult) return false; if (mult > 1) L %= 256; const int g = L >> 3; u.pm = L & 7; u.pn = 0; u.x0 = g; u.x1 = 0; u.arow = nullptr;
        u.A = (const char*)ws + WS_UCAT + ((size_t)g * UC_ROWS + (size_t)u.pm * 256) * 1024; u.B = (const char*)ws + WS_BCAT_T + (size_t)g * 256 * 1024; return true; } };
struct EpiG3 { static constexpr bool PERM = true; unsigned char* ws;
    __device__ __forceinline__ void operator()(const acc_t& acc, const Unit& u, int wr, int wc, int fr, int fq) const {
        bf16_t* ys = (bf16_t*)(ws + WS_YS);
        EPI_ROWS(ai, m, rowl)
            const int crow = u.pm * 256 + rowl;
#pragma unroll
            for (int bj = 0; bj < 2; ++bj) { const int col = bj * 128 + wc * 32 + 8 * fq; const f32x4 v0 = acc[ai][bj][m][0], v1 = acc[ai][bj][m][1]; u32x4 o;
                o.x = pk2(gelu_f(v0.x), gelu_f(v0.y)); o.y = pk2(gelu_f(v0.z), gelu_f(v0.w)); o.z = pk2(gelu_f(v1.x), gelu_f(v1.y)); o.w = pk2(gelu_f(v1.z), gelu_f(v1.w));
                *(u32x4*)(ys + ((size_t)crow * 16 + (col >> 4)) * 512 + u.x0 * 16 + (col & 15)) = o; }
        EPI_END
    } };
struct SchedG4 { const unsigned char* ws; int G, c, mult;
    __device__ __forceinline__ bool next(int i, Unit& u) const { int L = i * G + c; if (L >= 256 * mult) return false; if (mult > 1) L %= 256; u.pm = L >> 1; u.pn = L & 1; u.x0 = 0; u.x1 = 0; u.arow = nullptr;
        u.A = (const char*)ws + WS_YS + (size_t)u.pm * 256 * 1024; u.B = (const char*)ws + WS_WGLU_T + (size_t)u.pn * 256 * 1024; return true; } };
struct EpiG4 { static constexpr bool PERM = true; unsigned char* ws; const float* bglu;
    __device__ __forceinline__ void operator()(const acc_t& acc, const Unit& u, int wr, int wc, int fr, int fq) const {
        const int colb = u.pn * 256 + wc * 32 + 8 * fq;
        const f32x4 b00 = *(const f32x4*)(bglu + colb), b01 = *(const f32x4*)(bglu + colb + 4), b10 = *(const f32x4*)(bglu + colb + 128), b11 = *(const f32x4*)(bglu + colb + 132);
#pragma unroll
        for (int ai = 0; ai < 2; ++ai) {
            u32x4 y[4][2];
#pragma unroll
            for (int m = 0; m < 4; ++m)
#pragma unroll
                for (int bj = 0; bj < 2; ++bj) y[m][bj] = *(const u32x4*)((const bf16_t*)(ws + WS_YS) + ((size_t)u.pm * 256 + ai * 128 + wr * 64 + m * 16 + fr) * 512 + colb + bj * 128);
#pragma unroll
            for (int m = 0; m < 4; ++m)
#pragma unroll
                for (int bj = 0; bj < 2; ++bj) { const f32x4 v0 = acc[ai][bj][m][0], v1 = acc[ai][bj][m][1]; const f32x4 b0 = bj ? b10 : b00, b1 = bj ? b11 : b01; const u32x4 yy = y[m][bj]; u32x4 o;
                    o.x = pk2(bflo(yy.x) * sigmoid_f(v0.x + b0.x), bfhi(yy.x) * sigmoid_f(v0.y + b0.y)); o.y = pk2(bflo(yy.y) * sigmoid_f(v0.z + b0.z), bfhi(yy.y) * sigmoid_f(v0.w + b0.w));
                    o.z = pk2(bflo(yy.z) * sigmoid_f(v1.x + b1.x), bfhi(yy.z) * sigmoid_f(v1.y + b1.y)); o.w = pk2(bflo(yy.w) * sigmoid_f(v1.z + b1.z), bfhi(yy.w) * sigmoid_f(v1.w + b1.w));
                    *(u32x4*)((bf16_t*)(ws + WS_YS5) + ((size_t)u.pm * 256 + ai * 128 + wr * 64 + m * 16 + fr) * 512 + colb + bj * 128) = o; }
        }
    } };
struct SchedG5 { const unsigned char* ws; int G, c, mult;
    __device__ __forceinline__ bool next(int i, Unit& u) const { int tile = (i >> 1) * G + c; if (tile >= 512 * mult) return false; if (mult > 1) tile %= 512; const int which = i & 1; u.pm = tile >> 2; u.pn = tile & 3; u.x0 = which; u.x1 = 0; u.arow = nullptr;
        u.A = (const char*)ws + (which ? WS_YSGU : WS_YS5) + (size_t)u.pm * 256 * 1024; u.B = (const char*)ws + (which ? WS_WBS_T : WS_WB5_T) + (size_t)u.pn * 256 * 1024; return true; } };
struct EpiG5 { static constexpr bool PERM = true; unsigned char* ws;
    __device__ __forceinline__ void operator()(const acc_t& acc, const Unit& u, int wr, int wc, int fr, int fq) const {
        const bf16_t* gate = (const bf16_t*)(ws + (u.x0 ? WS_SGS : WS_SG5)); bf16_t* mg = (bf16_t*)(ws + WS_MERGED);
        const int colb = u.pn * 256 + wc * 32 + 8 * fq;
#pragma unroll
        for (int ai = 0; ai < 2; ++ai) {
            u32x4 sg[4][2], q[4][2];
#pragma unroll
            for (int m = 0; m < 4; ++m)
#pragma unroll
                for (int bj = 0; bj < 2; ++bj) { const size_t off = ((size_t)u.pm * 256 + ai * 128 + wr * 64 + m * 16 + fr) * 1024 + colb + bj * 128;
                    sg[m][bj] = *(const u32x4*)(gate + off); q[m][bj] = u.x0 ? *(const u32x4*)(mg + off) : (u32x4){0u, 0u, 0u, 0u}; }
#pragma unroll
            for (int m = 0; m < 4; ++m)
#pragma unroll
                for (int bj = 0; bj < 2; ++bj) { const size_t off = ((size_t)u.pm * 256 + ai * 128 + wr * 64 + m * 16 + fr) * 1024 + colb + bj * 128;
                    const f32x4 v0 = acc[ai][bj][m][0], v1 = acc[ai][bj][m][1]; const u32x4 g = sg[m][bj], qq = q[m][bj]; u32x4 o;
                    o.x = pk2(v0.x * bflo(g.x) + bflo(qq.x), v0.y * bfhi(g.x) + bfhi(qq.x)); o.y = pk2(v0.z * bflo(g.y) + bflo(qq.y), v0.w * bfhi(g.y) + bfhi(qq.y));
                    o.z = pk2(v1.x * bflo(g.z) + bflo(qq.z), v1.y * bfhi(g.z) + bfhi(qq.z)); o.w = pk2(v1.z * bflo(g.w) + bflo(qq.w), v1.w * bfhi(g.w) + bfhi(qq.w));
                    *(u32x4*)(mg + off) = o; }
        }
    } };
struct SchedG6 { const unsigned char* ws; int G, c, mult;
    __device__ __forceinline__ bool next(int i, Unit& u) const { int L = i * G + c; if (L >= 512 * mult) return false; if (mult > 1) L %= 512; u.pm = L >> 2; u.pn = L & 3; u.x0 = 0; u.x1 = 0; u.arow = nullptr;
        u.A = (const char*)ws + WS_MERGED + (size_t)u.pm * 256 * 2048; u.B = (const char*)ws + WS_WOUT_T + (size_t)u.pn * 256 * 2048; return true; } };
struct EpiG6 { static constexpr bool PERM = true; unsigned char* ws;
    __device__ __forceinline__ void operator()(const acc_t& acc, const Unit& u, int wr, int wc, int fr, int fq) const {
        EPI_ROWS(ai, m, rowl)
            const size_t row = (size_t)u.pm * 256 + rowl; float ssq = 0.f;
#pragma unroll
            for (int bj = 0; bj < 2; ++bj) { const int col = u.pn * 256 + bj * 128 + wc * 32 + 8 * fq; const f32x4 v0 = acc[ai][bj][m][0], v1 = acc[ai][bj][m][1]; u32x4 o;
                o.x = pk2(v0.x, v0.y); o.y = pk2(v0.z, v0.w); o.z = pk2(v1.x, v1.y); o.w = pk2(v1.z, v1.w);
                ssq += (v0.x * v0.x + v0.y * v0.y) + (v0.z * v0.z + v0.w * v0.w) + (v1.x * v1.x + v1.y * v1.y) + (v1.z * v1.z + v1.w * v1.w);
                *(u32x4*)((bf16_t*)(ws + WS_MX) + row * 1024 + col) = o; }
            ssq += __shfl_xor(ssq, 16); ssq += __shfl_xor(ssq, 32); if (fq == 0) ((float*)(ws + WS_SSQM))[row * 16 + u.pn * 4 + wc] = ssq;
        EPI_END
    } };
struct SchedG7 { const unsigned char* ws; int G, c, mult;
    __device__ __forceinline__ bool next(int i, Unit& u) const { int L = i * G + c; if (L >= 128 * mult) return false; if (mult > 1) L %= 128; u.pm = L; u.pn = 0; u.x0 = 0; u.x1 = 0; u.arow = nullptr;
        u.A = (const char*)ws + WS_XN + (size_t)u.pm * 256 * 2048; u.B = (const char*)ws + WS_WR_T; return true; } };
struct EpiG7 { static constexpr bool PERM = false; unsigned char* ws;
    __device__ __forceinline__ void operator()(const acc_t& acc, const Unit& u, int wr, int wc, int fr, int fq) const {
        EPI_ROWS(ai, m, rowl)
            float* rp = (float*)(ws + WS_LOGITS) + ((size_t)u.pm * 256 + rowl) * 256 + wc * 32 + 4 * fq;
#pragma unroll
            for (int bj = 0; bj < 2; ++bj)
#pragma unroll
                for (int n = 0; n < 2; ++n) *(f32x4*)(rp + bj * 128 + n * 16) = acc[ai][bj][m][n];
        EPI_END
    } };
struct SchedG8 { const unsigned char* ws; int G, c, mult;
    __device__ __forceinline__ bool next(int i, Unit& u) const { const int* te = (const int*)(ws + WS_TILEEXP); const int ntile = te[1500]; int L = i * G + c; if (L >= ntile * 2 * mult) return false; if (mult > 1) L %= ntile * 2;
        const int t = L >> 1; u.pm = t; u.pn = L & 1; const int e = te[t]; u.x0 = e; u.x1 = 0; u.arow = (const int*)(ws + WS_TOKSLOT) + (size_t)t * 256;
        u.A = (const char*)ws + WS_XN; u.B = (const char*)ws + WS_WGU_T + ((size_t)e * 512 + (size_t)u.pn * 256) * 2048; return true; } };
struct EpiG8 { static constexpr bool PERM = true; unsigned char* ws;
    __device__ __forceinline__ void operator()(const acc_t& acc, const Unit& u, int wr, int wc, int fr, int fq) const {
        EPI_ROWS(ai, m, rowl)
            const size_t slot = (size_t)u.pm * 256 + rowl; const int col = u.pn * 128 + wc * 32 + 8 * fq;
            const f32x4 g0 = acc[ai][0][m][0], g1 = acc[ai][0][m][1], u0 = acc[ai][1][m][0], u1 = acc[ai][1][m][1]; u32x4 o;
            o.x = pk2(silu_f(g0.x) * u0.x, silu_f(g0.y) * u0.y); o.y = pk2(silu_f(g0.z) * u0.z, silu_f(g0.w) * u0.w);
            o.z = pk2(silu_f(g1.x) * u1.x, silu_f(g1.y) * u1.y); o.w = pk2(silu_f(g1.z) * u1.z, silu_f(g1.w) * u1.w);
            *(u32x4*)((bf16_t*)(ws + WS_H) + slot * 256 + col) = o;
        EPI_END
    } };
struct SchedG9 { const unsigned char* ws; int G, c, hf, mult;
    __device__ __forceinline__ bool next(int i, Unit& u) const { const int* te = (const int*)(ws + WS_TILEEXP); const int ntr = te[1500] - 128; int L = i * G + c; if (L >= ntr * 2 * mult) return false; if (mult > 1) L %= ntr * 2;
        const int t = L >> 1; u.pm = t; u.pn = L & 1; const int e = te[t]; u.x0 = e; u.x1 = 0; u.arow = nullptr;
        u.A = (const char*)ws + WS_H + (size_t)t * 256 * 512; u.B = (const char*)ws + WS_WD_T + ((size_t)e * 1024 + (size_t)(hf * 2 + u.pn) * 256) * 512; return true; } };
struct EpiG9 { static constexpr bool PERM = true; unsigned char* ws;
    __device__ __forceinline__ void operator()(const acc_t& acc, const Unit& u, int wr, int wc, int fr, int fq) const {
        EPI_ROWS(ai, m, rowl)
            const size_t slot = (size_t)u.pm * 256 + rowl;
            bf16_t* yp = (bf16_t*)(ws + WS_YSLOT) + slot * 512 + u.pn * 256 + wc * 32 + 8 * fq;
#pragma unroll
            for (int bj = 0; bj < 2; ++bj) { const f32x4 v0 = acc[ai][bj][m][0], v1 = acc[ai][bj][m][1]; u32x4 o;
                o.x = pk2(v0.x, v0.y); o.y = pk2(v0.z, v0.w); o.z = pk2(v1.x, v1.y); o.w = pk2(v1.z, v1.w);
                *(u32x4*)(yp + bj * 128) = o; }
        EPI_END
    } };
struct SchedG10 { const unsigned char* ws; int G, c, mult;
    __device__ __forceinline__ bool next(int i, Unit& u) const { const int* te = (const int*)(ws + WS_TILEEXP); const int ntr = te[1500] - 128; int L = i * G + c; if (L >= 512 * mult) return false; if (mult > 1) L %= 512;
        const int t = L >> 2; u.pm = t; u.pn = L & 3; u.x0 = ntr; u.x1 = 0; u.arow = nullptr;
        u.A = (const char*)ws + WS_H + (size_t)(ntr + t) * 256 * 512; u.B = (const char*)ws + WS_WD_T + ((size_t)NEXP * 1024 + (size_t)u.pn * 256) * 512; return true; } };
struct EpiG10 { static constexpr bool PERM = true; float* out;
    __device__ __forceinline__ void operator()(const acc_t& acc, const Unit& u, int wr, int wc, int fr, int fq) const {
        EPI_ROWS(ai, m, rowl)
            float* dp = out + ((size_t)u.pm * 256 + rowl) * 1024 + u.pn * 256 + wc * 32 + 8 * fq;
            *(f32x4*)dp = acc[ai][0][m][0]; *(f32x4*)(dp + 4) = acc[ai][0][m][1]; *(f32x4*)(dp + 128) = acc[ai][1][m][0]; *(f32x4*)(dp + 132) = acc[ai][1][m][1];
        EPI_END
    } };

__device__ __forceinline__ void phase_sgu(const Params& p, ldsp_t lds) {
    const int tid = threadIdx.x, lane = tid & 63, wave = tid >> 6, fr = lane & 15, fq = lane >> 4, G = gridDim.x;
    constexpr int PITCH = 272;
    ldsp_t Wl = lds; ldsp_t VT = lds + 128 * PITCH; LAS float* rs = (LAS float*)(lds + 128 * PITCH + 64 * PITCH);
    const bf16_t* sguw = (const bf16_t*)(p.ws + WS_SGUW); const bf16_t* gv = (const bf16_t*)(p.ws + WS_GV); const bf16_t* gu = (const bf16_t*)(p.ws + WS_GU);
    const float* ssq = (const float*)(p.ws + WS_SSQV); const float* gn = p.in[21]; const float* bs = p.in[23];
    bf16_t* yo = (bf16_t*)(p.ws + WS_YSGU);
    for (int it = blockIdx.x; it < 2048; it += G) {
        const int chunk = it & 255, h = it >> 8; const size_t tok0 = (size_t)chunk * 128;
        __syncthreads();
        if (tid < 128) { const float* q = ssq + (tok0 + tid) * 8; const f32x4 a = *(const f32x4*)q, b = *(const f32x4*)(q + 4);
            rs[tid] = rsqrtf(((a.x + a.y) + (a.z + a.w) + (b.x + b.y) + (b.z + b.w)) * (1.0f / 512.0f) + EPS); }
#pragma unroll
        for (int i = 0; i < 4; ++i) { const int pc = tid + i * NT, row = pc >> 4, cp = pc & 15;
            *(LAS u32x4*)(Wl + row * PITCH + cp * 16) = *(const u32x4*)(sguw + ((size_t)h * 128 + row) * 128 + cp * 8); }
        __syncthreads();
#pragma unroll
        for (int i = 0; i < 2; ++i) { const int pc = tid + i * NT, s = pc >> 3, c8 = (pc & 7) * 8; const float r = rs[s];
            const u32x4 v = *(const u32x4*)(gv + (tok0 + s) * 512 + h * 64 + c8);
            LAS bf16_t* d = (LAS bf16_t*)(VT + c8 * PITCH + s * 2);
            d[0 * (PITCH / 2)] = (bf16_t)f2bf(bflo(v.x) * r); d[1 * (PITCH / 2)] = (bf16_t)f2bf(bfhi(v.x) * r); d[2 * (PITCH / 2)] = (bf16_t)f2bf(bflo(v.y) * r); d[3 * (PITCH / 2)] = (bf16_t)f2bf(bfhi(v.y) * r);
            d[4 * (PITCH / 2)] = (bf16_t)f2bf(bflo(v.z) * r); d[5 * (PITCH / 2)] = (bf16_t)f2bf(bfhi(v.z) * r); d[6 * (PITCH / 2)] = (bf16_t)f2bf(bflo(v.w) * r); d[7 * (PITCH / 2)] = (bf16_t)f2bf(bfhi(v.w) * r); }
        __syncthreads();
        f32x4 acc[4] = {(f32x4){0.f, 0.f, 0.f, 0.f}, (f32x4){0.f, 0.f, 0.f, 0.f}, (f32x4){0.f, 0.f, 0.f, 0.f}, (f32x4){0.f, 0.f, 0.f, 0.f}};
        const int t0 = wave * 16;
#pragma unroll
        for (int ks = 0; ks < 4; ++ks) {
            const bf16x8 bfr = *(const LAS bf16x8*)(Wl + (t0 + fr) * PITCH + (ks * 32 + 8 * fq) * 2);
#pragma unroll
            for (int mb = 0; mb < 4; ++mb) { const bf16x8 afr = *(const LAS bf16x8*)(VT + (mb * 16 + fr) * PITCH + (ks * 32 + 8 * fq) * 2);
                acc[mb] = __builtin_amdgcn_mfma_f32_16x16x32_bf16(afr, bfr, acc[mb], 0, 0, 0); }
        }
        const int t = t0 + fr; const float bt = bs[h * 128 + t];
#pragma unroll
        for (int mb = 0; mb < 4; ++mb) { const int c = h * 64 + mb * 16 + 4 * fq; const f32x4 gg = *(const f32x4*)(gn + c);
            const u32x2 uu = *(const u32x2*)(gu + (tok0 + t) * 512 + c); u32x2 o;
            o.x = pk2(bflo(uu.x) * (acc[mb].x * gg.x + bt), bfhi(uu.x) * (acc[mb].y * gg.y + bt)); o.y = pk2(bflo(uu.y) * (acc[mb].z * gg.z + bt), bfhi(uu.y) * (acc[mb].w * gg.w + bt));
            *(u32x2*)(yo + (tok0 + t) * 512 + c) = o; }
    }
    __syncthreads();
}

__device__ __forceinline__ size_t carry_row(int b, int d, int q) { return (q < 16) ? (size_t)(2048 + b * 16 + (d ? 15 - q : q)) : (size_t)(b * 512 + (d ? 511 - (q - 16) : (q - 16))); }
__device__ __forceinline__ void phase_carry(const Params& p, ldsp_t lds) {
    const int tid = threadIdx.x, lane = tid & 63, wave = tid >> 6, G = gridDim.x;
    const float* APL = (const float*)(p.ws + WS_APL);
    LAS f32x2* seg = (LAS f32x2*)lds;
    for (int s = blockIdx.x; s < 256; s += G) {
        const int d = s & 1, g = (s >> 1) & 31, b = s >> 6;
        const float ar = APL[((d * 32 + g) * 64 + lane) * 2], ai = APL[((d * 32 + g) * 64 + lane) * 2 + 1];
        const float* Eg = (const float*)(p.ws + WS_E) + (size_t)g * UC_ROWS * 256 + d * 128 + lane;
        bf16_t* Ug = (bf16_t*)(p.ws + WS_UCAT) + (size_t)g * UC_ROWS * 512 + 256 + d * 128 + lane;
        const int q0 = wave * 66;
        float cr = 0.f, ci = 0.f;
#pragma unroll 1
        for (int j0 = 0; j0 < 66; j0 += 11) {
            float er[11], ei[11];
#pragma unroll
            for (int j = 0; j < 11; ++j) { const size_t row = carry_row(b, d, q0 + j0 + j); er[j] = Eg[row * 256]; ei[j] = Eg[row * 256 + 64]; }
#pragma unroll
            for (int j = 0; j < 11; ++j) { const float nr = ar * cr - ai * ci + er[j], ni = ar * ci + ai * cr + ei[j]; cr = nr; ci = ni; }
        }
        __syncthreads();
        seg[wave * 64 + lane] = (f32x2){cr, ci};
        __syncthreads();
        float p2r = ar * ar - ai * ai, p2i = 2.f * ar * ai, pr = p2r, pi = p2i;
#pragma unroll
        for (int k = 0; k < 5; ++k) { const float nr = pr * pr - pi * pi, ni = 2.f * pr * pi; pr = nr; pi = ni; }
        const float Ar = pr * p2r - pi * p2i, Ai = pr * p2i + pi * p2r;
        cr = 0.f; ci = 0.f;
        for (int w = 0; w < wave; ++w) { const f32x2 e = seg[w * 64 + lane]; const float nr = Ar * cr - Ai * ci + e.x, ni = Ar * ci + Ai * cr + e.y; cr = nr; ci = ni; }
#pragma unroll 1
        for (int j0 = 0; j0 < 66; j0 += 11) {
            float er[11], ei[11];
#pragma unroll
            for (int j = 0; j < 11; ++j) { const size_t row = carry_row(b, d, q0 + j0 + j); er[j] = Eg[row * 256]; ei[j] = Eg[row * 256 + 64]; }
#pragma unroll
            for (int j = 0; j < 11; ++j) { const int q = q0 + j0 + j;
                if (q >= 16) { const size_t row = carry_row(b, d, q); Ug[row * 512] = (bf16_t)f2bf(cr); Ug[row * 512 + 64] = (bf16_t)f2bf(ci); }
                const float nr = ar * cr - ai * ci + er[j], ni = ar * ci + ai * cr + ei[j]; cr = nr; ci = ni; }
        }
    }
    __syncthreads();
}

__device__ __forceinline__ void phase_r1(const Params& p) {
    const int tid = threadIdx.x, lane = tid & 63, wave = tid >> 6, G = gridDim.x;
    const float* mod = (const float*)(p.ws + WS_MOD); const float* gpm = p.in[7]; const float* gpf = p.in[8];
    for (int row = blockIdx.x * 8 + wave; row < NTOK; row += G * 8) {
        const int b = row >> 13; const float* mb = mod + (size_t)b * 6144;
        const float* sq = (const float*)(p.ws + WS_SSQM) + (size_t)row * 16; float s0 = 0.f;
#pragma unroll
        for (int j = 0; j < 4; ++j) { const f32x4 q = *(const f32x4*)(sq + 4 * j); s0 += (q.x + q.y) + (q.z + q.w); }
        const float rm = rsqrtf(s0 * (1.0f / DM) + EPS);
        f32x4 x1[4]; float s = 0.f;
#pragma unroll
        for (int j = 0; j < 4; ++j) { const int c = 4 * lane + 256 * j; const f32x4 xv = *(const f32x4*)(p.in[0] + (size_t)row * DM + c);
            const u32x2 mv = *(const u32x2*)((const bf16_t*)(p.ws + WS_MX) + (size_t)row * DM + c); const f32x4 gt = *(const f32x4*)(mb + 2048 + c), gg = *(const f32x4*)(gpm + c);
            x1[j].x = xv.x + gt.x * (bflo(mv.x) * rm * gg.x); x1[j].y = xv.y + gt.y * (bfhi(mv.x) * rm * gg.y); x1[j].z = xv.z + gt.z * (bflo(mv.y) * rm * gg.z); x1[j].w = xv.w + gt.w * (bfhi(mv.y) * rm * gg.w);
            s += (x1[j].x * x1[j].x + x1[j].y * x1[j].y) + (x1[j].z * x1[j].z + x1[j].w * x1[j].w); }
        const float r1 = rsqrtf(wave_sum(s) * (1.0f / DM) + EPS);
        bf16_t* dst = (bf16_t*)(p.ws + WS_XN) + (size_t)row * DM;
#pragma unroll
        for (int j = 0; j < 4; ++j) { const int c = 4 * lane + 256 * j; const f32x4 gg = *(const f32x4*)(gpf + c), sh = *(const f32x4*)(mb + 3072 + c), sc = *(const f32x4*)(mb + 4096 + c); u32x2 o;
            o.x = pk2(x1[j].x * r1 * gg.x * (1.f + sc.x) + sh.x, x1[j].y * r1 * gg.y * (1.f + sc.y) + sh.y); o.y = pk2(x1[j].z * r1 * gg.z * (1.f + sc.z) + sh.z, x1[j].w * r1 * gg.w * (1.f + sc.w) + sh.w);
            *(u32x2*)(dst + c) = o; }
    }
}

__device__ __forceinline__ void phase_route(const Params& p, ldsp_t lds) {
    const int tid = threadIdx.x, lane = tid & 63, wave = tid >> 6, G = gridDim.x;
    LAS int* hist = (LAS int*)lds;
    const float* rb = p.in[28]; const f32x4 bias = *(const f32x4*)(rb + 4 * lane);
    for (int tile = blockIdx.x; tile < 256; tile += G) {
        __syncthreads();
        if (tid < 256) hist[tid] = 0;
        __syncthreads();
        for (int rr = wave * 16; rr < wave * 16 + 16; rr += 2) {
            float sc[2][4], sel[2][4];
#pragma unroll
            for (int t = 0; t < 2; ++t) { const int row = tile * 128 + rr + t;
                const f32x4 lg = *(const f32x4*)((const float*)(p.ws + WS_LOGITS) + (size_t)row * 256 + 4 * lane);
                sc[t][0] = sigmoid_f(lg.x); sc[t][1] = sigmoid_f(lg.y); sc[t][2] = sigmoid_f(lg.z); sc[t][3] = sigmoid_f(lg.w);
                sel[t][0] = sc[t][0] + bias.x; sel[t][1] = sc[t][1] + bias.y; sel[t][2] = sc[t][2] + bias.z; sel[t][3] = sc[t][3] + bias.w; }
#pragma unroll
            for (int t = 0; t < 2; ++t) {
                float m1 = fmaxf(sel[t][0], sel[t][1]), m2 = fminf(sel[t][0], sel[t][1]);
                { const float a = fmaxf(sel[t][2], sel[t][3]), bb = fminf(sel[t][2], sel[t][3]); const float n1 = fmaxf(m1, a); const float n2 = fmaxf(fminf(m1, a), fmaxf(m2, bb)); m1 = n1; m2 = n2; }
                { const float a = dpp_f<0xB1>(m1, m1), bb = dpp_f<0xB1>(m2, m2); const float n1 = fmaxf(m1, a); const float n2 = fmaxf(fminf(m1, a), fmaxf(m2, bb)); m1 = n1; m2 = n2; }
                { const float a = dpp_f<0x4E>(m1, m1), bb = dpp_f<0x4E>(m2, m2); const float n1 = fmaxf(m1, a); const float n2 = fmaxf(fminf(m1, a), fmaxf(m2, bb)); m1 = n1; m2 = n2; }
                { const float a = dpp_f<0x114>(-__builtin_inff(), m1), bb = dpp_f<0x114>(-__builtin_inff(), m2); const float n1 = fmaxf(m1, a); const float n2 = fmaxf(fminf(m1, a), fmaxf(m2, bb)); m1 = n1; m2 = n2; }
                const float gsv = m1 + m2; float gs[8];
#pragma unroll
                for (int g2 = 0; g2 < 8; ++g2) gs[g2] = __builtin_bit_cast(float, __builtin_amdgcn_readlane(__builtin_bit_cast(int, gsv), 8 * g2 + 7));
                unsigned gmask = 0u;
#pragma unroll
                for (int g1 = 0; g1 < 8; ++g1) { int rank = 0;
#pragma unroll
                    for (int g2 = 0; g2 < 8; ++g2) rank += (gs[g2] > gs[g1] || (gs[g2] == gs[g1] && g2 < g1)) ? 1 : 0;
                    gmask |= (rank < 4) ? (1u << g1) : 0u; }
                if (!((gmask >> (lane >> 3)) & 1u)) { sel[t][0] = -__builtin_inff(); sel[t][1] = -__builtin_inff(); sel[t][2] = -__builtin_inff(); sel[t][3] = -__builtin_inff(); }
            }
            float wk[2] = {0.f, 0.f}, wsum[2] = {0.f, 0.f}; int ek[2] = {0, 0};
#pragma unroll 1
            for (int k = 0; k < 8; ++k) {
#pragma unroll
                for (int t = 0; t < 2; ++t) {
                    const float bv = fmaxf(fmaxf(sel[t][0], sel[t][1]), fmaxf(sel[t][2], sel[t][3]));
                    const int j = (sel[t][0] == bv) ? 0 : (sel[t][1] == bv) ? 1 : (sel[t][2] == bv) ? 2 : 3;
                    const float s_c = (j == 0) ? sc[t][0] : (j == 1) ? sc[t][1] : (j == 2) ? sc[t][2] : sc[t][3];
                    const float v = wave_max_dpp(bv);
                    const unsigned long long bal = __ballot(bv == v);
                    const int wl = __builtin_amdgcn_readfirstlane(__builtin_ctzll(bal));
                    const float s_w = __builtin_bit_cast(float, __builtin_amdgcn_readlane(__builtin_bit_cast(int, s_c), wl));
                    const int e_w = 4 * wl + __builtin_amdgcn_readlane(j, wl);
                    if (lane == wl) { if (j == 0) sel[t][0] = -__builtin_inff(); else if (j == 1) sel[t][1] = -__builtin_inff(); else if (j == 2) sel[t][2] = -__builtin_inff(); else sel[t][3] = -__builtin_inff(); }
                    wsum[t] += s_w; if (lane == k) { wk[t] = s_w; ek[t] = e_w; }
                }
            }
#pragma unroll
            for (int t = 0; t < 2; ++t) if (lane < 8) { const int row = tile * 128 + rr + t; const float w = wk[t] / wsum[t] * 2.5f;
                ((int*)(p.ws + WS_IDX))[(size_t)row * 8 + lane] = ek[t]; ((float*)(p.ws + WS_WT))[(size_t)row * 8 + lane] = w; __hip_atomic_fetch_add(&hist[ek[t]], 1, __ATOMIC_RELAXED, __HIP_MEMORY_SCOPE_WORKGROUP); }
        }
        __syncthreads();
        if (tid < 256) ((int*)(p.ws + WS_BLKCNT))[tile * 256 + tid] = hist[tid];
    }
    __syncthreads();
}
__device__ __forceinline__ void phase_scan(const Params& p, ldsp_t lds) {
    const int tid = threadIdx.x, G = gridDim.x; LAS int* sm = (LAS int*)lds;
    for (int e = blockIdx.x; e < 256; e += G) {
        __syncthreads();
        int v = 0; if (tid < 256) { v = ((const int*)(p.ws + WS_BLKCNT))[tid * 256 + e]; sm[tid] = v; }
        __syncthreads();
        for (int o = 1; o < 256; o <<= 1) { int t = 0; if (tid < 256 && tid >= o) t = sm[tid - o]; __syncthreads(); if (tid < 256) sm[tid] += t; __syncthreads(); }
        if (tid < 256) { ((int*)(p.ws + WS_BLKOFF))[tid * 256 + e] = sm[tid] - v; if (tid == 255) ((int*)(p.ws + WS_TOTAL))[e] = sm[255]; }
    }
    __syncthreads();
}
__device__ __forceinline__ void phase_scatter(const Params& p, ldsp_t lds) {
    const int tid = threadIdx.x, G = gridDim.x; LAS int* pst = (LAS int*)lds; LAS int* cnt = (LAS int*)(lds + 2048); LAS int* tot = (LAS int*)(lds + 4096);
    int* tokslot = (int*)(p.ws + WS_TOKSLOT); float* wslot = (float*)(p.ws + WS_WSLOT); int* te = (int*)(p.ws + WS_TILEEXP);
    int mytot = 0, mypad = 0;
    if (tid < 256) { mytot = ((const int*)(p.ws + WS_TOTAL))[tid]; mypad = (mytot + 255) & ~255; pst[tid] = mypad; tot[tid] = mytot; }
    __syncthreads();
    for (int o = 1; o < 256; o <<= 1) { int t = 0; if (tid < 256 && tid >= o) t = pst[tid - o]; __syncthreads(); if (tid < 256) pst[tid] += t; __syncthreads(); }
    const int pend_all = pst[255];
    __syncthreads();
    if (tid < 256) pst[tid] -= mypad;
    __syncthreads();
    const int ntr = pend_all >> 8;
    if (blockIdx.x == 0 && tid == 0) te[1500] = ntr + 128;
    for (int e = blockIdx.x; e < 256; e += G) { const int s0 = pst[e], n = tot[e], pe = s0 + ((n + 255) & ~255);
        for (int t = (s0 >> 8) + tid; t < (pe >> 8); t += NT) te[t] = e;
        for (int s = s0 + n + tid; s < pe; s += NT) { tokslot[s] = 0; wslot[s] = 0.f; } }
    for (int t = blockIdx.x * NT + tid; t < NTOK; t += G * NT) { tokslot[pend_all + t] = t; wslot[pend_all + t] = 1.0f; if (t < 128) te[ntr + t] = NEXP; }
    for (int tile = blockIdx.x; tile < 256; tile += G) {
        __syncthreads();
        if (tid < 256) cnt[tid] = 0;
        __syncthreads();
        for (int q = tid; q < 1024; q += NT) { const int row = tile * 128 + (q >> 3), k = q & 7; const int e = ((const int*)(p.ws + WS_IDX))[(size_t)row * 8 + k];
            const int r = __hip_atomic_fetch_add(&cnt[e], 1, __ATOMIC_RELAXED, __HIP_MEMORY_SCOPE_WORKGROUP); const int slot = pst[e] + ((const int*)(p.ws + WS_BLKOFF))[tile * 256 + e] + r;
            tokslot[slot] = row; wslot[slot] = ((const float*)(p.ws + WS_WT))[(size_t)row * 8 + k]; ((int*)(p.ws + WS_SLOT))[(size_t)row * 8 + k] = slot; }
    }
    __syncthreads();
}

__device__ __forceinline__ void phase_r3a(const Params& p) {
    const int tid = threadIdx.x, lane = tid & 63, wave = tid >> 6, G = gridDim.x;
    const bf16_t* ys = (const bf16_t*)(p.ws + WS_YSLOT);
    for (int row = blockIdx.x * 8 + wave; row < NTOK; row += G * 8) {
        const int* sl = (const int*)(p.ws + WS_SLOT) + (size_t)row * 8; const float* wt = (const float*)(p.ws + WS_WT) + (size_t)row * 8; float* dp = p.out + (size_t)row * DM + 8 * lane;
        f32x4 a0 = *(const f32x4*)dp, a1 = *(const f32x4*)(dp + 4);
#pragma unroll
        for (int k = 0; k < 8; ++k) { const u32x4 v = *(const u32x4*)(ys + (size_t)sl[k] * 512 + 8 * lane); const float w = wt[k];
            a0.x += w * bflo(v.x); a0.y += w * bfhi(v.x); a0.z += w * bflo(v.y); a0.w += w * bfhi(v.y); a1.x += w * bflo(v.z); a1.y += w * bfhi(v.z); a1.z += w * bflo(v.w); a1.w += w * bfhi(v.w); }
        *(f32x4*)dp = a0; *(f32x4*)(dp + 4) = a1;
    }
}
__device__ __forceinline__ void phase_r3b(const Params& p) {
    const int tid = threadIdx.x, lane = tid & 63, wave = tid >> 6, G = gridDim.x;
    const bf16_t* ys = (const bf16_t*)(p.ws + WS_YSLOT); const float* mod = (const float*)(p.ws + WS_MOD); const float* gpm = p.in[7]; const float* gpo = p.in[9];
    for (int row = blockIdx.x * 8 + wave; row < NTOK; row += G * 8) {
        const int b = row >> 13; const float* mb = mod + (size_t)b * 6144;
        const int* sl = (const int*)(p.ws + WS_SLOT) + (size_t)row * 8; const float* wt = (const float*)(p.ws + WS_WT) + (size_t)row * 8; float* orow = p.out + (size_t)row * DM;
        f32x4 f0 = *(const f32x4*)(orow + 8 * lane), f1 = *(const f32x4*)(orow + 8 * lane + 4), f2 = *(const f32x4*)(orow + 512 + 8 * lane), f3 = *(const f32x4*)(orow + 512 + 8 * lane + 4);
#pragma unroll
        for (int k = 0; k < 8; ++k) { const u32x4 v = *(const u32x4*)(ys + (size_t)sl[k] * 512 + 8 * lane); const float w = wt[k];
            f2.x += w * bflo(v.x); f2.y += w * bfhi(v.x); f2.z += w * bflo(v.y); f2.w += w * bfhi(v.y); f3.x += w * bflo(v.z); f3.y += w * bfhi(v.z); f3.z += w * bflo(v.w); f3.w += w * bfhi(v.w); }
        float s = (f0.x * f0.x + f0.y * f0.y) + (f0.z * f0.z + f0.w * f0.w) + (f1.x * f1.x + f1.y * f1.y) + (f1.z * f1.z + f1.w * f1.w)
                + (f2.x * f2.x + f2.y * f2.y) + (f2.z * f2.z + f2.w * f2.w) + (f3.x * f3.x + f3.y * f3.y) + (f3.z * f3.z + f3.w * f3.w);
        const float rf = rsqrtf(wave_sum(s) * (1.0f / DM) + EPS);
        const float* sq = (const float*)(p.ws + WS_SSQM) + (size_t)row * 16; float s0 = 0.f;
#pragma unroll
        for (int j = 0; j < 4; ++j) { const f32x4 q = *(const f32x4*)(sq + 4 * j); s0 += (q.x + q.y) + (q.z + q.w); }
        const float rm = rsqrtf(s0 * (1.0f / DM) + EPS);
#pragma unroll
        for (int hh = 0; hh < 2; ++hh) { const int c = hh * 512 + 8 * lane; const f32x4 fa = hh ? f2 : f0, fb = hh ? f3 : f1;
            const f32x4 xa = *(const f32x4*)(p.in[0] + (size_t)row * DM + c), xb = *(const f32x4*)(p.in[0] + (size_t)row * DM + c + 4);
            const u32x4 mv = *(const u32x4*)((const bf16_t*)(p.ws + WS_MX) + (size_t)row * DM + c);
            const f32x4 gma = *(const f32x4*)(mb + 2048 + c), gmb = *(const f32x4*)(mb + 2048 + c + 4), gfa = *(const f32x4*)(mb + 5120 + c), gfb = *(const f32x4*)(mb + 5120 + c + 4);
            const f32x4 pma = *(const f32x4*)(gpm + c), pmb = *(const f32x4*)(gpm + c + 4), poa = *(const f32x4*)(gpo + c), pob = *(const f32x4*)(gpo + c + 4);
            f32x4 oa, ob;
            oa.x = xa.x + gma.x * (bflo(mv.x) * rm * pma.x) + gfa.x * (fa.x * rf * poa.x); oa.y = xa.y + gma.y * (bfhi(mv.x) * rm * pma.y) + gfa.y * (fa.y * rf * poa.y);
            oa.z = xa.z + gma.z * (bflo(mv.y) * rm * pma.z) + gfa.z * (fa.z * rf * poa.z); oa.w = xa.w + gma.w * (bfhi(mv.y) * rm * pma.w) + gfa.w * (fa.w * rf * poa.w);
            ob.x = xb.x + gmb.x * (bflo(mv.z) * rm * pmb.x) + gfb.x * (fb.x * rf * pob.x); ob.y = xb.y + gmb.y * (bfhi(mv.z) * rm * pmb.y) + gfb.y * (fb.y * rf * pob.y);
            ob.z = xb.z + gmb.z * (bflo(mv.w) * rm * pmb.z) + gfb.z * (fb.z * rf * pob.z); ob.w = xb.w + gmb.w * (bfhi(mv.w) * rm * pmb.w) + gfb.w * (fb.w * rf * pob.w);
            *(f32x4*)(orow + c) = oa; *(f32x4*)(orow + c + 4) = ob; }
    }
}

#define XB_TMO      128
#define XB_XCNT(j)  (256  + 64 * (j))
#define XB_XSUB(j)  (1280 + 64 * (j))
#define XB_XGEN(j)  (2304 + 64 * (j))
#define XB_TOP      3328
#define XB_TOPGEN   3392
#define XCD_BAR_WORDS 3456
#define XB_SPIN_CAP (1u << 18)
__device__ __forceinline__ unsigned xb_ld(unsigned* p)              { return __hip_atomic_load(p, __ATOMIC_RELAXED, __HIP_MEMORY_SCOPE_AGENT); }
__device__ __forceinline__ unsigned xb_add(unsigned* p, unsigned v) { return __hip_atomic_fetch_add(p, v, __ATOMIC_RELAXED, __HIP_MEMORY_SCOPE_AGENT); }
__device__ __forceinline__ unsigned xb_xcc_id() { return (unsigned)__builtin_amdgcn_s_getreg((3 << 11) | 20) & 0xFu; }
#define XB_SPIN(cond, bar) do { unsigned _sp = 0; while (cond) { __builtin_amdgcn_s_sleep(1); \
    if ((++_sp & 255u) == 0u) { if (xb_ld(&(bar)[XB_TMO])) break; if (_sp > XB_SPIN_CAP) { atomicAdd(&(bar)[XB_TMO], 1u); break; } } } } while (0)
struct XcdBarrier { unsigned* bar; unsigned x; volatile LAS unsigned* st; };
__device__ __forceinline__ XcdBarrier xcd_barrier_post(unsigned* bar, volatile LAS unsigned* st) {
    XcdBarrier b; b.bar = bar; b.x = xb_xcc_id(); b.st = st;
    if (threadIdx.x == 0) (void)xb_add(&bar[XB_XCNT(b.x)], 1u);
    return b;
}
__device__ __forceinline__ void xcd_barrier_complete(unsigned* bar, unsigned x, unsigned& nloc, unsigned& nx) {
    const unsigned G = gridDim.x * gridDim.y * gridDim.z;
    unsigned sum, cnt, mine, sp = 0u;
    for (;;) {
        sum = 0u; cnt = 0u; mine = 0u;
#pragma unroll
        for (unsigned j = 0; j < 16; ++j) { const unsigned c = xb_ld(&bar[XB_XCNT(j)]); sum += c; cnt += (c > 0u) ? 1u : 0u; mine = (j == x) ? c : mine; }
        if (sum == G) break;
        __builtin_amdgcn_s_sleep(1);
        if ((++sp & 255u) == 0u) { if (xb_ld(&bar[XB_TMO])) break; if (sp > XB_SPIN_CAP) { atomicAdd(&bar[XB_TMO], 1u); break; } }
    }
    nloc = mine > 0u ? mine : 1u; nx = cnt > 0u ? cnt : 1u;
}
__device__ __forceinline__ void xcd_barrier(const XcdBarrier& b) {
    asm volatile("s_waitcnt vmcnt(0)" ::: "memory");
    __syncthreads();
    if (threadIdx.x == 0) {
        unsigned* bar = b.bar;
        __builtin_amdgcn_s_waitcnt(0);
        unsigned nloc = b.st[0], nx = b.st[1];
        if (nloc == 0u) { xcd_barrier_complete(bar, b.x, nloc, nx); b.st[0] = nloc; b.st[1] = nx; }
        const unsigned old = xb_add(&bar[XB_XSUB(b.x)], 1u);
        const unsigned gen = old / nloc;
        if (old + 1u == (gen + 1u) * nloc) {
            __builtin_amdgcn_fence(__ATOMIC_RELEASE, "agent");
            asm volatile("s_waitcnt vmcnt(0)" ::: "memory");
            const unsigned og = xb_add(&bar[XB_TOP], 1u);
            const unsigned tg = og / nx;
            if (og + 1u == (tg + 1u) * nx) xb_add(&bar[XB_TOPGEN], 1u);
            else XB_SPIN(xb_ld(&bar[XB_TOPGEN]) == tg, bar);
            __builtin_amdgcn_fence(__ATOMIC_ACQUIRE, "agent");
            xb_add(&bar[XB_XGEN(b.x)], 1u);
            asm volatile("s_waitcnt vmcnt(0)" ::: "memory");
        } else {
            XB_SPIN(xb_ld(&bar[XB_XGEN(b.x)]) == gen, bar);
            __builtin_amdgcn_fence(__ATOMIC_ACQUIRE, "agent");
            asm volatile("s_waitcnt vmcnt(0)" ::: "memory");
        }
    }
    __syncthreads();
}

constexpr int N_PHASES = 21;
__global__ void __launch_bounds__(NT, 2) fwd_kernel(Params p) {
    extern __shared__ __attribute__((aligned(16))) unsigned char lds_raw[];
    ldsp_t lds = (ldsp_t)lds_raw;
    const int G = gridDim.x, c = blockIdx.x;
    const int lo = p.ph_lo, hi = p.ph_hi;
    volatile LAS unsigned* bst = (volatile LAS unsigned*)(lds + LDS_BYTES - 16);
    if (threadIdx.x < 4) bst[threadIdx.x] = 0u;
    __syncthreads();
    XcdBarrier bar = xcd_barrier_post((unsigned*)p.ws, bst);
    unsigned long long spin_acc = 0;
#ifdef ONLY_PHASE
#define IN(k) ((k) == ONLY_PHASE && lo <= (k) && (k) < hi)
#else
#define IN(k) (lo <= (k) && (k) < hi)
#endif
#define TS_BEGIN(k) unsigned long long ts0_ = 0; if (SPIN_PHASE == (k)) ts0_ = __builtin_amdgcn_s_memrealtime();
#define TS_END(k) if (SPIN_PHASE == (k)) spin_acc += __builtin_amdgcn_s_memrealtime() - ts0_;
#define PH(k, ...) if (IN(k)) { TS_BEGIN(k) const int nrep_ = (DUP_PHASE == (k)) ? (1 + DUP_REPS + lo) : 1; _Pragma("nounroll") for (int r_ = 0; r_ < nrep_; ++r_) { if (r_) xcd_barrier(bar); __VA_ARGS__ } SEAM(k); TS_END(k) }
#define PG(k, ...) if (IN(k)) { TS_BEGIN(k) __VA_ARGS__ SEAM(k); TS_END(k) }
#define MULT(k) ((DUP_PHASE == (k)) ? (1 + DUP_REPS) : 1)
#define SEAM(k) do { if (IN((k) + 1)) { if ((k) == 0) cg::this_grid().sync(); else xcd_barrier(bar); } } while (0)
    PH(0, phase_prep(p, lds);)
    PH(1, phase_xn(p, lds);)
    PG(2, SchedG1 S{p.ws, G, c, MULT(2)}; EpiG1 E{p.ws}; pg8::gemm_phase<EpiG1, SchedG1, false>(lds, 1024, 2048u, 2048u, S, E);)
    PG(3, SchedG2 S{p.ws, G, c, MULT(3)}; EpiG2 E{p.ws}; pg8::gemm_phase<EpiG2, SchedG2, false>(lds, 256, 1024u, 512u, S, E);)
    PH(4, if (r_ == 0 || DUP_SUB != 1) phase_carry(p, lds); if (r_ == 0 || DUP_SUB != 0) phase_sgu(p, lds);)
    PG(5, SchedG3 S{p.ws, G, c, MULT(5)}; EpiG3 E{p.ws}; pg8::gemm_phase<EpiG3, SchedG3, false>(lds, 512, 1024u, 1024u, S, E);)
    PG(6, SchedG4 S{p.ws, G, c, MULT(6)}; EpiG4 E{p.ws, p.in[20]}; pg8::gemm_phase<EpiG4, SchedG4, false>(lds, 512, 1024u, 1024u, S, E);)
    PG(7, SchedG5 S{p.ws, G, c, MULT(7)}; EpiG5 E{p.ws}; pg8::gemm_phase<EpiG5, SchedG5, false>(lds, 512, 1024u, 1024u, S, E);)
    PG(8, SchedG6 S{p.ws, G, c, MULT(8)}; EpiG6 E{p.ws}; pg8::gemm_phase<EpiG6, SchedG6, false>(lds, 1024, 2048u, 2048u, S, E);)
    PH(9, phase_r1(p);)
    PG(10, SchedG7 S{p.ws, G, c, MULT(10)}; EpiG7 E{p.ws}; pg8::gemm_phase<EpiG7, SchedG7, false>(lds, 1024, 2048u, 2048u, S, E);)
    PH(11, phase_route(p, lds);)
    PH(12, phase_scan(p, lds);)
    PH(13, phase_scatter(p, lds);)
    PG(14, SchedG8 S{p.ws, G, c, MULT(14)}; EpiG8 E{p.ws}; pg8::gemm_phase<EpiG8, SchedG8, true>(lds, 1024, 2048u, 2048u, S, E);)
    PG(15, { SchedG9 S{p.ws, G, c, 0, MULT(15)}; EpiG9 E{p.ws}; pg8::gemm_phase<EpiG9, SchedG9, false>(lds, 256, 512u, 512u, S, E); } { SchedG10 S{p.ws, G, c, MULT(19)}; EpiG10 E{p.out}; pg8::gemm_phase<EpiG10, SchedG10, false>(lds, 256, 512u, 512u, S, E); })
    PH(16, phase_r3a(p);)
    PG(17, SchedG9 S{p.ws, G, c, 1, MULT(17)}; EpiG9 E{p.ws}; pg8::gemm_phase<EpiG9, SchedG9, false>(lds, 256, 512u, 512u, S, E);)
    PH(18, phase_r3b(p);)
    if (SPIN_PHASE >= 0) { const unsigned long long t0_ = __builtin_amdgcn_s_memrealtime(); while (__builtin_amdgcn_s_memrealtime() - t0_ < spin_acc * SPIN_MULT) __builtin_amdgcn_s_sleep(8); }
#undef IN
#undef SEAM
#undef PH
#undef PG
#undef MULT
}

extern "C" void kernel_launch(void* const* d_in, const int* in_sizes, int n_in, void* d_out, int out_size, void* d_ws, size_t ws_size, hipStream_t stream) {
    static int grid = 0;
    if (grid == 0) {
        if (n_in != 35 || out_size != NTOK * DM || ws_size < WS_NEED) { fprintf(stderr, "kernel_launch: unexpected shapes / workspace (%d inputs, out %d, ws %zu)\n", n_in, out_size, ws_size); grid = -1; return; }
        int dev = 0, cus = 0, per_cu = 0;
        hipGetDevice(&dev); hipDeviceGetAttribute(&cus, hipDeviceAttributeMultiprocessorCount, dev);
        hipFuncSetAttribute((const void*)fwd_kernel, hipFuncAttributeMaxDynamicSharedMemorySize, LDS_BYTES);
        hipOccupancyMaxActiveBlocksPerMultiprocessor(&per_cu, (const void*)fwd_kernel, NT, LDS_BYTES);
        if (per_cu < 1) { fprintf(stderr, "kernel_launch: occupancy query says %d blocks per CU\n", per_cu); per_cu = 1; }
        grid = cus * 1;
        (void)hipGetLastError();
    }
    if (grid < 0) return;
    Params p{};
    for (int i = 0; i < 35; ++i) p.in[i] = (const float*)d_in[i];
    p.out = (float*)d_out; p.ws = (unsigned char*)d_ws;
#if N_LAUNCH_MODE == 1
    hipMemsetAsync(d_ws, 0, 16384, stream);
    p.ph_lo = 0; p.ph_hi = N_PHASES;
    void* args[] = {&p};
    hipError_t e = hipLaunchCooperativeKernel((const void*)fwd_kernel, dim3(grid), dim3(NT), args, LDS_BYTES, stream);
    if (e != hipSuccess) fprintf(stderr, "cooperative launch failed: %s (grid %d)\n", hipGetErrorString(e), grid);
#else
    for (int k = 0; k < 19; ++k) { p.ph_lo = k; p.ph_hi = k + 1; hipLaunchKernelGGL(fwd_kernel, dim3(grid), dim3(NT), LDS_BYTES, stream, p); }
#endif
}
```

```cpp
#include <hip/hip_runtime.h>
#include <hip/hip_cooperative_groups.h>
#include <cstdio>
namespace cg = cooperative_groups;

#ifndef DUP_PHASE
#define DUP_PHASE -1
#define DUP_REPS 1
#define DUP_SUB -1
#define SPIN_PHASE -1
#define SPIN_MULT 9
#endif
#ifndef N_LAUNCH_MODE
#define N_LAUNCH_MODE 1
#endif

#define LAS __attribute__((address_space(3)))
typedef unsigned short bf16_t;
typedef short bf16x8 __attribute__((ext_vector_type(8)));
typedef float f32x4 __attribute__((ext_vector_type(4)));
typedef float f32x2 __attribute__((ext_vector_type(2)));
typedef unsigned u32x4 __attribute__((ext_vector_type(4)));
typedef unsigned u32x2 __attribute__((ext_vector_type(2)));
typedef LAS unsigned char* ldsp_t;

constexpr int NT = 512;
constexpr int DM = 1024;
constexpr int NTOK = 32768;
constexpr int NCTXR = 1024;
constexpr int NROWS = NTOK + NCTXR;
constexpr int DIN = 3584;
constexpr int UC_ROWS = 2304;
constexpr int NEXP = 256;
constexpr int MAXSLOT = 360448;
constexpr float EPS = 1e-6f;

constexpr size_t MiB = 1u << 20;
constexpr size_t WS_MODP = 1 * MiB;
constexpr size_t WS_MOD = 3 * MiB;
constexpr size_t WS_APL = 3 * MiB + 256 * 1024;
constexpr size_t WS_SGUW = 3 * MiB + 512 * 1024;
constexpr size_t WS_WGLU_T = 4 * MiB;
constexpr size_t WS_WR_T = 4 * MiB + 512 * 1024;
constexpr size_t WS_WB5_T = 5 * MiB;
constexpr size_t WS_WBS_T = 6 * MiB;
constexpr size_t WS_WOUT_T = 7 * MiB;
constexpr size_t WS_WIN_T = 9 * MiB;
constexpr size_t WS_BCAT_T = 16 * MiB;
constexpr size_t WS_WEND_T = 24 * MiB;
constexpr size_t WS_SSQV = 28 * MiB;
constexpr size_t WS_SSQM = 29 * MiB;
constexpr size_t WS_IDX = 31 * MiB;
constexpr size_t WS_WT = 32 * MiB;
constexpr size_t WS_SLOT = 33 * MiB;
constexpr size_t WS_BLKCNT = 34 * MiB;
constexpr size_t WS_BLKOFF = 34 * MiB + 256 * 1024;
constexpr size_t WS_TOTAL = 34 * MiB + 512 * 1024;
constexpr size_t WS_TILEEXP = 34 * MiB + 768 * 1024;
constexpr size_t WS_TOKSLOT = 35 * MiB;
constexpr size_t WS_WSLOT = 36 * MiB + 512 * 1024;
constexpr size_t WS_WD_T = 48 * MiB;
constexpr size_t WS_WGU_T = 177 * MiB;
constexpr size_t WS_XN = 434 * MiB;
constexpr size_t WS_UCAT = 500 * MiB;
constexpr size_t WS_E = 572 * MiB;
constexpr size_t WS_GU = 644 * MiB;
constexpr size_t WS_GV = 676 * MiB;
constexpr size_t WS_SG5 = 708 * MiB;
constexpr size_t WS_SGS = 772 * MiB;
constexpr size_t WS_YS = 836 * MiB;
constexpr size_t WS_YS5 = 868 * MiB;
constexpr size_t WS_YSGU = 900 * MiB;
constexpr size_t WS_MX = 932 * MiB;
constexpr size_t WS_MERGED = 500 * MiB;
constexpr size_t WS_LOGITS = 564 * MiB;
constexpr size_t WS_H = 596 * MiB;
constexpr size_t WS_YSLOT = 177 * MiB;
constexpr size_t WS_NEED = 996 * MiB;

constexpr int LDS_BYTES = 147456;

struct Params { const float* in[35]; float* out; unsigned char* ws; int ph_lo, ph_hi; };

__device__ __forceinline__ unsigned f2bf(float f) { unsigned u = __builtin_bit_cast(unsigned, f); return (u + 0x7fffu + ((u >> 16) & 1u)) >> 16; }
typedef __bf16 bf16v2_t __attribute__((ext_vector_type(2)));
__device__ __forceinline__ unsigned pk2(float lo, float hi) { bf16v2_t v; v.x = (__bf16)lo; v.y = (__bf16)hi; return __builtin_bit_cast(unsigned, v); }
__device__ __forceinline__ float bflo(unsigned w) { return __builtin_bit_cast(float, w << 16); }
__device__ __forceinline__ float bfhi(unsigned w) { return __builtin_bit_cast(float, w & 0xffff0000u); }
__device__ __forceinline__ float bf2f(bf16_t b) { return __builtin_bit_cast(float, ((unsigned)b) << 16); }
__device__ __forceinline__ float sigmoid_f(float x) { return __builtin_amdgcn_rcpf(1.0f + __expf(-x)); }
__device__ __forceinline__ float silu_f(float x) { return x * sigmoid_f(x); }
__device__ __forceinline__ float gelu_f(float x) { const float z = 1.5957691216057308f * (x + 0.044715f * x * x * x); return x * sigmoid_f(z); }
__device__ __forceinline__ float wave_sum(float v) {
#pragma unroll
    for (int o = 1; o < 64; o <<= 1) v += __shfl_xor(v, o);
    return v;
}
template <int CTRL, int RM = 0xf, int BM = 0xf> __device__ __forceinline__ float dpp_f(float oldv, float x) {
    return __builtin_bit_cast(float, __builtin_amdgcn_update_dpp(__builtin_bit_cast(int, oldv), __builtin_bit_cast(int, x), CTRL, RM, BM, false)); }
__device__ __forceinline__ float wave_max_dpp(float v) {
    v = fmaxf(v, dpp_f<0xB1>(v, v)); v = fmaxf(v, dpp_f<0x4E>(v, v)); v = fmaxf(v, dpp_f<0x124>(v, v)); v = fmaxf(v, dpp_f<0x128>(v, v));
    v = fmaxf(v, dpp_f<0x142, 0xa>(v, v)); v = fmaxf(v, dpp_f<0x143, 0xc>(v, v));
    return __builtin_bit_cast(float, __builtin_amdgcn_readlane(__builtin_bit_cast(int, v), 63)); }
#define LDS_WAIT() asm volatile("s_waitcnt lgkmcnt(0)" ::: "memory")

__device__ __forceinline__ double dexp_(double x) {
    const double r = x * (1.0 / 32.0); double t = 1.0, s = 1.0;
#pragma unroll 1
    for (int i = 1; i <= 14; ++i) { t *= r / (double)i; s += t; }
#pragma unroll 1
    for (int i = 0; i < 5; ++i) s *= s;
    return s;
}
__device__ __forceinline__ void dsincos_(double th, double& sn, double& cs) {
    const double TWO_PI_HI = 6.283185307179586232, TWO_PI_LO = 2.4492935982947064e-16;
    const double k = __builtin_rint(th * 0.15915494309189535);
    double r = (th - k * TWO_PI_HI) - k * TWO_PI_LO;
    r *= 0.125;
    const double r2 = r * r; double ts = r, tc = 1.0, s = r, c = 1.0;
#pragma unroll 1
    for (int i = 1; i <= 9; ++i) { tc *= -r2 / (double)((2 * i - 1) * (2 * i)); c += tc; ts *= -r2 / (double)((2 * i) * (2 * i + 1)); s += ts; }
#pragma unroll 1
    for (int i = 0; i < 3; ++i) { const double s2 = 2.0 * s * c, c2 = c * c - s * s; s = s2; c = c2; }
    sn = s; cs = c;
}

namespace pg8 {
constexpr int BM = 256, BK = 64, HALF = 128, HTB = HALF * BK * 2, STAGE_BYTES = 8 * HTB;
__device__ __forceinline__ int lds_byte(int r, int c) { const int st = (r >> 4) * 2 + (c >> 5), rr = r & 15, cc = c & 31, ob = rr * 64 + cc * 2; return st * 1024 + (ob ^ (((ob >> 9) & 1) << 5)); }
__device__ __forceinline__ void stage_rc(int b, int& R, int& C) { const int st = b / 1024, sb = b % 1024, swz = sb ^ (((sb >> 9) & 1) << 5); R = (st >> 1) * 16 + swz / 64; C = (st & 1) * 32 + (swz % 64) / 2; }
__device__ __forceinline__ int perm32(int rho) { const int n = rho >> 4, i = rho & 15; return 8 * (i >> 2) + 4 * n + (i & 3); }

struct Unit { const char* A; const char* B; const int* arow; int pm, pn, x0, x1; };

template <class Epi, class Sched, bool GATHER>
__device__ __forceinline__ void gemm_phase(ldsp_t lds, const int K, const unsigned lda, const unsigned ldb, const Sched& S, const Epi& E) {
    const int tid = threadIdx.x, wid = __builtin_amdgcn_readfirstlane(tid >> 6), lane = tid & 63, wr = wid >> 2, wc = wid & 3, fr = lane & 15, fq = lane >> 4;
    const int nt = K / BK;
    int RA[2], CA[2]; unsigned voffB[2][2];
#pragma unroll
    for (int i = 0; i < 2; ++i) { int R, C; stage_rc(tid * 16 + i * 8192, R, C); RA[i] = R; CA[i] = C; const int Rb = Epi::PERM ? ((R & ~31) + perm32(R & 31)) : R;
        voffB[0][i] = (unsigned)Rb * ldb + (unsigned)C * 2u; voffB[1][i] = (unsigned)(Rb + HALF) * ldb + (unsigned)C * 2u; }
    unsigned vA[2][2], vN[2][2];
#define PG8_SETA(v, u) do { _Pragma("unroll") for (int _h = 0; _h < 2; ++_h) _Pragma("unroll") for (int _i = 0; _i < 2; ++_i) { \
        const int _row = _h * HALF + RA[_i]; const unsigned _src = GATHER ? (unsigned)(u).arow[_row] : (unsigned)_row; (v)[_h][_i] = _src * lda + (unsigned)CA[_i] * 2u; } } while (0)
    const size_t kstep = (size_t)(BK * 2);
    const unsigned ldsw = (unsigned)wid * 1024u;
    const int aoff = lds_byte(wr * 64 + fr, fq * 8), boff = lds_byte(wc * 32 + fr, fq * 8);
#define PG8_SA(b, h) (((b) * 2 + (h)) * HTB)
#define PG8_SB(b, h) ((4 + (b) * 2 + (h)) * HTB)
#define PG8_STAGE(bufoff, gbase, o0, o1) do { \
        __builtin_amdgcn_global_load_lds((const unsigned*)((const char*)(gbase) + (o0)), (LAS unsigned*)(lds + (bufoff) + ldsw), 16, 0, 0); \
        __builtin_amdgcn_global_load_lds((const unsigned*)((const char*)(gbase) + (o1)), (LAS unsigned*)(lds + (bufoff) + ldsw + 8192), 16, 0, 0); } while (0)
#define PG8_LDA(dst, b, h) do { _Pragma("unroll") for (int m = 0; m < 4; ++m) _Pragma("unroll") for (int k = 0; k < 2; ++k) dst[m][k] = *(const LAS bf16x8*)(lds + PG8_SA(b, h) + aoff + m * 2048 + k * 1024); } while (0)
#define PG8_LDB(dst, b, h) do { _Pragma("unroll") for (int n = 0; n < 2; ++n) _Pragma("unroll") for (int k = 0; k < 2; ++k) dst[n][k] = *(const LAS bf16x8*)(lds + PG8_SB(b, h) + boff + n * 2048 + k * 1024); } while (0)
#define PG8_MMA(ai, bj, At, Bt) do { __builtin_amdgcn_s_setprio(1); _Pragma("unroll") for (int m = 0; m < 4; ++m) _Pragma("unroll") for (int n = 0; n < 2; ++n) _Pragma("unroll") for (int k = 0; k < 2; ++k) \
        acc[ai][bj][m][n] = __builtin_amdgcn_mfma_f32_16x16x32_bf16(Bt[n][k], At[m][k], acc[ai][bj][m][n], 0, 0, 0); __builtin_amdgcn_s_setprio(0); } while (0)
#define PG8_WAIT_V(n) asm volatile("s_waitcnt vmcnt(" #n ")" ::: "memory")
#define PG8_WAIT_L(n) asm volatile("s_waitcnt lgkmcnt(" #n ")" ::: "memory")
#define PG8_BAR __builtin_amdgcn_s_barrier()
#define PG8_SCHED __builtin_amdgcn_sched_barrier(0)
    Unit cur, nxt; int ui = 0;
    if (!S.next(0, cur)) return;
    PG8_SETA(vA, cur);
    f32x4 acc[2][2][4][2];
#pragma unroll
    for (int a = 0; a < 2; ++a)
#pragma unroll
        for (int b = 0; b < 2; ++b)
#pragma unroll
            for (int m = 0; m < 4; ++m)
#pragma unroll
                for (int n = 0; n < 2; ++n) acc[a][b][m][n] = (f32x4){0.f, 0.f, 0.f, 0.f};
    bf16x8 At[4][2], B0[2][2], B1[2][2];
    const char* cA = cur.A; const char* cB = cur.B;
    PG8_STAGE(PG8_SB(0, 0), cB, voffB[0][0], voffB[0][1]); PG8_STAGE(PG8_SA(0, 0), cA, vA[0][0], vA[0][1]);
    PG8_STAGE(PG8_SB(0, 1), cB, voffB[1][0], voffB[1][1]); PG8_STAGE(PG8_SA(0, 1), cA, vA[1][0], vA[1][1]);
    if (wr == 1) PG8_BAR;
    PG8_WAIT_V(4); PG8_BAR;
    PG8_STAGE(PG8_SB(1, 0), cB + kstep, voffB[0][0], voffB[0][1]); PG8_STAGE(PG8_SA(1, 0), cA + kstep, vA[0][0], vA[0][1]);
    PG8_STAGE(PG8_SB(1, 1), cB + kstep, voffB[1][0], voffB[1][1]);
    PG8_WAIT_V(6); PG8_BAR;
    for (;;) {
        const bool has_next = S.next(ui + 1, nxt);
        const char* nA = has_next ? nxt.A : cA; const char* nB = has_next ? nxt.B : cB;
        if (GATHER) { if (has_next && nxt.arow != cur.arow) { PG8_SETA(vN, nxt); } else { vN[0][0] = vA[0][0]; vN[0][1] = vA[0][1]; vN[1][0] = vA[1][0]; vN[1][1] = vA[1][1]; } }
#pragma nounroll
        for (int t = 0; t < nt; t += 2) {
            const bool last = (t == nt - 2);
            const char* a1 = cA + (size_t)(t + 1) * kstep;
            const char* a2 = last ? nA : cA + (size_t)(t + 2) * kstep; const char* b2 = last ? nB : cB + (size_t)(t + 2) * kstep;
            const char* a3 = a2 + kstep; const char* b3 = b2 + kstep;
            unsigned o00, o01, o10, o11;
            if (GATHER && last) { o00 = vN[0][0]; o01 = vN[0][1]; o10 = vN[1][0]; o11 = vN[1][1]; } else { o00 = vA[0][0]; o01 = vA[0][1]; o10 = vA[1][0]; o11 = vA[1][1]; }
            PG8_LDB(B0, 0, 0); PG8_SCHED; PG8_LDA(At, 0, 0); PG8_STAGE(PG8_SA(1, 1), a1, vA[1][0], vA[1][1]);
            PG8_WAIT_L(8); PG8_BAR; PG8_WAIT_L(0); PG8_MMA(0, 0, At, B0); PG8_BAR; PG8_SCHED;
            PG8_LDB(B1, 0, 1); PG8_STAGE(PG8_SB(0, 0), b2, voffB[0][0], voffB[0][1]);
            PG8_BAR; PG8_WAIT_L(0); PG8_MMA(0, 1, At, B1); PG8_BAR;
            PG8_LDA(At, 0, 1); PG8_STAGE(PG8_SA(0, 0), a2, o00, o01);
            PG8_BAR; PG8_WAIT_L(0); PG8_MMA(1, 0, At, B0); PG8_BAR; PG8_SCHED;
            PG8_STAGE(PG8_SB(0, 1), b2, voffB[1][0], voffB[1][1]);
            PG8_WAIT_V(6); PG8_BAR; PG8_MMA(1, 1, At, B1); PG8_BAR;
            PG8_LDB(B0, 1, 0); PG8_SCHED; PG8_LDA(At, 1, 0); PG8_STAGE(PG8_SA(0, 1), a2, o10, o11);
            PG8_WAIT_L(8); PG8_BAR; PG8_WAIT_L(0); PG8_MMA(0, 0, At, B0); PG8_BAR; PG8_SCHED;
            PG8_LDB(B1, 1, 1); PG8_STAGE(PG8_SB(1, 0), b3, voffB[0][0], voffB[0][1]);
            PG8_BAR; PG8_WAIT_L(0); PG8_MMA(0, 1, At, B1); PG8_BAR;
            PG8_LDA(At, 1, 1); PG8_STAGE(PG8_SA(1, 0), a3, o00, o01);
            PG8_BAR; PG8_WAIT_L(0); PG8_MMA(1, 0, At, B0); PG8_BAR; PG8_SCHED;
            PG8_STAGE(PG8_SB(1, 1), b3, voffB[1][0], voffB[1][1]);
            PG8_WAIT_V(6); PG8_BAR; PG8_MMA(1, 1, At, B1); PG8_BAR;
        }
        E(acc, cur, wr, wc, fr, fq);
        if (!has_next) break;
#pragma unroll
        for (int a = 0; a < 2; ++a)
#pragma unroll
            for (int b = 0; b < 2; ++b)
#pragma unroll
                for (int m = 0; m < 4; ++m)
#pragma unroll
                    for (int n = 0; n < 2; ++n) acc[a][b][m][n] = (f32x4){0.f, 0.f, 0.f, 0.f};
        cur = nxt; cA = nA; cB = nB; ++ui;
        if (GATHER) { vA[0][0] = vN[0][0]; vA[0][1] = vN[0][1]; vA[1][0] = vN[1][0]; vA[1][1] = vN[1][1]; }
    }
    PG8_WAIT_V(0);
    if (wr == 0) PG8_BAR;
    PG8_BAR;
#undef PG8_SETA
#undef PG8_SA
#undef PG8_SB
#undef PG8_STAGE
#undef PG8_LDA
#undef PG8_LDB
#undef PG8_MMA
#undef PG8_WAIT_V
#undef PG8_WAIT_L
#undef PG8_BAR
#undef PG8_SCHED
}
}
using pg8::Unit;
typedef f32x4 acc_t[2][2][4][2];

#define EPI_ROWS(ai, m, rowl) _Pragma("unroll") for (int ai = 0; ai < 2; ++ai) _Pragma("unroll") for (int m = 0; m < 4; ++m) { const int rowl = ai * 128 + wr * 64 + m * 16 + fr;
#define EPI_END }

struct TItem { const float* src; bf16_t* dst; int ldw, ldt; };
__device__ __forceinline__ TItem tr_make(const float* W, int ldw, int k0, int n0, bf16_t* WT, size_t drow0, int ldt) { TItem t; t.src = W + (size_t)k0 * ldw + n0; t.dst = WT + drow0 * (size_t)ldt + k0; t.ldw = ldw; t.ldt = ldt; return t; }
__device__ __forceinline__ TItem tr_decode(const Params& p, int r) {
    constexpr int I_IN = 16 * 56, I_GLU = 64, I_B5 = 128, I_BS = 128, I_OUT = 256, I_R = 64;
    if (r < I_IN) return tr_make(p.in[10], DIN, (r / 56) * 64, (r % 56) * 64, (bf16_t*)(p.ws + WS_WIN_T), (size_t)(r % 56) * 64, 1024); r -= I_IN;
    if (r < I_GLU) return tr_make(p.in[19], 512, (r / 8) * 64, (r % 8) * 64, (bf16_t*)(p.ws + WS_WGLU_T), (size_t)(r % 8) * 64, 512); r -= I_GLU;
    if (r < I_B5) return tr_make(p.in[24], 1024, (r / 16) * 64, (r % 16) * 64, (bf16_t*)(p.ws + WS_WB5_T), (size_t)(r % 16) * 64, 512); r -= I_B5;
    if (r < I_BS) return tr_make(p.in[25], 1024, (r / 16) * 64, (r % 16) * 64, (bf16_t*)(p.ws + WS_WBS_T), (size_t)(r % 16) * 64, 512); r -= I_BS;
    if (r < I_OUT) return tr_make(p.in[26], 1024, (r / 16) * 64, (r % 16) * 64, (bf16_t*)(p.ws + WS_WOUT_T), (size_t)(r % 16) * 64, 1024); r -= I_OUT;
    if (r < I_R) return tr_make(p.in[27], 256, (r / 4) * 64, (r % 4) * 64, (bf16_t*)(p.ws + WS_WR_T), (size_t)(r % 4) * 64, 1024); r -= I_R;
    const int e = r / 192, q = r % 192;
    if (q < 128) {
        const int up = q >> 6, qq = q & 63, k0 = (qq / 4) * 64, n0 = (qq % 4) * 64;
        const float* W = (e < 256) ? p.in[up ? 30 : 29] + (size_t)e * 262144 : p.in[up ? 33 : 32];
        return tr_make(W, 256, k0, n0, (bf16_t*)(p.ws + WS_WGU_T), (size_t)e * 512 + (size_t)(n0 >> 7) * 256 + up * 128 + (n0 & 127), 1024);
    }
    const int qq = q - 128, k0 = (qq / 16) * 64, n0 = (qq % 16) * 64;
    const float* W = (e < 256) ? p.in[31] + (size_t)e * 262144 : p.in[34];
    return tr_make(W, 1024, k0, n0, (bf16_t*)(p.ws + WS_WD_T), (size_t)e * 1024 + n0, 256);
}
#define TR_LOAD(v, t) do { __builtin_amdgcn_sched_barrier(0); _Pragma("unroll") for (int it_ = 0; it_ < 16; ++it_) (v)[it_] = __builtin_nontemporal_load((const f32x4*)((t).src + (size_t)(it_ * 4 + (lane >> 4)) * (t).ldw + (lane & 15) * 4)); __builtin_amdgcn_sched_barrier(0); } while (0)
#define TR_STORE(v, t) do { \
    _Pragma("unroll") for (int it_ = 0; it_ < 16; ++it_) { LAS float* s_ = scr + (it_ * 4 + (lane >> 4)) * 65 + (lane & 15) * 4; s_[0] = (v)[it_].x; s_[1] = (v)[it_].y; s_[2] = (v)[it_].z; s_[3] = (v)[it_].w; } \
    LDS_WAIT(); \
    _Pragma("unroll") for (int it_ = 0; it_ < 8; ++it_) { const int n_ = it_ * 8 + (lane >> 3), c_ = lane & 7; const LAS float* s_ = scr + (8 * c_) * 65 + n_; \
        u32x4 o_; o_.x = pk2(s_[0], s_[65]); o_.y = pk2(s_[130], s_[195]); o_.z = pk2(s_[260], s_[325]); o_.w = pk2(s_[390], s_[455]); \
        __builtin_nontemporal_store(o_, (u32x4*)((t).dst + (size_t)n_ * (t).ldt + 8 * c_)); } \
    LDS_WAIT(); } while (0)

__device__ __forceinline__ void s5_tables(const Params& p, int g, int sub, ldsp_t lds) {
    LAS f32x2* apow = (LAS f32x2*)lds;
    LAS f32x2* bbar = (LAS f32x2*)(lds + 17408);
    LAS f32x2* cm = (LAS f32x2*)(lds + 17408 + 16384);
    LAS float* Kt = (LAS float*)(lds + 17408 + 32768);
    const int tid = threadIdx.x;
    const float *a_re = p.in[11], *a_im = p.in[12], *log_dt = p.in[13], *b_re = p.in[14], *b_im = p.in[15], *c_re = p.in[16], *c_im = p.in[17], *dsk = p.in[18];
    float* APL = (float*)(p.ws + WS_APL);
    if (tid < 128) {
        const int d = tid >> 6, pp = tid & 63, idx = (d * 32 + g) * 64 + pp;
        const double are = (double)a_re[idx], aim = (double)a_im[idx];
        const double dt = dexp_((double)log_dt[d * 32 + g]);
        const double mag = dexp_(dt * are); double sn, cs; dsincos_(dt * aim, sn, cs);
        const double abr = mag * cs, abi = mag * sn;
        double pr = 1.0, pi = 0.0;
#pragma unroll 1
        for (int m = 0; m <= 16; ++m) { apow[(d * 17 + m) * 64 + pp] = (f32x2){(float)pr, (float)pi}; const double nr = pr * abr - pi * abi, ni = pr * abi + pi * abr; pr = nr; pi = ni; }
        if (sub == 0) { const f32x2 aL = apow[(d * 17 + 16) * 64 + pp]; APL[idx * 2 + 0] = aL.x; APL[idx * 2 + 1] = aL.y; }
        const double nr = abr - 1.0, ni = abi, den = are * are + aim * aim;
        const double qr = (nr * are + ni * aim) / den, qi = (ni * are - nr * aim) / den;
#pragma unroll 1
        for (int i = 0; i < 16; ++i) { const double br = (double)b_re[idx * 16 + i], bi = (double)b_im[idx * 16 + i];
            bbar[(d * 64 + pp) * 16 + i] = (f32x2){(float)(qr * br - qi * bi), (float)(qr * bi + qi * br)}; }
    }
    for (int e = tid; e < 2048; e += NT) { const int d = e >> 10, j = (e >> 6) & 15, pp = e & 63; const int gi = ((d * 32 + g) * 16 + j) * 64 + pp; cm[e] = (f32x2){c_re[gi], c_im[gi]}; }
    __syncthreads();
    for (int e1 = tid; e1 < 1024; e1 += NT) {
        const int d = e1 >> 9, m = (e1 >> 5) & 15, j = 2 * sub + ((e1 >> 4) & 1), i = e1 & 15, e = (d << 12) | (m << 8) | (j << 4) | i; float s = 0.f;
#pragma unroll 4
        for (int pp = 0; pp < 64; ++pp) { const f32x2 a = apow[(d * 17 + m) * 64 + pp], b = bbar[(d * 64 + pp) * 16 + i], c = cm[(d * 16 + j) * 64 + pp];
            const float tr = a.x * b.x - a.y * b.y, ti = a.x * b.y + a.y * b.x; s += c.x * tr - c.y * ti; }
        Kt[e] = s;
    }
    __syncthreads();
    unsigned* BC = (unsigned*)(p.ws + WS_BCAT_T) + (size_t)g * 256 * 256;
    for (int e3 = tid; e3 < 8192; e3 += NT) {
        const int rr = e3 >> 8, tau = rr >> 1, j = 2 * sub + (rr & 1), n = tau * 16 + j, e2 = n * 256 + (e3 & 255), kk0 = (e3 & 255) * 2; float v[2];
#pragma unroll
        for (int q = 0; q < 2; ++q) { const int kk = kk0 + q; float r;
            if (kk < 256) { const int k = kk >> 4, i = kk & 15; r = 0.f;
                if (tau >= k) r += Kt[((0 * 16 + (tau - k)) * 16 + j) * 16 + i];
                if (k >= tau) r += Kt[((1 * 16 + (k - tau)) * 16 + j) * 16 + i];
                if (k == tau && i == j) r += dsk[16 * g + j];
            } else { const int qq = kk - 256, part = qq >> 6, pp = qq & 63, d = part >> 1, m = (d == 0) ? (tau + 1) : (16 - tau);
                const f32x2 c = cm[(d * 16 + j) * 64 + pp], a = apow[(d * 17 + m) * 64 + pp];
                r = (part & 1) ? -(c.x * a.y + c.y * a.x) : (c.x * a.x - c.y * a.y); }
            v[q] = r; }
        BC[e2] = pk2(v[0], v[1]);
    }
    unsigned* WE = (unsigned*)(p.ws + WS_WEND_T) + (size_t)g * 256 * 128;
    for (int e3 = tid; e3 < 4096; e3 += NT) {
        const int n = 32 * sub + (e3 >> 7), e2 = n * 128 + (e3 & 127), kk0 = (e3 & 127) * 2, d = n >> 7, ri = (n >> 6) & 1, pp = n & 63; float v[2];
#pragma unroll
        for (int q = 0; q < 2; ++q) { const int kk = kk0 + q, k = kk >> 4, i = kk & 15, m = (d == 0) ? (15 - k) : k;
            const f32x2 a = apow[(d * 17 + m) * 64 + pp], b = bbar[(d * 64 + pp) * 16 + i];
            v[q] = ri ? (a.x * b.y + a.y * b.x) : (a.x * b.x - a.y * b.y); }
        WE[e2] = pk2(v[0], v[1]);
    }
    __syncthreads();
}

__device__ __forceinline__ void phase_prep(const Params& p, ldsp_t lds) {
    const int tid = threadIdx.x, lane = tid & 63, wave = tid >> 6, G = gridDim.x, bx = blockIdx.x;
    for (int q = bx; q < 256; q += G) s5_tables(p, q >> 3, q & 7, lds);
    { const float* sw = p.in[22]; unsigned* dst = (unsigned*)(p.ws + WS_SGUW);
      for (size_t e = (size_t)bx * NT + tid; e < 65536; e += (size_t)G * NT) dst[e] = pk2(sw[2 * e], sw[2 * e + 1]);
      u32x4* uc = (u32x4*)(p.ws + WS_UCAT);
      for (size_t e = (size_t)bx * NT + tid; e < (size_t)32 * 12288; e += (size_t)G * NT) { const size_t g = e / 12288, r = e % 12288; uc[(g * UC_ROWS + 2112) * 64 + r] = (u32x4){0u, 0u, 0u, 0u}; } }
    const int gw = bx * 8 + __builtin_amdgcn_readfirstlane(wave), NGW = G * 8;
    for (int r = gw; r < 1536; r += NGW) {
        const int cb = r % 96, ks = r / 96, n = cb * 64 + lane; const float* wm = p.in[4];
        float a0 = 0.f, a1 = 0.f, a2 = 0.f, a3 = 0.f, a4 = 0.f;
#pragma unroll 8
        for (int kk = 0; kk < 64; ++kk) { const int k = ks * 64 + kk; const float w = __builtin_nontemporal_load(wm + (size_t)k * 6144 + n);
            a0 += silu_f(p.in[1][k]) * w; a1 += silu_f(p.in[1][1024 + k]) * w; a2 += silu_f(p.in[1][2048 + k]) * w; a3 += silu_f(p.in[1][3072 + k]) * w; a4 += silu_f(p.in[3][k]) * w; }
        float* mp = (float*)(p.ws + WS_MODP) + (size_t)ks * 5 * 6144 + n;
        mp[0] = a0; mp[6144] = a1; mp[2 * 6144] = a2; mp[3 * 6144] = a3; mp[4 * 6144] = a4;
    }
    LAS float* scr = (LAS float*)(lds + wave * 16640);
    constexpr int N_TR = 16 * 56 + 64 + 128 + 128 + 256 + 64 + 257 * 192;
    int it = __builtin_amdgcn_readfirstlane(gw);
    if (it < N_TR) {
        f32x4 va[16], vb[16];
        TItem ta = tr_decode(p, it), tb; TR_LOAD(va, ta);
        for (;;) {
            bool more = (it + NGW) < N_TR;
            tb = tr_decode(p, more ? it + NGW : it); TR_LOAD(vb, tb);
            TR_STORE(va, ta);
            if (!more) break;
            it += NGW; more = (it + NGW) < N_TR;
            ta = tr_decode(p, more ? it + NGW : it); TR_LOAD(va, ta);
            TR_STORE(vb, tb);
            if (!more) break;
            it += NGW;
        }
    }
}

__device__ __forceinline__ void phase_xn(const Params& p, ldsp_t lds) {
    const int tid = threadIdx.x, lane = tid & 63, wave = tid >> 6, G = gridDim.x, bx = blockIdx.x;
    const float* modp = (const float*)(p.ws + WS_MODP); const float* bmod = p.in[5];
    { float* mod = (float*)(p.ws + WS_MOD);
      for (int e = bx * NT + tid; e < 5 * 6144; e += G * NT) { const int n = e % 6144; float s = bmod[n];
#pragma unroll
          for (int ks = 0; ks < 16; ++ks) s += modp[(size_t)ks * 5 * 6144 + e];
          mod[e] = s; } }
    LAS float* shv = (LAS float*)lds; LAS float* gsc = (LAS float*)(lds + 4096);
    const float* gpre = p.in[6];
    for (int tile = bx; tile < NROWS / 128; tile += G) {
        const int mr = tile < 256 ? (tile >> 6) : 4;
        __syncthreads();
        for (int col = tid; col < 1024; col += NT) { float sh = bmod[col], sc = bmod[1024 + col];
#pragma unroll
            for (int ks = 0; ks < 16; ++ks) { sh += modp[((size_t)ks * 5 + mr) * 6144 + col]; sc += modp[((size_t)ks * 5 + mr) * 6144 + 1024 + col]; }
            shv[col] = sh; gsc[col] = gpre[col] * (1.0f + sc); }
        __syncthreads();
        for (int rr = wave; rr < 128; rr += 8) {
            const int row = tile * 128 + rr;
            const float* src = (row < NTOK) ? p.in[0] + (size_t)row * DM : p.in[2] + (size_t)(row - NTOK) * DM;
            f32x4 v[4]; float s = 0.f;
#pragma unroll
            for (int j = 0; j < 4; ++j) { v[j] = __builtin_nontemporal_load((const f32x4*)(src + 4 * lane + 256 * j)); s += (v[j].x * v[j].x + v[j].y * v[j].y) + (v[j].z * v[j].z + v[j].w * v[j].w); }
            const float rstd = rsqrtf(wave_sum(s) * (1.0f / DM) + EPS);
            bf16_t* dst = (bf16_t*)(p.ws + WS_XN) + (size_t)row * DM;
#pragma unroll
            for (int j = 0; j < 4; ++j) { const int c = 4 * lane + 256 * j; const f32x4 gs = *(const LAS f32x4*)(gsc + c), sh = *(const LAS f32x4*)(shv + c);
                u32x2 o; o.x = pk2(v[j].x * rstd * gs.x + sh.x, v[j].y * rstd * gs.y + sh.y); o.y = pk2(v[j].z * rstd * gs.z + sh.z, v[j].w * rstd * gs.w + sh.w);
                *(u32x2*)(dst + c) = o; }
        }
    }
    __syncthreads();
}

struct SchedG1 { const unsigned char* ws; int G, c, mult;
    __device__ __forceinline__ bool next(int i, Unit& u) const { int L = i * G + c; if (L >= 1800 * mult) return false; if (mult > 1) L %= 1800;
        if (L < 1792) { u.pm = L / 14; u.pn = L % 14; } else { const int q = L - 1792; u.pm = 128 + (q >> 1); u.pn = q & 1; }
        u.A = (const char*)ws + WS_XN + (size_t)u.pm * 256 * 2048; u.B = (const char*)ws + WS_WIN_T + (size_t)u.pn * 256 * 2048; u.arow = nullptr; u.x0 = 0; u.x1 = 0; return true; } };
struct EpiG1 { static constexpr bool PERM = true; unsigned char* ws;
    __device__ __forceinline__ void operator()(const acc_t& acc, const Unit& u, int wr, int wc, int fr, int fq) const {
        const int pn = u.pn;
        EPI_ROWS(ai, m, rowl)
            const int row = u.pm * 256 + rowl; float ssq = 0.f;
#pragma unroll
            for (int bj = 0; bj < 2; ++bj) {
                const int col = pn * 256 + bj * 128 + wc * 32 + 8 * fq; const f32x4 v0 = acc[ai][bj][m][0], v1 = acc[ai][bj][m][1]; u32x4 o;
                if (pn < 2) {
                    const int g = col >> 4, i0 = col & 15; int crow, k;
                    if (row < NTOK) { crow = row >> 4; k = row & 15; } else { const int rc = row - NTOK; crow = 2048 + (rc >> 8) * 16 + ((rc & 255) >> 4); k = rc & 15; }
                    o.x = pk2(v0.x, v0.y); o.y = pk2(v0.z, v0.w); o.z = pk2(v1.x, v1.y); o.w = pk2(v1.z, v1.w);
                    *(u32x4*)((bf16_t*)(ws + WS_UCAT) + ((size_t)(g * UC_ROWS + crow) * 512 + k * 16 + i0)) = o;
                } else if (pn < 6) {
                    const float g0 = gelu_f(v0.x), g1 = gelu_f(v0.y), g2 = gelu_f(v0.z), g3 = gelu_f(v0.w), g4 = gelu_f(v1.x), g5 = gelu_f(v1.y), g6 = gelu_f(v1.z), g7 = gelu_f(v1.w);
                    o.x = pk2(g0, g1); o.y = pk2(g2, g3); o.z = pk2(g4, g5); o.w = pk2(g6, g7);
                    if (pn < 4) *(u32x4*)((bf16_t*)(ws + WS_GU) + (size_t)row * 512 + (col - 512)) = o;
                    else { *(u32x4*)((bf16_t*)(ws + WS_GV) + (size_t)row * 512 + (col - 1024)) = o; ssq += (g0 * g0 + g1 * g1) + (g2 * g2 + g3 * g3) + (g4 * g4 + g5 * g5) + (g6 * g6 + g7 * g7); }
                } else {
                    o.x = pk2(sigmoid_f(v0.x), sigmoid_f(v0.y)); o.y = pk2(sigmoid_f(v0.z), sigmoid_f(v0.w)); o.z = pk2(sigmoid_f(v1.x), sigmoid_f(v1.y)); o.w = pk2(sigmoid_f(v1.z), sigmoid_f(v1.w));
                    if (pn < 10) *(u32x4*)((bf16_t*)(ws + WS_SG5) + (size_t)row * 1024 + (col - 1536)) = o;
                    else *(u32x4*)((bf16_t*)(ws + WS_SGS) + (size_t)row * 1024 + (col - 2560)) = o;
                }
            }
            if (pn == 4 || pn == 5) { ssq += __shfl_xor(ssq, 16); ssq += __shfl_xor(ssq, 32); if (fq == 0) ((float*)(ws + WS_SSQV))[(size_t)row * 8 + (pn - 4) * 4 + wc] = ssq; }
        EPI_END
    } };
struct SchedG2 { const unsigned char* ws; int G, c, mult;
    __device__ __forceinline__ bool next(int i, Unit& u) const { int L = i * G + c; if (L >= 288 * mult) return false; if (mult > 1) L %= 288; const int g = L / 9; u.pm = L % 9; u.pn = 0; u.x0 = g; u.x1 = 0; u.arow = nullptr;
        u.A = (const char*)ws + WS_UCAT + ((size_t)g * UC_ROWS + (size_t)u.pm * 256) * 1024; u.B = (const char*)ws + WS_WEND_T + (size_t)g * 256 * 512; return true; } };
struct EpiG2 { static constexpr bool PERM = false; unsigned char* ws;
    __device__ __forceinline__ void operator()(const acc_t& acc, const Unit& u, int wr, int wc, int fr, int fq) const {
        float* Eo = (float*)(ws + WS_E) + (size_t)u.x0 * UC_ROWS * 256;
        EPI_ROWS(ai, m, rowl)
            float* rp = Eo + (size_t)(u.pm * 256 + rowl) * 256 + wc * 32 + 4 * fq;
#pragma unroll
            for (int bj = 0; bj < 2; ++bj)
#pragma unroll
                for (int n = 0; n < 2; ++n) *(f32x4*)(rp + bj * 128 + n * 16) = acc[ai][bj][m][n];
        EPI_END
    } };
struct SchedG3 { const unsigned char* ws; int G, c, mult;
    __device__ __forceinline__ bool next(int i, Unit& u) const { int L = i * G + c; if (L >= 256 * mult) return false; if (mult > 1) L %= 256; const int g = L >> 3; u.pm = L & 7; u.pn = 0; u.x0 = g; u.x1 = 0; u.arow = nullptr;
        u.A = (const char*)ws + WS_UCAT + ((size_t)g * UC_ROWS + (size_t)u.pm * 256) * 1024; u.B = (const char*)ws + WS_BCAT_T + (size_t)g * 256 * 1024; return true; } };
struct EpiG3 { static constexpr bool PERM = true; unsigned char* ws;
    __device__ __forceinline__ void operator()(const acc_t& acc, const Unit& u, int wr, int wc, int fr, int fq) const {
        bf16_t* ys = (bf16_t*)(ws + WS_YS);
        EPI_ROWS(ai, m, rowl)
            const int crow = u.pm * 256 + rowl;
#pragma unroll
            for (int bj = 0; bj < 2; ++bj) { const int col = bj * 128 + wc * 32 + 8 * fq; const f32x4 v0 = acc[ai][bj][m][0], v1 = acc[ai][bj][m][1]; u32x4 o;
                o.x = pk2(gelu_f(v0.x), gelu_f(v0.y)); o.y = pk2(gelu_f(v0.z), gelu_f(v0.w)); o.z = pk2(gelu_f(v1.x), gelu_f(v1.y)); o.w = pk2(gelu_f(v1.z), gelu_f(v1.w));
                *(u32x4*)(ys + ((size_t)crow * 16 + (col >> 4)) * 512 + u.x0 * 16 + (col & 15)) = o; }
        EPI_END
    } };
struct SchedG4 { const unsigned char* ws; int G, c, mult;
    __device__ __forceinline__ bool next(int i, Unit& u) const { int L = i * G + c; if (L >= 256 * mult) return false; if (mult > 1) L %= 256; u.pm = L >> 1; u.pn = L & 1; u.x0 = 0; u.x1 = 0; u.arow = nullptr;
        u.A = (const char*)ws + WS_YS + (size_t)u.pm * 256 * 1024; u.B = (const char*)ws + WS_WGLU_T + (size_t)u.pn * 256 * 1024; return true; } };
struct EpiG4 { static constexpr bool PERM = true; unsigned char* ws; const float* bglu;
    __device__ __forceinline__ void operator()(const acc_t& acc, const Unit& u, int wr, int wc, int fr, int fq) const {
        const int colb = u.pn * 256 + wc * 32 + 8 * fq;
        const f32x4 b00 = *(const f32x4*)(bglu + colb), b01 = *(const f32x4*)(bglu + colb + 4), b10 = *(const f32x4*)(bglu + colb + 128), b11 = *(const f32x4*)(bglu + colb + 132);
#pragma unroll
        for (int ai = 0; ai < 2; ++ai) {
            u32x4 y[4][2];
#pragma unroll
            for (int m = 0; m < 4; ++m)
#pragma unroll
                for (int bj = 0; bj < 2; ++bj) y[m][bj] = *(const u32x4*)((const bf16_t*)(ws + WS_YS) + ((size_t)u.pm * 256 + ai * 128 + wr * 64 + m * 16 + fr) * 512 + colb + bj * 128);
#pragma unroll
            for (int m = 0; m < 4; ++m)
#pragma unroll
                for (int bj = 0; bj < 2; ++bj) { const f32x4 v0 = acc[ai][bj][m][0], v1 = acc[ai][bj][m][1]; const f32x4 b0 = bj ? b10 : b00, b1 = bj ? b11 : b01; const u32x4 yy = y[m][bj]; u32x4 o;
                    o.x = pk2(bflo(yy.x) * sigmoid_f(v0.x + b0.x), bfhi(yy.x) * sigmoid_f(v0.y + b0.y)); o.y = pk2(bflo(yy.y) * sigmoid_f(v0.z + b0.z), bfhi(yy.y) * sigmoid_f(v0.w + b0.w));
                    o.z = pk2(bflo(yy.z) * sigmoid_f(v1.x + b1.x), bfhi(yy.z) * sigmoid_f(v1.y + b1.y)); o.w = pk2(bflo(yy.w) * sigmoid_f(v1.z + b1.z), bfhi(yy.w) * sigmoid_f(v1.w + b1.w));
                    *(u32x4*)((bf16_t*)(ws + WS_YS5) + ((size_t)u.pm * 256 + ai * 128 + wr * 64 + m * 16 + fr) * 512 + colb + bj * 128) = o; }
        }
    } };
struct SchedG5 { const unsigned char* ws; int G, c, mult;
    __device__ __forceinline__ bool next(int i, Unit& u) const { int tile = (i >> 1) * G + c; if (tile >= 512 * mult) return false; if (mult > 1) tile %= 512; const int which = i & 1; u.pm = tile >> 2; u.pn = tile & 3; u.x0 = which; u.x1 = 0; u.arow = nullptr;
        u.A = (const char*)ws + (which ? WS_YSGU : WS_YS5) + (size_t)u.pm * 256 * 1024; u.B = (const char*)ws + (which ? WS_WBS_T : WS_WB5_T) + (size_t)u.pn * 256 * 1024; return true; } };
struct EpiG5 { static constexpr bool PERM = true; unsigned char* ws;
    __device__ __forceinline__ void operator()(const acc_t& acc, const Unit& u, int wr, int wc, int fr, int fq) const {
        const bf16_t* gate = (const bf16_t*)(ws + (u.x0 ? WS_SGS : WS_SG5)); bf16_t* mg = (bf16_t*)(ws + WS_MERGED);
        const int colb = u.pn * 256 + wc * 32 + 8 * fq;
#pragma unroll
        for (int ai = 0; ai < 2; ++ai) {
            u32x4 sg[4][2], q[4][2];
#pragma unroll
            for (int m = 0; m < 4; ++m)
#pragma unroll
                for (int bj = 0; bj < 2; ++bj) { const size_t off = ((size_t)u.pm * 256 + ai * 128 + wr * 64 + m * 16 + fr) * 1024 + colb + bj * 128;
                    sg[m][bj] = *(const u32x4*)(gate + off); q[m][bj] = u.x0 ? *(const u32x4*)(mg + off) : (u32x4){0u, 0u, 0u, 0u}; }
#pragma unroll
            for (int m = 0; m < 4; ++m)
#pragma unroll
                for (int bj = 0; bj < 2; ++bj) { const size_t off = ((size_t)u.pm * 256 + ai * 128 + wr * 64 + m * 16 + fr) * 1024 + colb + bj * 128;
                    const f32x4 v0 = acc[ai][bj][m][0], v1 = acc[ai][bj][m][1]; const u32x4 g = sg[m][bj], qq = q[m][bj]; u32x4 o;
                    o.x = pk2(v0.x * bflo(g.x) + bflo(qq.x), v0.y * bfhi(g.x) + bfhi(qq.x)); o.y = pk2(v0.z * bflo(g.y) + bflo(qq.y), v0.w * bfhi(g.y) + bfhi(qq.y));
                    o.z = pk2(v1.x * bflo(g.z) + bflo(qq.z), v1.y * bfhi(g.z) + bfhi(qq.z)); o.w = pk2(v1.z * bflo(g.w) + bflo(qq.w), v1.w * bfhi(g.w) + bfhi(qq.w));
                    *(u32x4*)(mg + off) = o; }
        }
    } };
struct SchedG6 { const unsigned char* ws; int G, c, mult;
    __device__ __forceinline__ bool next(int i, Unit& u) const { int L = i * G + c; if (L >= 512 * mult) return false; if (mult > 1) L %= 512; u.pm = L >> 2; u.pn = L & 3; u.x0 = 0; u.x1 = 0; u.arow = nullptr;
        u.A = (const char*)ws + WS_MERGED + (size_t)u.pm * 256 * 2048; u.B = (const char*)ws + WS_WOUT_T + (size_t)u.pn * 256 * 2048; return true; } };
struct EpiG6 { static constexpr bool PERM = true; unsigned char* ws;
    __device__ __forceinline__ void operator()(const acc_t& acc, const Unit& u, int wr, int wc, int fr, int fq) const {
        EPI_ROWS(ai, m, rowl)
            const size_t row = (size_t)u.pm * 256 + rowl; float ssq = 0.f;
#pragma unroll
            for (int bj = 0; bj < 2; ++bj) { const int col = u.pn * 256 + bj * 128 + wc * 32 + 8 * fq; const f32x4 v0 = acc[ai][bj][m][0], v1 = acc[ai][bj][m][1]; u32x4 o;
                o.x = pk2(v0.x, v0.y); o.y = pk2(v0.z, v0.w); o.z = pk2(v1.x, v1.y); o.w = pk2(v1.z, v1.w);
                ssq += (v0.x * v0.x + v0.y * v0.y) + (v0.z * v0.z + v0.w * v0.w) + (v1.x * v1.x + v1.y * v1.y) + (v1.z * v1.z + v1.w * v1.w);
                *(u32x4*)((bf16_t*)(ws + WS_MX) + row * 1024 + col) = o; }
            ssq += __shfl_xor(ssq, 16); ssq += __shfl_xor(ssq, 32); if (fq == 0) ((float*)(ws + WS_SSQM))[row * 16 + u.pn * 4 + wc] = ssq;
        EPI_END
    } };
struct SchedG7 { const unsigned char* ws; int G, c, mult;
    __device__ __forceinline__ bool next(int i, Unit& u) const { int L = i * G + c; if (L >= 128 * mult) return false; if (mult > 1) L %= 128; u.pm = L; u.pn = 0; u.x0 = 0; u.x1 = 0; u.arow = nullptr;
        u.A = (const char*)ws + WS_XN + (size_t)u.pm * 256 * 2048; u.B = (const char*)ws + WS_WR_T; return true; } };
struct EpiG7 { static constexpr bool PERM = false; unsigned char* ws;
    __device__ __forceinline__ void operator()(const acc_t& acc, const Unit& u, int wr, int wc, int fr, int fq) const {
        EPI_ROWS(ai, m, rowl)
            float* rp = (float*)(ws + WS_LOGITS) + ((size_t)u.pm * 256 + rowl) * 256 + wc * 32 + 4 * fq;
#pragma unroll
            for (int bj = 0; bj < 2; ++bj)
#pragma unroll
                for (int n = 0; n < 2; ++n) *(f32x4*)(rp + bj * 128 + n * 16) = acc[ai][bj][m][n];
        EPI_END
    } };
struct SchedG8 { const unsigned char* ws; int G, c, mult;
    __device__ __forceinline__ bool next(int i, Unit& u) const { const int* te = (const int*)(ws + WS_TILEEXP); const int ntile = te[1500]; int L = i * G + c; if (L >= ntile * 2 * mult) return false; if (mult > 1) L %= ntile * 2;
        const int t = L >> 1; u.pm = t; u.pn = L & 1; const int e = te[t]; u.x0 = e; u.x1 = 0; u.arow = (const int*)(ws + WS_TOKSLOT) + (size_t)t * 256;
        u.A = (const char*)ws + WS_XN; u.B = (const char*)ws + WS_WGU_T + ((size_t)e * 512 + (size_t)u.pn * 256) * 2048; return true; } };
struct EpiG8 { static constexpr bool PERM = true; unsigned char* ws;
    __device__ __forceinline__ void operator()(const acc_t& acc, const Unit& u, int wr, int wc, int fr, int fq) const {
        EPI_ROWS(ai, m, rowl)
            const size_t slot = (size_t)u.pm * 256 + rowl; const int col = u.pn * 128 + wc * 32 + 8 * fq;
            const f32x4 g0 = acc[ai][0][m][0], g1 = acc[ai][0][m][1], u0 = acc[ai][1][m][0], u1 = acc[ai][1][m][1]; u32x4 o;
            o.x = pk2(silu_f(g0.x) * u0.x, silu_f(g0.y) * u0.y); o.y = pk2(silu_f(g0.z) * u0.z, silu_f(g0.w) * u0.w);
            o.z = pk2(silu_f(g1.x) * u1.x, silu_f(g1.y) * u1.y); o.w = pk2(silu_f(g1.z) * u1.z, silu_f(g1.w) * u1.w);
            *(u32x4*)((bf16_t*)(ws + WS_H) + slot * 256 + col) = o;
        EPI_END
    } };
struct SchedG9 { const unsigned char* ws; int G, c, hf, mult;
    __device__ __forceinline__ bool next(int i, Unit& u) const { const int* te = (const int*)(ws + WS_TILEEXP); const int ntr = te[1500] - 128; int L = i * G + c; if (L >= ntr * 2 * mult) return false; if (mult > 1) L %= ntr * 2;
        const int t = L >> 1; u.pm = t; u.pn = L & 1; const int e = te[t]; u.x0 = e; u.x1 = 0; u.arow = nullptr;
        u.A = (const char*)ws + WS_H + (size_t)t * 256 * 512; u.B = (const char*)ws + WS_WD_T + ((size_t)e * 1024 + (size_t)(hf * 2 + u.pn) * 256) * 512; return true; } };
struct EpiG9 { static constexpr bool PERM = true; unsigned char* ws;
    __device__ __forceinline__ void operator()(const acc_t& acc, const Unit& u, int wr, int wc, int fr, int fq) const {
        EPI_ROWS(ai, m, rowl)
            const size_t slot = (size_t)u.pm * 256 + rowl;
            bf16_t* yp = (bf16_t*)(ws + WS_YSLOT) + slot * 512 + u.pn * 256 + wc * 32 + 8 * fq;
#pragma unroll
            for (int bj = 0; bj < 2; ++bj) { const f32x4 v0 = acc[ai][bj][m][0], v1 = acc[ai][bj][m][1]; u32x4 o;
                o.x = pk2(v0.x, v0.y); o.y = pk2(v0.z, v0.w); o.z = pk2(v1.x, v1.y); o.w = pk2(v1.z, v1.w);
                *(u32x4*)(yp + bj * 128) = o; }
        EPI_END
    } };
struct SchedG10 { const unsigned char* ws; int G, c, mult;
    __device__ __forceinline__ bool next(int i, Unit& u) const { const int* te = (const int*)(ws + WS_TILEEXP); const int ntr = te[1500] - 128; int L = i * G + c; if (L >= 512 * mult) return false; if (mult > 1) L %= 512;
        const int t = L >> 2; u.pm = t; u.pn = L & 3; u.x0 = ntr; u.x1 = 0; u.arow = nullptr;
        u.A = (const char*)ws + WS_H + (size_t)(ntr + t) * 256 * 512; u.B = (const char*)ws + WS_WD_T + ((size_t)NEXP * 1024 + (size_t)u.pn * 256) * 512; return true; } };
struct EpiG10 { static constexpr bool PERM = true; float* out;
    __device__ __forceinline__ void operator()(const acc_t& acc, const Unit& u, int wr, int wc, int fr, int fq) const {
        EPI_ROWS(ai, m, rowl)
            float* dp = out + ((size_t)u.pm * 256 + rowl) * 1024 + u.pn * 256 + wc * 32 + 8 * fq;
            *(f32x4*)dp = acc[ai][0][m][0]; *(f32x4*)(dp + 4) = acc[ai][0][m][1]; *(f32x4*)(dp + 128) = acc[ai][1][m][0]; *(f32x4*)(dp + 132) = acc[ai][1][m][1];
        EPI_END
    } };

__device__ __forceinline__ void phase_sgu(const Params& p, ldsp_t lds) {
    const int tid = threadIdx.x, lane = tid & 63, wave = tid >> 6, fr = lane & 15, fq = lane >> 4, G = gridDim.x;
    constexpr int PITCH = 272;
    ldsp_t Wl = lds; ldsp_t VT = lds + 128 * PITCH; LAS float* rs = (LAS float*)(lds + 128 * PITCH + 64 * PITCH);
    const bf16_t* sguw = (const bf16_t*)(p.ws + WS_SGUW); const bf16_t* gv = (const bf16_t*)(p.ws + WS_GV); const bf16_t* gu = (const bf16_t*)(p.ws + WS_GU);
    const float* ssq = (const float*)(p.ws + WS_SSQV); const float* gn = p.in[21]; const float* bs = p.in[23];
    bf16_t* yo = (bf16_t*)(p.ws + WS_YSGU);
    for (int it = blockIdx.x; it < 2048; it += G) {
        const int chunk = it & 255, h = it >> 8; const size_t tok0 = (size_t)chunk * 128;
        __syncthreads();
        if (tid < 128) { const float* q = ssq + (tok0 + tid) * 8; const f32x4 a = *(const f32x4*)q, b = *(const f32x4*)(q + 4);
            rs[tid] = rsqrtf(((a.x + a.y) + (a.z + a.w) + (b.x + b.y) + (b.z + b.w)) * (1.0f / 512.0f) + EPS); }
#pragma unroll
        for (int i = 0; i < 4; ++i) { const int pc = tid + i * NT, row = pc >> 4, cp = pc & 15;
            *(LAS u32x4*)(Wl + row * PITCH + cp * 16) = *(const u32x4*)(sguw + ((size_t)h * 128 + row) * 128 + cp * 8); }
        __syncthreads();
#pragma unroll
        for (int i = 0; i < 2; ++i) { const int pc = tid + i * NT, s = pc >> 3, c8 = (pc & 7) * 8; const float r = rs[s];
            const u32x4 v = *(const u32x4*)(gv + (tok0 + s) * 512 + h * 64 + c8);
            LAS bf16_t* d = (LAS bf16_t*)(VT + c8 * PITCH + s * 2);
            d[0 * (PITCH / 2)] = (bf16_t)f2bf(bflo(v.x) * r); d[1 * (PITCH / 2)] = (bf16_t)f2bf(bfhi(v.x) * r); d[2 * (PITCH / 2)] = (bf16_t)f2bf(bflo(v.y) * r); d[3 * (PITCH / 2)] = (bf16_t)f2bf(bfhi(v.y) * r);
            d[4 * (PITCH / 2)] = (bf16_t)f2bf(bflo(v.z) * r); d[5 * (PITCH / 2)] = (bf16_t)f2bf(bfhi(v.z) * r); d[6 * (PITCH / 2)] = (bf16_t)f2bf(bflo(v.w) * r); d[7 * (PITCH / 2)] = (bf16_t)f2bf(bfhi(v.w) * r); }
        __syncthreads();
        f32x4 acc[4] = {(f32x4){0.f, 0.f, 0.f, 0.f}, (f32x4){0.f, 0.f, 0.f, 0.f}, (f32x4){0.f, 0.f, 0.f, 0.f}, (f32x4){0.f, 0.f, 0.f, 0.f}};
        const int t0 = wave * 16;
#pragma unroll
        for (int ks = 0; ks < 4; ++ks) {
            const bf16x8 bfr = *(const LAS bf16x8*)(Wl + (t0 + fr) * PITCH + (ks * 32 + 8 * fq) * 2);
#pragma unroll
            for (int mb = 0; mb < 4; ++mb) { const bf16x8 afr = *(const LAS bf16x8*)(VT + (mb * 16 + fr) * PITCH + (ks * 32 + 8 * fq) * 2);
                acc[mb] = __builtin_amdgcn_mfma_f32_16x16x32_bf16(afr, bfr, acc[mb], 0, 0, 0); }
        }
        const int t = t0 + fr; const float bt = bs[h * 128 + t];
#pragma unroll
        for (int mb = 0; mb < 4; ++mb) { const int c = h * 64 + mb * 16 + 4 * fq; const f32x4 gg = *(const f32x4*)(gn + c);
            const u32x2 uu = *(const u32x2*)(gu + (tok0 + t) * 512 + c); u32x2 o;
            o.x = pk2(bflo(uu.x) * (acc[mb].x * gg.x + bt), bfhi(uu.x) * (acc[mb].y * gg.y + bt)); o.y = pk2(bflo(uu.y) * (acc[mb].z * gg.z + bt), bfhi(uu.y) * (acc[mb].w * gg.w + bt));
            *(u32x2*)(yo + (tok0 + t) * 512 + c) = o; }
    }
    __syncthreads();
}

__device__ __forceinline__ size_t carry_row(int b, int d, int q) { return (q < 16) ? (size_t)(2048 + b * 16 + (d ? 15 - q : q)) : (size_t)(b * 512 + (d ? 511 - (q - 16) : (q - 16))); }
__device__ __forceinline__ void phase_carry(const Params& p, ldsp_t lds) {
    const int tid = threadIdx.x, lane = tid & 63, wave = tid >> 6, G = gridDim.x;
    const float* APL = (const float*)(p.ws + WS_APL);
    LAS f32x2* seg = (LAS f32x2*)lds;
    for (int s = blockIdx.x; s < 256; s += G) {
        const int d = s & 1, g = (s >> 1) & 31, b = s >> 6;
        const float ar = APL[((d * 32 + g) * 64 + lane) * 2], ai = APL[((d * 32 + g) * 64 + lane) * 2 + 1];
        const float* Eg = (const float*)(p.ws + WS_E) + (size_t)g * UC_ROWS * 256 + d * 128 + lane;
        bf16_t* Ug = (bf16_t*)(p.ws + WS_UCAT) + (size_t)g * UC_ROWS * 512 + 256 + d * 128 + lane;
        const int q0 = wave * 66;
        float cr = 0.f, ci = 0.f;
#pragma unroll 1
        for (int j0 = 0; j0 < 66; j0 += 11) {
            float er[11], ei[11];
#pragma unroll
            for (int j = 0; j < 11; ++j) { const size_t row = carry_row(b, d, q0 + j0 + j); er[j] = Eg[row * 256]; ei[j] = Eg[row * 256 + 64]; }
#pragma unroll
            for (int j = 0; j < 11; ++j) { const float nr = ar * cr - ai * ci + er[j], ni = ar * ci + ai * cr + ei[j]; cr = nr; ci = ni; }
        }
        __syncthreads();
        seg[wave * 64 + lane] = (f32x2){cr, ci};
        __syncthreads();
        float p2r = ar * ar - ai * ai, p2i = 2.f * ar * ai, pr = p2r, pi = p2i;
#pragma unroll
        for (int k = 0; k < 5; ++k) { const float nr = pr * pr - pi * pi, ni = 2.f * pr * pi; pr = nr; pi = ni; }
        const float Ar = pr * p2r - pi * p2i, Ai = pr * p2i + pi * p2r;
        cr = 0.f; ci = 0.f;
        for (int w = 0; w < wave; ++w) { const f32x2 e = seg[w * 64 + lane]; const float nr = Ar * cr - Ai * ci + e.x, ni = Ar * ci + Ai * cr + e.y; cr = nr; ci = ni; }
#pragma unroll 1
        for (int j0 = 0; j0 < 66; j0 += 11) {
            float er[11], ei[11];
#pragma unroll
            for (int j = 0; j < 11; ++j) { const size_t row = carry_row(b, d, q0 + j0 + j); er[j] = Eg[row * 256]; ei[j] = Eg[row * 256 + 64]; }
#pragma unroll
            for (int j = 0; j < 11; ++j) { const int q = q0 + j0 + j;
                if (q >= 16) { const size_t row = carry_row(b, d, q); Ug[row * 512] = (bf16_t)f2bf(cr); Ug[row * 512 + 64] = (bf16_t)f2bf(ci); }
                const float nr = ar * cr - ai * ci + er[j], ni = ar * ci + ai * cr + ei[j]; cr = nr; ci = ni; }
        }
    }
    __syncthreads();
}

__device__ __forceinline__ void phase_r1(const Params& p) {
    const int tid = threadIdx.x, lane = tid & 63, wave = tid >> 6, G = gridDim.x;
    const float* mod = (const float*)(p.ws + WS_MOD); const float* gpm = p.in[7]; const float* gpf = p.in[8];
    for (int row = blockIdx.x * 8 + wave; row < NTOK; row += G * 8) {
        const int b = row >> 13; const float* mb = mod + (size_t)b * 6144;
        const float* sq = (const float*)(p.ws + WS_SSQM) + (size_t)row * 16; float s0 = 0.f;
#pragma unroll
        for (int j = 0; j < 4; ++j) { const f32x4 q = *(const f32x4*)(sq + 4 * j); s0 += (q.x + q.y) + (q.z + q.w); }
        const float rm = rsqrtf(s0 * (1.0f / DM) + EPS);
        f32x4 x1[4]; float s = 0.f;
#pragma unroll
        for (int j = 0; j < 4; ++j) { const int c = 4 * lane + 256 * j; const f32x4 xv = __builtin_nontemporal_load((const f32x4*)(p.in[0] + (size_t)row * DM + c));
            const u32x2 mv = *(const u32x2*)((const bf16_t*)(p.ws + WS_MX) + (size_t)row * DM + c); const f32x4 gt = *(const f32x4*)(mb + 2048 + c), gg = *(const f32x4*)(gpm + c);
            x1[j].x = xv.x + gt.x * (bflo(mv.x) * rm * gg.x); x1[j].y = xv.y + gt.y * (bfhi(mv.x) * rm * gg.y); x1[j].z = xv.z + gt.z * (bflo(mv.y) * rm * gg.z); x1[j].w = xv.w + gt.w * (bfhi(mv.y) * rm * gg.w);
            s += (x1[j].x * x1[j].x + x1[j].y * x1[j].y) + (x1[j].z * x1[j].z + x1[j].w * x1[j].w); }
        const float r1 = rsqrtf(wave_sum(s) * (1.0f / DM) + EPS);
        bf16_t* dst = (bf16_t*)(p.ws + WS_XN) + (size_t)row * DM;
#pragma unroll
        for (int j = 0; j < 4; ++j) { const int c = 4 * lane + 256 * j; const f32x4 gg = *(const f32x4*)(gpf + c), sh = *(const f32x4*)(mb + 3072 + c), sc = *(const f32x4*)(mb + 4096 + c); u32x2 o;
            o.x = pk2(x1[j].x * r1 * gg.x * (1.f + sc.x) + sh.x, x1[j].y * r1 * gg.y * (1.f + sc.y) + sh.y); o.y = pk2(x1[j].z * r1 * gg.z * (1.f + sc.z) + sh.z, x1[j].w * r1 * gg.w * (1.f + sc.w) + sh.w);
            *(u32x2*)(dst + c) = o; }
    }
}

__device__ __forceinline__ void phase_route(const Params& p, ldsp_t lds) {
    const int tid = threadIdx.x, lane = tid & 63, wave = tid >> 6, G = gridDim.x;
    LAS int* hist = (LAS int*)lds;
    const float* rb = p.in[28]; const f32x4 bias = *(const f32x4*)(rb + 4 * lane);
    for (int tile = blockIdx.x; tile < 256; tile += G) {
        __syncthreads();
        if (tid < 256) hist[tid] = 0;
        __syncthreads();
        for (int rr = wave * 16; rr < wave * 16 + 16; rr += 2) {
            float sc[2][4], sel[2][4];
#pragma unroll
            for (int t = 0; t < 2; ++t) { const int row = tile * 128 + rr + t;
                const f32x4 lg = *(const f32x4*)((const float*)(p.ws + WS_LOGITS) + (size_t)row * 256 + 4 * lane);
                sc[t][0] = sigmoid_f(lg.x); sc[t][1] = sigmoid_f(lg.y); sc[t][2] = sigmoid_f(lg.z); sc[t][3] = sigmoid_f(lg.w);
                sel[t][0] = sc[t][0] + bias.x; sel[t][1] = sc[t][1] + bias.y; sel[t][2] = sc[t][2] + bias.z; sel[t][3] = sc[t][3] + bias.w; }
#pragma unroll
            for (int t = 0; t < 2; ++t) {
                float m1 = fmaxf(sel[t][0], sel[t][1]), m2 = fminf(sel[t][0], sel[t][1]);
                { const float a = fmaxf(sel[t][2], sel[t][3]), bb = fminf(sel[t][2], sel[t][3]); const float n1 = fmaxf(m1, a); const float n2 = fmaxf(fminf(m1, a), fmaxf(m2, bb)); m1 = n1; m2 = n2; }
                { const float a = dpp_f<0xB1>(m1, m1), bb = dpp_f<0xB1>(m2, m2); const float n1 = fmaxf(m1, a); const float n2 = fmaxf(fminf(m1, a), fmaxf(m2, bb)); m1 = n1; m2 = n2; }
                { const float a = dpp_f<0x4E>(m1, m1), bb = dpp_f<0x4E>(m2, m2); const float n1 = fmaxf(m1, a); const float n2 = fmaxf(fminf(m1, a), fmaxf(m2, bb)); m1 = n1; m2 = n2; }
                { const float a = dpp_f<0x114>(-__builtin_inff(), m1), bb = dpp_f<0x114>(-__builtin_inff(), m2); const float n1 = fmaxf(m1, a); const float n2 = fmaxf(fminf(m1, a), fmaxf(m2, bb)); m1 = n1; m2 = n2; }
                const float gsv = m1 + m2; float gs[8];
#pragma unroll
                for (int g2 = 0; g2 < 8; ++g2) gs[g2] = __builtin_bit_cast(float, __builtin_amdgcn_readlane(__builtin_bit_cast(int, gsv), 8 * g2 + 7));
                unsigned gmask = 0u;
#pragma unroll
                for (int g1 = 0; g1 < 8; ++g1) { int rank = 0;
#pragma unroll
                    for (int g2 = 0; g2 < 8; ++g2) rank += (gs[g2] > gs[g1] || (gs[g2] == gs[g1] && g2 < g1)) ? 1 : 0;
                    gmask |= (rank < 4) ? (1u << g1) : 0u; }
                if (!((gmask >> (lane >> 3)) & 1u)) { sel[t][0] = -__builtin_inff(); sel[t][1] = -__builtin_inff(); sel[t][2] = -__builtin_inff(); sel[t][3] = -__builtin_inff(); }
            }
            float wk[2] = {0.f, 0.f}, wsum[2] = {0.f, 0.f}; int ek[2] = {0, 0};
#pragma unroll 1
            for (int k = 0; k < 8; ++k) {
#pragma unroll
                for (int t = 0; t < 2; ++t) {
                    const float bv = fmaxf(fmaxf(sel[t][0], sel[t][1]), fmaxf(sel[t][2], sel[t][3]));
                    const int j = (sel[t][0] == bv) ? 0 : (sel[t][1] == bv) ? 1 : (sel[t][2] == bv) ? 2 : 3;
                    const float s_c = (j == 0) ? sc[t][0] : (j == 1) ? sc[t][1] : (j == 2) ? sc[t][2] : sc[t][3];
                    const float v = wave_max_dpp(bv);
                    const unsigned long long bal = __ballot(bv == v);
                    const int wl = __builtin_amdgcn_readfirstlane(__builtin_ctzll(bal));
                    const float s_w = __builtin_bit_cast(float, __builtin_amdgcn_readlane(__builtin_bit_cast(int, s_c), wl));
                    const int e_w = 4 * wl + __builtin_amdgcn_readlane(j, wl);
                    if (lane == wl) { if (j == 0) sel[t][0] = -__builtin_inff(); else if (j == 1) sel[t][1] = -__builtin_inff(); else if (j == 2) sel[t][2] = -__builtin_inff(); else sel[t][3] = -__builtin_inff(); }
                    wsum[t] += s_w; if (lane == k) { wk[t] = s_w; ek[t] = e_w; }
                }
            }
#pragma unroll
            for (int t = 0; t < 2; ++t) if (lane < 8) { const int row = tile * 128 + rr + t; const float w = wk[t] / wsum[t] * 2.5f;
                ((int*)(p.ws + WS_IDX))[(size_t)row * 8 + lane] = ek[t]; ((float*)(p.ws + WS_WT))[(size_t)row * 8 + lane] = w; __hip_atomic_fetch_add(&hist[ek[t]], 1, __ATOMIC_RELAXED, __HIP_MEMORY_SCOPE_WORKGROUP); }
        }
        __syncthreads();
        if (tid < 256) ((int*)(p.ws + WS_BLKCNT))[tile * 256 + tid] = hist[tid];
    }
    __syncthreads();
}
__device__ __forceinline__ void phase_scan(const Params& p, ldsp_t lds) {
    const int tid = threadIdx.x, G = gridDim.x; LAS int* sm = (LAS int*)lds;
    for (int e = blockIdx.x; e < 256; e += G) {
        __syncthreads();
        int v = 0; if (tid < 256) { v = ((const int*)(p.ws + WS_BLKCNT))[tid * 256 + e]; sm[tid] = v; }
        __syncthreads();
        for (int o = 1; o < 256; o <<= 1) { int t = 0; if (tid < 256 && tid >= o) t = sm[tid - o]; __syncthreads(); if (tid < 256) sm[tid] += t; __syncthreads(); }
        if (tid < 256) { ((int*)(p.ws + WS_BLKOFF))[tid * 256 + e] = sm[tid] - v; if (tid == 255) ((int*)(p.ws + WS_TOTAL))[e] = sm[255]; }
    }
    __syncthreads();
}
__device__ __forceinline__ void phase_scatter(const Params& p, ldsp_t lds) {
    const int tid = threadIdx.x, G = gridDim.x; LAS int* pst = (LAS int*)lds; LAS int* cnt = (LAS int*)(lds + 2048); LAS int* tot = (LAS int*)(lds + 4096);
    int* tokslot = (int*)(p.ws + WS_TOKSLOT); float* wslot = (float*)(p.ws + WS_WSLOT); int* te = (int*)(p.ws + WS_TILEEXP);
    int mytot = 0, mypad = 0;
    if (tid < 256) { mytot = ((const int*)(p.ws + WS_TOTAL))[tid]; mypad = (mytot + 255) & ~255; pst[tid] = mypad; tot[tid] = mytot; }
    __syncthreads();
    for (int o = 1; o < 256; o <<= 1) { int t = 0; if (tid < 256 && tid >= o) t = pst[tid - o]; __syncthreads(); if (tid < 256) pst[tid] += t; __syncthreads(); }
    const int pend_all = pst[255];
    __syncthreads();
    if (tid < 256) pst[tid] -= mypad;
    __syncthreads();
    const int ntr = pend_all >> 8;
    if (blockIdx.x == 0 && tid == 0) te[1500] = ntr + 128;
    for (int e = blockIdx.x; e < 256; e += G) { const int s0 = pst[e], n = tot[e], pe = s0 + ((n + 255) & ~255);
        for (int t = (s0 >> 8) + tid; t < (pe >> 8); t += NT) te[t] = e;
        for (int s = s0 + n + tid; s < pe; s += NT) { tokslot[s] = 0; wslot[s] = 0.f; } }
    for (int t = blockIdx.x * NT + tid; t < NTOK; t += G * NT) { tokslot[pend_all + t] = t; wslot[pend_all + t] = 1.0f; if (t < 128) te[ntr + t] = NEXP; }
    for (int tile = blockIdx.x; tile < 256; tile += G) {
        __syncthreads();
        if (tid < 256) cnt[tid] = 0;
        __syncthreads();
        for (int q = tid; q < 1024; q += NT) { const int row = tile * 128 + (q >> 3), k = q & 7; const int e = ((const int*)(p.ws + WS_IDX))[(size_t)row * 8 + k];
            const int r = __hip_atomic_fetch_add(&cnt[e], 1, __ATOMIC_RELAXED, __HIP_MEMORY_SCOPE_WORKGROUP); const int slot = pst[e] + ((const int*)(p.ws + WS_BLKOFF))[tile * 256 + e] + r;
            tokslot[slot] = row; wslot[slot] = ((const float*)(p.ws + WS_WT))[(size_t)row * 8 + k]; ((int*)(p.ws + WS_SLOT))[(size_t)row * 8 + k] = slot; }
    }
    __syncthreads();
}

__device__ __forceinline__ void phase_r3a(const Params& p) {
    const int tid = threadIdx.x, lane = tid & 63, wave = tid >> 6, G = gridDim.x;
    const bf16_t* ys = (const bf16_t*)(p.ws + WS_YSLOT);
    for (int row = blockIdx.x * 8 + wave; row < NTOK; row += G * 8) {
        const int* sl = (const int*)(p.ws + WS_SLOT) + (size_t)row * 8; const float* wt = (const float*)(p.ws + WS_WT) + (size_t)row * 8; float* dp = p.out + (size_t)row * DM + 8 * lane;
        f32x4 a0 = *(const f32x4*)dp, a1 = *(const f32x4*)(dp + 4);
#pragma unroll
        for (int k = 0; k < 8; ++k) { const u32x4 v = __builtin_nontemporal_load((const u32x4*)(ys + (size_t)sl[k] * 512 + 8 * lane)); const float w = wt[k];
            a0.x += w * bflo(v.x); a0.y += w * bfhi(v.x); a0.z += w * bflo(v.y); a0.w += w * bfhi(v.y); a1.x += w * bflo(v.z); a1.y += w * bfhi(v.z); a1.z += w * bflo(v.w); a1.w += w * bfhi(v.w); }
        *(f32x4*)dp = a0; *(f32x4*)(dp + 4) = a1;
    }
}
__device__ __forceinline__ void phase_r3b(const Params& p) {
    const int tid = threadIdx.x, lane = tid & 63, wave = tid >> 6, G = gridDim.x;
    const bf16_t* ys = (const bf16_t*)(p.ws + WS_YSLOT); const float* mod = (const float*)(p.ws + WS_MOD); const float* gpm = p.in[7]; const float* gpo = p.in[9];
    for (int row = blockIdx.x * 8 + wave; row < NTOK; row += G * 8) {
        const int b = row >> 13; const float* mb = mod + (size_t)b * 6144;
        const int* sl = (const int*)(p.ws + WS_SLOT) + (size_t)row * 8; const float* wt = (const float*)(p.ws + WS_WT) + (size_t)row * 8; float* orow = p.out + (size_t)row * DM;
        f32x4 f0 = *(const f32x4*)(orow + 8 * lane), f1 = *(const f32x4*)(orow + 8 * lane + 4), f2 = *(const f32x4*)(orow + 512 + 8 * lane), f3 = *(const f32x4*)(orow + 512 + 8 * lane + 4);
#pragma unroll
        for (int k = 0; k < 8; ++k) { const u32x4 v = __builtin_nontemporal_load((const u32x4*)(ys + (size_t)sl[k] * 512 + 8 * lane)); const float w = wt[k];
            f2.x += w * bflo(v.x); f2.y += w * bfhi(v.x); f2.z += w * bflo(v.y); f2.w += w * bfhi(v.y); f3.x += w * bflo(v.z); f3.y += w * bfhi(v.z); f3.z += w * bflo(v.w); f3.w += w * bfhi(v.w); }
        float s = (f0.x * f0.x + f0.y * f0.y) + (f0.z * f0.z + f0.w * f0.w) + (f1.x * f1.x + f1.y * f1.y) + (f1.z * f1.z + f1.w * f1.w)
                + (f2.x * f2.x + f2.y * f2.y) + (f2.z * f2.z + f2.w * f2.w) + (f3.x * f3.x + f3.y * f3.y) + (f3.z * f3.z + f3.w * f3.w);
        const float rf = rsqrtf(wave_sum(s) * (1.0f / DM) + EPS);
        const float* sq = (const float*)(p.ws + WS_SSQM) + (size_t)row * 16; float s0 = 0.f;
#pragma unroll
        for (int j = 0; j < 4; ++j) { const f32x4 q = *(const f32x4*)(sq + 4 * j); s0 += (q.x + q.y) + (q.z + q.w); }
        const float rm = rsqrtf(s0 * (1.0f / DM) + EPS);
#pragma unroll
        for (int hh = 0; hh < 2; ++hh) { const int c = hh * 512 + 8 * lane; const f32x4 fa = hh ? f2 : f0, fb = hh ? f3 : f1;
            const f32x4 xa = __builtin_nontemporal_load((const f32x4*)(p.in[0] + (size_t)row * DM + c)), xb = __builtin_nontemporal_load((const f32x4*)(p.in[0] + (size_t)row * DM + c + 4));
            const u32x4 mv = __builtin_nontemporal_load((const u32x4*)((const bf16_t*)(p.ws + WS_MX) + (size_t)row * DM + c));
            const f32x4 gma = *(const f32x4*)(mb + 2048 + c), gmb = *(const f32x4*)(mb + 2048 + c + 4), gfa = *(const f32x4*)(mb + 5120 + c), gfb = *(const f32x4*)(mb + 5120 + c + 4);
            const f32x4 pma = *(const f32x4*)(gpm + c), pmb = *(const f32x4*)(gpm + c + 4), poa = *(const f32x4*)(gpo + c), pob = *(const f32x4*)(gpo + c + 4);
            f32x4 oa, ob;
            oa.x = xa.x + gma.x * (bflo(mv.x) * rm * pma.x) + gfa.x * (fa.x * rf * poa.x); oa.y = xa.y + gma.y * (bfhi(mv.x) * rm * pma.y) + gfa.y * (fa.y * rf * poa.y);
            oa.z = xa.z + gma.z * (bflo(mv.y) * rm * pma.z) + gfa.z * (fa.z * rf * poa.z); oa.w = xa.w + gma.w * (bfhi(mv.y) * rm * pma.w) + gfa.w * (fa.w * rf * poa.w);
            ob.x = xb.x + gmb.x * (bflo(mv.z) * rm * pmb.x) + gfb.x * (fb.x * rf * pob.x); ob.y = xb.y + gmb.y * (bfhi(mv.z) * rm * pmb.y) + gfb.y * (fb.y * rf * pob.y);
            ob.z = xb.z + gmb.z * (bflo(mv.w) * rm * pmb.z) + gfb.z * (fb.z * rf * pob.z); ob.w = xb.w + gmb.w * (bfhi(mv.w) * rm * pmb.w) + gfb.w * (fb.w * rf * pob.w);
            __builtin_nontemporal_store(oa, (f32x4*)(orow + c)); __builtin_nontemporal_store(ob, (f32x4*)(orow + c + 4)); }
    }
}

#define XB_TMO      128
#define XB_XCNT(j)  (256  + 64 * (j))
#define XB_XSUB(j)  (1280 + 64 * (j))
#define XB_XGEN(j)  (2304 + 64 * (j))
#define XB_TOP      3328
#define XB_TOPGEN   3392
#define XCD_BAR_WORDS 3456
#define XB_SPIN_CAP (1u << 18)
__device__ __forceinline__ unsigned xb_ld(unsigned* p)              { return __hip_atomic_load(p, __ATOMIC_RELAXED, __HIP_MEMORY_SCOPE_AGENT); }
__device__ __forceinline__ unsigned xb_add(unsigned* p, unsigned v) { return __hip_atomic_fetch_add(p, v, __ATOMIC_RELAXED, __HIP_MEMORY_SCOPE_AGENT); }
__device__ __forceinline__ unsigned xb_xcc_id() { return (unsigned)__builtin_amdgcn_s_getreg((3 << 11) | 20) & 0xFu; }
#define XB_SPIN(cond, bar) do { unsigned _sp = 0; while (cond) { __builtin_amdgcn_s_sleep(1); \
    if ((++_sp & 255u) == 0u) { if (xb_ld(&(bar)[XB_TMO])) break; if (_sp > XB_SPIN_CAP) { atomicAdd(&(bar)[XB_TMO], 1u); break; } } } } while (0)
struct XcdBarrier { unsigned* bar; unsigned x; volatile LAS unsigned* st; };
__device__ __forceinline__ XcdBarrier xcd_barrier_post(unsigned* bar, volatile LAS unsigned* st) {
    XcdBarrier b; b.bar = bar; b.x = xb_xcc_id(); b.st = st;
    if (threadIdx.x == 0) (void)xb_add(&bar[XB_XCNT(b.x)], 1u);
    return b;
}
__device__ __forceinline__ void xcd_barrier_complete(unsigned* bar, unsigned x, unsigned& nloc, unsigned& nx) {
    const unsigned G = gridDim.x * gridDim.y * gridDim.z;
    unsigned sum, cnt, mine, sp = 0u;
    for (;;) {
        sum = 0u; cnt = 0u; mine = 0u;
#pragma unroll
        for (unsigned j = 0; j < 16; ++j) { const unsigned c = xb_ld(&bar[XB_XCNT(j)]); sum += c; cnt += (c > 0u) ? 1u : 0u; mine = (j == x) ? c : mine; }
        if (sum == G) break;
        __builtin_amdgcn_s_sleep(1);
        if ((++sp & 255u) == 0u) { if (xb_ld(&bar[XB_TMO])) break; if (sp > XB_SPIN_CAP) { atomicAdd(&bar[XB_TMO], 1u); break; } }
    }
    nloc = mine > 0u ? mine : 1u; nx = cnt > 0u ? cnt : 1u;
}
__device__ __forceinline__ void xcd_barrier(const XcdBarrier& b) {
    asm volatile("s_waitcnt vmcnt(0)" ::: "memory");
    __syncthreads();
    if (threadIdx.x == 0) {
        unsigned* bar = b.bar;
        __builtin_amdgcn_s_waitcnt(0);
        unsigned nloc = b.st[0], nx = b.st[1];
        if (nloc == 0u) { xcd_barrier_complete(bar, b.x, nloc, nx); b.st[0] = nloc; b.st[1] = nx; }
        const unsigned old = xb_add(&bar[XB_XSUB(b.x)], 1u);
        const unsigned gen = old / nloc;
        if (old + 1u == (gen + 1u) * nloc) {
            __builtin_amdgcn_fence(__ATOMIC_RELEASE, "agent");
            asm volatile("s_waitcnt vmcnt(0)" ::: "memory");
            const unsigned og = xb_add(&bar[XB_TOP], 1u);
            const unsigned tg = og / nx;
            if (og + 1u == (tg + 1u) * nx) xb_add(&bar[XB_TOPGEN], 1u);
            else XB_SPIN(xb_ld(&bar[XB_TOPGEN]) == tg, bar);
            __builtin_amdgcn_fence(__ATOMIC_ACQUIRE, "agent");
            xb_add(&bar[XB_XGEN(b.x)], 1u);
            asm volatile("s_waitcnt vmcnt(0)" ::: "memory");
        } else {
            XB_SPIN(xb_ld(&bar[XB_XGEN(b.x)]) == gen, bar);
            __builtin_amdgcn_fence(__ATOMIC_ACQUIRE, "agent");
            asm volatile("s_waitcnt vmcnt(0)" ::: "memory");
        }
    }
    __syncthreads();
}

constexpr int N_PHASES = 21;
__global__ void __launch_bounds__(NT, 2) fwd_kernel(Params p) {
    extern __shared__ __attribute__((aligned(16))) unsigned char lds_raw[];
    ldsp_t lds = (ldsp_t)lds_raw;
    const int G = gridDim.x, c = (G % 8 == 0) ? (int)(blockIdx.x % 8) * (G / 8) + (int)(blockIdx.x / 8) : (int)blockIdx.x;
    const int lo = p.ph_lo, hi = p.ph_hi;
    volatile LAS unsigned* bst = (volatile LAS unsigned*)(lds + LDS_BYTES - 16);
    if (threadIdx.x < 4) bst[threadIdx.x] = 0u;
    __syncthreads();
    XcdBarrier bar = xcd_barrier_post((unsigned*)p.ws, bst);
    unsigned long long spin_acc = 0;
#ifdef ONLY_PHASE
#define IN(k) ((k) == ONLY_PHASE && lo <= (k) && (k) < hi)
#else
#define IN(k) (lo <= (k) && (k) < hi)
#endif
#define TS_BEGIN(k) unsigned long long ts0_ = 0; if (SPIN_PHASE == (k)) ts0_ = __builtin_amdgcn_s_memrealtime();
#define TS_END(k) if (SPIN_PHASE == (k)) spin_acc += __builtin_amdgcn_s_memrealtime() - ts0_;
#define PH(k, ...) if (IN(k)) { TS_BEGIN(k) const int nrep_ = (DUP_PHASE == (k)) ? (1 + DUP_REPS + lo) : 1; _Pragma("nounroll") for (int r_ = 0; r_ < nrep_; ++r_) { if (r_) xcd_barrier(bar); __VA_ARGS__ } SEAM(k); TS_END(k) }
#define PG(k, ...) if (IN(k)) { TS_BEGIN(k) __VA_ARGS__ SEAM(k); TS_END(k) }
#define MULT(k) ((DUP_PHASE == (k)) ? (1 + DUP_REPS) : 1)
#define SEAM(k) do { if (IN((k) + 1)) { if ((k) == 0) cg::this_grid().sync(); else xcd_barrier(bar); } } while (0)
    PH(0, phase_prep(p, lds);)
    PH(1, phase_xn(p, lds);)
    PG(2, SchedG1 S{p.ws, G, c, MULT(2)}; EpiG1 E{p.ws}; pg8::gemm_phase<EpiG1, SchedG1, false>(lds, 1024, 2048u, 2048u, S, E);)
    PG(3, SchedG2 S{p.ws, G, c, MULT(3)}; EpiG2 E{p.ws}; pg8::gemm_phase<EpiG2, SchedG2, false>(lds, 256, 1024u, 512u, S, E);)
    PH(4, if (r_ == 0 || DUP_SUB != 1) phase_carry(p, lds); if (r_ == 0 || DUP_SUB != 0) phase_sgu(p, lds);)
    PG(5, SchedG3 S{p.ws, G, c, MULT(5)}; EpiG3 E{p.ws}; pg8::gemm_phase<EpiG3, SchedG3, false>(lds, 512, 1024u, 1024u, S, E);)
    PG(6, SchedG4 S{p.ws, G, c, MULT(6)}; EpiG4 E{p.ws, p.in[20]}; pg8::gemm_phase<EpiG4, SchedG4, false>(lds, 512, 1024u, 1024u, S, E);)
    PG(7, SchedG5 S{p.ws, G, c, MULT(7)}; EpiG5 E{p.ws}; pg8::gemm_phase<EpiG5, SchedG5, false>(lds, 512, 1024u, 1024u, S, E);)
    PG(8, SchedG6 S{p.ws, G, c, MULT(8)}; EpiG6 E{p.ws}; pg8::gemm_phase<EpiG6, SchedG6, false>(lds, 1024, 2048u, 2048u, S, E);)
    PH(9, phase_r1(p);)
    PG(10, SchedG7 S{p.ws, G, c, MULT(10)}; EpiG7 E{p.ws}; pg8::gemm_phase<EpiG7, SchedG7, false>(lds, 1024, 2048u, 2048u, S, E);)
    PH(11, phase_route(p, lds);)
    PH(12, phase_scan(p, lds);)
    PH(13, phase_scatter(p, lds);)
    PG(14, SchedG8 S{p.ws, G, c, MULT(14)}; EpiG8 E{p.ws}; pg8::gemm_phase<EpiG8, SchedG8, true>(lds, 1024, 2048u, 2048u, S, E);)
    PG(15, { SchedG9 S{p.ws, G, c, 0, MULT(15)}; EpiG9 E{p.ws}; pg8::gemm_phase<EpiG9, SchedG9, false>(lds, 256, 512u, 512u, S, E); } { SchedG10 S{p.ws, G, c, MULT(19)}; EpiG10 E{p.out}; pg8::gemm_phase<EpiG10, SchedG10, false>(lds, 256, 512u, 512u, S, E); })
    PH(16, phase_r3a(p);)
    PG(17, SchedG9 S{p.ws, G, c, 1, MULT(17)}; EpiG9 E{p.ws}; pg8::gemm_phase<EpiG9, SchedG9, false>(lds, 256, 512u, 512u, S, E);)
    PH(18, phase_r3b(p);)
    if (SPIN_PHASE >= 0) { const unsigned long long t0_ = __builtin_amdgcn_s_memrealtime(); while (__builtin_amdgcn_s_memrealtime() - t0_ < spin_acc * SPIN_MULT) __builtin_amdgcn_s_sleep(8); }
#undef IN
#undef SEAM
#undef PH
#undef PG
#undef MULT
}

extern "C" void kernel_launch(void* const* d_in, const int* in_sizes, int n_in, void* d_out, int out_size, void* d_ws, size_t ws_size, hipStream_t stream) {
    static int grid = 0;
    if (grid == 0) {
        if (n_in != 35 || out_size != NTOK * DM || ws_size < WS_NEED) { fprintf(stderr, "kernel_launch: unexpected shapes / workspace (%d inputs, out %d, ws %zu)\n", n_in, out_size, ws_size); grid = -1; return; }
        int dev = 0, cus = 0, per_cu = 0;
        hipGetDevice(&dev); hipDeviceGetAttribute(&cus, hipDeviceAttributeMultiprocessorCount, dev);
        hipFuncSetAttribute((const void*)fwd_kernel, hipFuncAttributeMaxDynamicSharedMemorySize, LDS_BYTES);
        hipOccupancyMaxActiveBlocksPerMultiprocessor(&per_cu, (const void*)fwd_kernel, NT, LDS_BYTES);
        if (per_cu < 1) { fprintf(stderr, "kernel_launch: occupancy query says %d blocks per CU\n", per_cu); per_cu = 1; }
        grid = cus * 1;
        (void)hipGetLastError();
    }
    if (grid < 0) return;
    Params p{};
    for (int i = 0; i < 35; ++i) p.in[i] = (const float*)d_in[i];
    p.out = (float*)d_out; p.ws = (unsigned char*)d_ws;
#if N_LAUNCH_MODE == 1
    hipMemsetAsync(d_ws, 0, 16384, stream);
    p.ph_lo = 0; p.ph_hi = N_PHASES;
    void* args[] = {&p};
    hipError_t e = hipLaunchCooperativeKernel((const void*)fwd_kernel, dim3(grid), dim3(NT), args, LDS_BYTES, stream);
    if (e != hipSuccess) fprintf(stderr, "cooperative launch failed: %s (grid %d)\n", hipGetErrorString(e), grid);
#else
    for (int k = 0; k < 19; ++k) { p.ph_lo = k; p.ph_hi = k + 1; hipLaunchKernelGGL(fwd_kernel, dim3(grid), dim3(NT), LDS_BYTES, stream, p); }
#endif
}
```

```cpp
#include <hip/hip_runtime.h>
#include <hip/hip_cooperative_groups.h>
#include <cstdio>
namespace cg = cooperative_groups;

#ifndef DUP_PHASE
#define DUP_PHASE -1
#define DUP_REPS 1
#define DUP_SUB -1
#define SPIN_PHASE -1
#define SPIN_MULT 9
#endif
#ifndef N_LAUNCH_MODE
#define N_LAUNCH_MODE 1
#endif

#define LAS __attribute__((address_space(3)))
typedef unsigned short bf16_t;
typedef short bf16x8 __attribute__((ext_vector_type(8)));
typedef float f32x4 __attribute__((ext_vector_type(4)));
typedef float f32x2 __attribute__((ext_vector_type(2)));
typedef unsigned u32x4 __attribute__((ext_vector_type(4)));
typedef unsigned u32x2 __attribute__((ext_vector_type(2)));
typedef LAS unsigned char* ldsp_t;

constexpr int NT = 512;
constexpr int DM = 1024;
constexpr int NTOK = 32768;
constexpr int NCTXR = 1024;
constexpr int NROWS = NTOK + NCTXR;
constexpr int DIN = 3584;
constexpr int UC_ROWS = 2304;
constexpr int NEXP = 256;
constexpr int MAXSLOT = 360448;
constexpr float EPS = 1e-6f;

constexpr size_t MiB = 1u << 20;
constexpr size_t WS_MODP = 1 * MiB;
constexpr size_t WS_MOD = 3 * MiB;
constexpr size_t WS_APL = 3 * MiB + 256 * 1024;
constexpr size_t WS_SGUW = 3 * MiB + 512 * 1024;
constexpr size_t WS_WGLU_T = 4 * MiB;
constexpr size_t WS_WR_T = 4 * MiB + 512 * 1024;
constexpr size_t WS_WB5_T = 5 * MiB;
constexpr size_t WS_WBS_T = 6 * MiB;
constexpr size_t WS_WOUT_T = 7 * MiB;
constexpr size_t WS_WIN_T = 9 * MiB;
constexpr size_t WS_BCAT_T = 16 * MiB;
constexpr size_t WS_WEND_T = 24 * MiB;
constexpr size_t WS_SSQV = 28 * MiB;
constexpr size_t WS_SSQM = 29 * MiB;
constexpr size_t WS_IDX = 31 * MiB;
constexpr size_t WS_WT = 32 * MiB;
constexpr size_t WS_SLOT = 33 * MiB;
constexpr size_t WS_BLKCNT = 34 * MiB;
constexpr size_t WS_BLKOFF = 34 * MiB + 256 * 1024;
constexpr size_t WS_TOTAL = 34 * MiB + 512 * 1024;
constexpr size_t WS_TILEEXP = 34 * MiB + 768 * 1024;
constexpr size_t WS_TOKSLOT = 35 * MiB;
constexpr size_t WS_WSLOT = 36 * MiB + 512 * 1024;
constexpr size_t WS_WD_T = 48 * MiB;
constexpr size_t WS_WGU_T = 177 * MiB;
constexpr size_t WS_XN = 434 * MiB;
constexpr size_t WS_UCAT = 500 * MiB;
constexpr size_t WS_E = 572 * MiB;
constexpr size_t WS_GU = 644 * MiB;
constexpr size_t WS_GV = 676 * MiB;
constexpr size_t WS_SG5 = 708 * MiB;
constexpr size_t WS_SGS = 772 * MiB;
constexpr size_t WS_YS = 836 * MiB;
constexpr size_t WS_YS5 = 868 * MiB;
constexpr size_t WS_YSGU = 900 * MiB;
constexpr size_t WS_MX = 932 * MiB;
constexpr size_t WS_MERGED = 500 * MiB;
constexpr size_t WS_LOGITS = 564 * MiB;
constexpr size_t WS_H = 596 * MiB;
constexpr size_t WS_YSLOT = 177 * MiB;
constexpr size_t WS_NEED = 996 * MiB;

constexpr int LDS_BYTES = 147456;

struct Params { const float* in[35]; float* out; unsigned char* ws; int ph_lo, ph_hi; };

__device__ __forceinline__ unsigned f2bf(float f) { unsigned u = __builtin_bit_cast(unsigned, f); return (u + 0x7fffu + ((u >> 16) & 1u)) >> 16; }
typedef __bf16 bf16v2_t __attribute__((ext_vector_type(2)));
__device__ __forceinline__ unsigned pk2(float lo, float hi) { bf16v2_t v; v.x = (__bf16)lo; v.y = (__bf16)hi; return __builtin_bit_cast(unsigned, v); }
__device__ __forceinline__ float bflo(unsigned w) { return __builtin_bit_cast(float, w << 16); }
__device__ __forceinline__ float bfhi(unsigned w) { return __builtin_bit_cast(float, w & 0xffff0000u); }
__device__ __forceinline__ float bf2f(bf16_t b) { return __builtin_bit_cast(float, ((unsigned)b) << 16); }
__device__ __forceinline__ float sigmoid_f(float x) { return __builtin_amdgcn_rcpf(1.0f + __expf(-x)); }
__device__ __forceinline__ float silu_f(float x) { return x * sigmoid_f(x); }
__device__ __forceinline__ float gelu_f(float x) { const float z = 1.5957691216057308f * (x + 0.044715f * x * x * x); return x * sigmoid_f(z); }
__device__ __forceinline__ float wave_sum(float v) {
#pragma unroll
    for (int o = 1; o < 64; o <<= 1) v += __shfl_xor(v, o);
    return v;
}
template <int CTRL, int RM = 0xf, int BM = 0xf> __device__ __forceinline__ float dpp_f(float oldv, float x) {
    return __builtin_bit_cast(float, __builtin_amdgcn_update_dpp(__builtin_bit_cast(int, oldv), __builtin_bit_cast(int, x), CTRL, RM, BM, false)); }
__device__ __forceinline__ float wave_max_dpp(float v) {
    v = fmaxf(v, dpp_f<0xB1>(v, v)); v = fmaxf(v, dpp_f<0x4E>(v, v)); v = fmaxf(v, dpp_f<0x124>(v, v)); v = fmaxf(v, dpp_f<0x128>(v, v));
    v = fmaxf(v, dpp_f<0x142, 0xa>(v, v)); v = fmaxf(v, dpp_f<0x143, 0xc>(v, v));
    return __builtin_bit_cast(float, __builtin_amdgcn_readlane(__builtin_bit_cast(int, v), 63)); }
#define LDS_WAIT() asm volatile("s_waitcnt lgkmcnt(0)" ::: "memory")

__device__ __forceinline__ double dexp_(double x) {
    const double r = x * (1.0 / 32.0); double t = 1.0, s = 1.0;
#pragma unroll 1
    for (int i = 1; i <= 14; ++i) { t *= r / (double)i; s += t; }
#pragma unroll 1
    for (int i = 0; i < 5; ++i) s *= s;
    return s;
}
__device__ __forceinline__ void dsincos_(double th, double& sn, double& cs) {
    const double TWO_PI_HI = 6.283185307179586232, TWO_PI_LO = 2.4492935982947064e-16;
    const double k = __builtin_rint(th * 0.15915494309189535);
    double r = (th - k * TWO_PI_HI) - k * TWO_PI_LO;
    r *= 0.125;
    const double r2 = r * r; double ts = r, tc = 1.0, s = r, c = 1.0;
#pragma unroll 1
    for (int i = 1; i <= 9; ++i) { tc *= -r2 / (double)((2 * i - 1) * (2 * i)); c += tc; ts *= -r2 / (double)((2 * i) * (2 * i + 1)); s += ts; }
#pragma unroll 1
    for (int i = 0; i < 3; ++i) { const double s2 = 2.0 * s * c, c2 = c * c - s * s; s = s2; c = c2; }
    sn = s; cs = c;
}

namespace pg8 {
constexpr int BM = 256, BK = 64, HALF = 128, HTB = HALF * BK * 2, STAGE_BYTES = 8 * HTB;
__device__ __forceinline__ int lds_byte(int r, int c) { const int st = (r >> 4) * 2 + (c >> 5), rr = r & 15, cc = c & 31, ob = rr * 64 + cc * 2; return st * 1024 + (ob ^ (((ob >> 9) & 1) << 5)); }
__device__ __forceinline__ void stage_rc(int b, int& R, int& C) { const int st = b / 1024, sb = b % 1024, swz = sb ^ (((sb >> 9) & 1) << 5); R = (st >> 1) * 16 + swz / 64; C = (st & 1) * 32 + (swz % 64) / 2; }
__device__ __forceinline__ int perm32(int rho) { const int n = rho >> 4, i = rho & 15; return 8 * (i >> 2) + 4 * n + (i & 3); }

struct Unit { const char* A; const char* B; const int* arow; int pm, pn, x0, x1; };

template <class Epi, class Sched, bool GATHER>
__device__ __forceinline__ void gemm_phase(ldsp_t lds, const int K, const unsigned lda, const unsigned ldb, const Sched& S, const Epi& E) {
    const int tid = threadIdx.x, wid = __builtin_amdgcn_readfirstlane(tid >> 6), lane = tid & 63, wr = wid >> 2, wc = wid & 3, fr = lane & 15, fq = lane >> 4;
    const int nt = K / BK;
    int RA[2], CA[2]; unsigned voffB[2][2];
#pragma unroll
    for (int i = 0; i < 2; ++i) { int R, C; stage_rc(tid * 16 + i * 8192, R, C); RA[i] = R; CA[i] = C; const int Rb = Epi::PERM ? ((R & ~31) + perm32(R & 31)) : R;
        voffB[0][i] = (unsigned)Rb * ldb + (unsigned)C * 2u; voffB[1][i] = (unsigned)(Rb + HALF) * ldb + (unsigned)C * 2u; }
    unsigned vA[2][2], vN[2][2];
#define PG8_SETA(v, u) do { _Pragma("unroll") for (int _h = 0; _h < 2; ++_h) _Pragma("unroll") for (int _i = 0; _i < 2; ++_i) { \
        const int _row = _h * HALF + RA[_i]; const unsigned _src = GATHER ? (unsigned)(u).arow[_row] : (unsigned)_row; (v)[_h][_i] = _src * lda + (unsigned)CA[_i] * 2u; } } while (0)
    const size_t kstep = (size_t)(BK * 2);
    const unsigned ldsw = (unsigned)wid * 1024u;
    const int aoff = lds_byte(wr * 64 + fr, fq * 8), boff = lds_byte(wc * 32 + fr, fq * 8);
#define PG8_SA(b, h) (((b) * 2 + (h)) * HTB)
#define PG8_SB(b, h) ((4 + (b) * 2 + (h)) * HTB)
#define PG8_STAGE(bufoff, gbase, o0, o1) do { \
        __builtin_amdgcn_global_load_lds((const unsigned*)((const char*)(gbase) + (o0)), (LAS unsigned*)(lds + (bufoff) + ldsw), 16, 0, 0); \
        __builtin_amdgcn_global_load_lds((const unsigned*)((const char*)(gbase) + (o1)), (LAS unsigned*)(lds + (bufoff) + ldsw + 8192), 16, 0, 0); } while (0)
#define PG8_LDA(dst, b, h) do { _Pragma("unroll") for (int m = 0; m < 4; ++m) _Pragma("unroll") for (int k = 0; k < 2; ++k) dst[m][k] = *(const LAS bf16x8*)(lds + PG8_SA(b, h) + aoff + m * 2048 + k * 1024); } while (0)
#define PG8_LDB(dst, b, h) do { _Pragma("unroll") for (int n = 0; n < 2; ++n) _Pragma("unroll") for (int k = 0; k < 2; ++k) dst[n][k] = *(const LAS bf16x8*)(lds + PG8_SB(b, h) + boff + n * 2048 + k * 1024); } while (0)
#define PG8_MMA(ai, bj, At, Bt) do { __builtin_amdgcn_s_setprio(1); _Pragma("unroll") for (int m = 0; m < 4; ++m) _Pragma("unroll") for (int n = 0; n < 2; ++n) _Pragma("unroll") for (int k = 0; k < 2; ++k) \
        acc[ai][bj][m][n] = __builtin_amdgcn_mfma_f32_16x16x32_bf16(Bt[n][k], At[m][k], acc[ai][bj][m][n], 0, 0, 0); __builtin_amdgcn_s_setprio(0); } while (0)
#define PG8_WAIT_V(n) asm volatile("s_waitcnt vmcnt(" #n ")" ::: "memory")
#define PG8_WAIT_L(n) asm volatile("s_waitcnt lgkmcnt(" #n ")" ::: "memory")
#define PG8_BAR __builtin_amdgcn_s_barrier()
#define PG8_SCHED __builtin_amdgcn_sched_barrier(0)
    Unit cur, nxt; int ui = 0;
    if (!S.next(0, cur)) return;
    PG8_SETA(vA, cur);
    f32x4 acc[2][2][4][2];
#pragma unroll
    for (int a = 0; a < 2; ++a)
#pragma unroll
        for (int b = 0; b < 2; ++b)
#pragma unroll
            for (int m = 0; m < 4; ++m)
#pragma unroll
                for (int n = 0; n < 2; ++n) acc[a][b][m][n] = (f32x4){0.f, 0.f, 0.f, 0.f};
    bf16x8 At[4][2], B0[2][2], B1[2][2];
    const char* cA = cur.A; const char* cB = cur.B;
    PG8_STAGE(PG8_SB(0, 0), cB, voffB[0][0], voffB[0][1]); PG8_STAGE(PG8_SA(0, 0), cA, vA[0][0], vA[0][1]);
    PG8_STAGE(PG8_SB(0, 1), cB, voffB[1][0], voffB[1][1]); PG8_STAGE(PG8_SA(0, 1), cA, vA[1][0], vA[1][1]);
    if (wr == 1) PG8_BAR;
    PG8_WAIT_V(4); PG8_BAR;
    PG8_STAGE(PG8_SB(1, 0), cB + kstep, voffB[0][0], voffB[0][1]); PG8_STAGE(PG8_SA(1, 0), cA + kstep, vA[0][0], vA[0][1]);
    PG8_STAGE(PG8_SB(1, 1), cB + kstep, voffB[1][0], voffB[1][1]);
    PG8_WAIT_V(6); PG8_BAR;
    for (;;) {
        const bool has_next = S.next(ui + 1, nxt);
        const char* nA = has_next ? nxt.A : cA; const char* nB = has_next ? nxt.B : cB;
        if (GATHER) { if (has_next && nxt.arow != cur.arow) { PG8_SETA(vN, nxt); } else { vN[0][0] = vA[0][0]; vN[0][1] = vA[0][1]; vN[1][0] = vA[1][0]; vN[1][1] = vA[1][1]; } }
#pragma nounroll
        for (int t = 0; t < nt; t += 2) {
            const bool last = (t == nt - 2);
            const char* a1 = cA + (size_t)(t + 1) * kstep;
            const char* a2 = last ? nA : cA + (size_t)(t + 2) * kstep; const char* b2 = last ? nB : cB + (size_t)(t + 2) * kstep;
            const char* a3 = a2 + kstep; const char* b3 = b2 + kstep;
            unsigned o00, o01, o10, o11;
            if (GATHER && last) { o00 = vN[0][0]; o01 = vN[0][1]; o10 = vN[1][0]; o11 = vN[1][1]; } else { o00 = vA[0][0]; o01 = vA[0][1]; o10 = vA[1][0]; o11 = vA[1][1]; }
            PG8_LDB(B0, 0, 0); PG8_SCHED; PG8_LDA(At, 0, 0); PG8_STAGE(PG8_SA(1, 1), a1, vA[1][0], vA[1][1]);
            PG8_WAIT_L(8); PG8_BAR; PG8_WAIT_L(0); PG8_MMA(0, 0, At, B0); PG8_BAR; PG8_SCHED;
            PG8_LDB(B1, 0, 1); PG8_STAGE(PG8_SB(0, 0), b2, voffB[0][0], voffB[0][1]);
            PG8_BAR; PG8_WAIT_L(0); PG8_MMA(0, 1, At, B1); PG8_BAR;
            PG8_LDA(At, 0, 1); PG8_STAGE(PG8_SA(0, 0), a2, o00, o01);
            PG8_BAR; PG8_WAIT_L(0); PG8_MMA(1, 0, At, B0); PG8_BAR; PG8_SCHED;
            PG8_STAGE(PG8_SB(0, 1), b2, voffB[1][0], voffB[1][1]);
            PG8_WAIT_V(6); PG8_BAR; PG8_MMA(1, 1, At, B1); PG8_BAR;
            PG8_LDB(B0, 1, 0); PG8_SCHED; PG8_LDA(At, 1, 0); PG8_STAGE(PG8_SA(0, 1), a2, o10, o11);
            PG8_WAIT_L(8); PG8_BAR; PG8_WAIT_L(0); PG8_MMA(0, 0, At, B0); PG8_BAR; PG8_SCHED;
            PG8_LDB(B1, 1, 1); PG8_STAGE(PG8_SB(1, 0), b3, voffB[0][0], voffB[0][1]);
            PG8_BAR; PG8_WAIT_L(0); PG8_MMA(0, 1, At, B1); PG8_BAR;
            PG8_LDA(At, 1, 1); PG8_STAGE(PG8_SA(1, 0), a3, o00, o01);
            PG8_BAR; PG8_WAIT_L(0); PG8_MMA(1, 0, At, B0); PG8_BAR; PG8_SCHED;
            PG8_STAGE(PG8_SB(1, 1), b3, voffB[1][0], voffB[1][1]);
            PG8_WAIT_V(6); PG8_BAR; PG8_MMA(1, 1, At, B1); PG8_BAR;
        }
        E(acc, cur, wr, wc, fr, fq);
        if (!has_next) break;
#pragma unroll
        for (int a = 0; a < 2; ++a)
#pragma unroll
            for (int b = 0; b < 2; ++b)
#pragma unroll
                for (int m = 0; m < 4; ++m)
#pragma unroll
                    for (int n = 0; n < 2; ++n) acc[a][b][m][n] = (f32x4){0.f, 0.f, 0.f, 0.f};
        cur = nxt; cA = nA; cB = nB; ++ui;
        if (GATHER) { vA[0][0] = vN[0][0]; vA[0][1] = vN[0][1]; vA[1][0] = vN[1][0]; vA[1][1] = vN[1][1]; }
    }
    PG8_WAIT_V(0);
    if (wr == 0) PG8_BAR;
    PG8_BAR;
#undef PG8_SETA
#undef PG8_SA
#undef PG8_SB
#undef PG8_STAGE
#undef PG8_LDA
#undef PG8_LDB
#undef PG8_MMA
#undef PG8_WAIT_V
#undef PG8_WAIT_L
#undef PG8_BAR
#undef PG8_SCHED
}
}
using pg8::Unit;
typedef f32x4 acc_t[2][2][4][2];

#define EPI_ROWS(ai, m, rowl) _Pragma("unroll") for (int ai = 0; ai < 2; ++ai) _Pragma("unroll") for (int m = 0; m < 4; ++m) { const int rowl = ai * 128 + wr * 64 + m * 16 + fr;
#define EPI_END }

struct TItem { const float* src; bf16_t* dst; int ldw, ldt; };
__device__ __forceinline__ TItem tr_make(const float* W, int ldw, int k0, int n0, bf16_t* WT, size_t drow0, int ldt) { TItem t; t.src = W + (size_t)k0 * ldw + n0; t.dst = WT + drow0 * (size_t)ldt + k0; t.ldw = ldw; t.ldt = ldt; return t; }
__device__ __forceinline__ TItem tr_decode(const Params& p, int r) {
    constexpr int I_IN = 16 * 56, I_GLU = 64, I_B5 = 128, I_BS = 128, I_OUT = 256, I_R = 64;
    if (r < I_IN) return tr_make(p.in[10], DIN, (r / 56) * 64, (r % 56) * 64, (bf16_t*)(p.ws + WS_WIN_T), (size_t)(r % 56) * 64, 1024); r -= I_IN;
    if (r < I_GLU) return tr_make(p.in[19], 512, (r / 8) * 64, (r % 8) * 64, (bf16_t*)(p.ws + WS_WGLU_T), (size_t)(r % 8) * 64, 512); r -= I_GLU;
    if (r < I_B5) return tr_make(p.in[24], 1024, (r / 16) * 64, (r % 16) * 64, (bf16_t*)(p.ws + WS_WB5_T), (size_t)(r % 16) * 64, 512); r -= I_B5;
    if (r < I_BS) return tr_make(p.in[25], 1024, (r / 16) * 64, (r % 16) * 64, (bf16_t*)(p.ws + WS_WBS_T), (size_t)(r % 16) * 64, 512); r -= I_BS;
    if (r < I_OUT) return tr_make(p.in[26], 1024, (r / 16) * 64, (r % 16) * 64, (bf16_t*)(p.ws + WS_WOUT_T), (size_t)(r % 16) * 64, 1024); r -= I_OUT;
    if (r < I_R) return tr_make(p.in[27], 256, (r / 4) * 64, (r % 4) * 64, (bf16_t*)(p.ws + WS_WR_T), (size_t)(r % 4) * 64, 1024); r -= I_R;
    const int e = r / 192, q = r % 192;
    if (q < 128) {
        const int up = q >> 6, qq = q & 63, k0 = (qq / 4) * 64, n0 = (qq % 4) * 64;
        const float* W = (e < 256) ? p.in[up ? 30 : 29] + (size_t)e * 262144 : p.in[up ? 33 : 32];
        return tr_make(W, 256, k0, n0, (bf16_t*)(p.ws + WS_WGU_T), (size_t)e * 512 + (size_t)(n0 >> 7) * 256 + up * 128 + (n0 & 127), 1024);
    }
    const int qq = q - 128, k0 = (qq / 16) * 64, n0 = (qq % 16) * 64;
    const float* W = (e < 256) ? p.in[31] + (size_t)e * 262144 : p.in[34];
    return tr_make(W, 1024, k0, n0, (bf16_t*)(p.ws + WS_WD_T), (size_t)e * 1024 + n0, 256);
}
#define TR_LOAD(v, t) do { __builtin_amdgcn_sched_barrier(0); _Pragma("unroll") for (int it_ = 0; it_ < 16; ++it_) (v)[it_] = __builtin_nontemporal_load((const f32x4*)((t).src + (size_t)(it_ * 4 + (lane >> 4)) * (t).ldw + (lane & 15) * 4)); __builtin_amdgcn_sched_barrier(0); } while (0)
#define TR_STORE(v, t) do { \
    _Pragma("unroll") for (int it_ = 0; it_ < 16; ++it_) { LAS float* s_ = scr + (it_ * 4 + (lane >> 4)) * 65 + (lane & 15) * 4; s_[0] = (v)[it_].x; s_[1] = (v)[it_].y; s_[2] = (v)[it_].z; s_[3] = (v)[it_].w; } \
    LDS_WAIT(); \
    _Pragma("unroll") for (int it_ = 0; it_ < 8; ++it_) { const int n_ = it_ * 8 + (lane >> 3), c_ = lane & 7; const LAS float* s_ = scr + (8 * c_) * 65 + n_; \
        u32x4 o_; o_.x = pk2(s_[0], s_[65]); o_.y = pk2(s_[130], s_[195]); o_.z = pk2(s_[260], s_[325]); o_.w = pk2(s_[390], s_[455]); \
        __builtin_nontemporal_store(o_, (u32x4*)((t).dst + (size_t)n_ * (t).ldt + 8 * c_)); } \
    LDS_WAIT(); } while (0)

__device__ __forceinline__ void s5_tables(const Params& p, int g, int sub, ldsp_t lds) {
    LAS f32x2* apow = (LAS f32x2*)lds;
    LAS f32x2* bbar = (LAS f32x2*)(lds + 17408);
    LAS f32x2* cm = (LAS f32x2*)(lds + 17408 + 16384);
    LAS float* Kt = (LAS float*)(lds + 17408 + 32768);
    const int tid = threadIdx.x;
    const float *a_re = p.in[11], *a_im = p.in[12], *log_dt = p.in[13], *b_re = p.in[14], *b_im = p.in[15], *c_re = p.in[16], *c_im = p.in[17], *dsk = p.in[18];
    float* APL = (float*)(p.ws + WS_APL);
    if (tid < 128) {
        const int d = tid >> 6, pp = tid & 63, idx = (d * 32 + g) * 64 + pp;
        const double are = (double)a_re[idx], aim = (double)a_im[idx];
        const double dt = dexp_((double)log_dt[d * 32 + g]);
        const double mag = dexp_(dt * are); double sn, cs; dsincos_(dt * aim, sn, cs);
        const double abr = mag * cs, abi = mag * sn;
        double pr = 1.0, pi = 0.0;
#pragma unroll 1
        for (int m = 0; m <= 16; ++m) { apow[(d * 17 + m) * 64 + pp] = (f32x2){(float)pr, (float)pi}; const double nr = pr * abr - pi * abi, ni = pr * abi + pi * abr; pr = nr; pi = ni; }
        if (sub == 0) { const f32x2 aL = apow[(d * 17 + 16) * 64 + pp]; APL[idx * 2 + 0] = aL.x; APL[idx * 2 + 1] = aL.y; }
        const double nr = abr - 1.0, ni = abi, den = are * are + aim * aim;
        const double qr = (nr * are + ni * aim) / den, qi = (ni * are - nr * aim) / den;
#pragma unroll 1
        for (int i = 0; i < 16; ++i) { const double br = (double)b_re[idx * 16 + i], bi = (double)b_im[idx * 16 + i];
            bbar[(d * 64 + pp) * 16 + i] = (f32x2){(float)(qr * br - qi * bi), (float)(qr * bi + qi * br)}; }
    }
    for (int e = tid; e < 2048; e += NT) { const int d = e >> 10, j = (e >> 6) & 15, pp = e & 63; const int gi = ((d * 32 + g) * 16 + j) * 64 + pp; cm[e] = (f32x2){c_re[gi], c_im[gi]}; }
    __syncthreads();
    for (int e1 = tid; e1 < 1024; e1 += NT) {
        const int d = e1 >> 9, m = (e1 >> 5) & 15, j = 2 * sub + ((e1 >> 4) & 1), i = e1 & 15, e = (d << 12) | (m << 8) | (j << 4) | i; float s = 0.f;
#pragma unroll 4
        for (int pp = 0; pp < 64; ++pp) { const f32x2 a = apow[(d * 17 + m) * 64 + pp], b = bbar[(d * 64 + pp) * 16 + i], c = cm[(d * 16 + j) * 64 + pp];
            const float tr = a.x * b.x - a.y * b.y, ti = a.x * b.y + a.y * b.x; s += c.x * tr - c.y * ti; }
        Kt[e] = s;
    }
    __syncthreads();
    unsigned* BC = (unsigned*)(p.ws + WS_BCAT_T) + (size_t)g * 256 * 256;
    for (int e3 = tid; e3 < 8192; e3 += NT) {
        const int rr = e3 >> 8, tau = rr >> 1, j = 2 * sub + (rr & 1), n = tau * 16 + j, e2 = n * 256 + (e3 & 255), kk0 = (e3 & 255) * 2; float v[2];
#pragma unroll
        for (int q = 0; q < 2; ++q) { const int kk = kk0 + q; float r;
            if (kk < 256) { const int k = kk >> 4, i = kk & 15; r = 0.f;
                if (tau >= k) r += Kt[((0 * 16 + (tau - k)) * 16 + j) * 16 + i];
                if (k >= tau) r += Kt[((1 * 16 + (k - tau)) * 16 + j) * 16 + i];
                if (k == tau && i == j) r += dsk[16 * g + j];
            } else { const int qq = kk - 256, part = qq >> 6, pp = qq & 63, d = part >> 1, m = (d == 0) ? (tau + 1) : (16 - tau);
                const f32x2 c = cm[(d * 16 + j) * 64 + pp], a = apow[(d * 17 + m) * 64 + pp];
                r = (part & 1) ? -(c.x * a.y + c.y * a.x) : (c.x * a.x - c.y * a.y); }
            v[q] = r; }
        BC[e2] = pk2(v[0], v[1]);
    }
    unsigned* WE = (unsigned*)(p.ws + WS_WEND_T) + (size_t)g * 256 * 128;
    for (int e3 = tid; e3 < 4096; e3 += NT) {
        const int n = 32 * sub + (e3 >> 7), e2 = n * 128 + (e3 & 127), kk0 = (e3 & 127) * 2, d = n >> 7, ri = (n >> 6) & 1, pp = n & 63; float v[2];
#pragma unroll
        for (int q = 0; q < 2; ++q) { const int kk = kk0 + q, k = kk >> 4, i = kk & 15, m = (d == 0) ? (15 - k) : k;
            const f32x2 a = apow[(d * 17 + m) * 64 + pp], b = bbar[(d * 64 + pp) * 16 + i];
            v[q] = ri ? (a.x * b.y + a.y * b.x) : (a.x * b.x - a.y * b.y); }
        WE[e2] = pk2(v[0], v[1]);
    }
    __syncthreads();
}

__device__ __forceinline__ void phase_prep(const Params& p, ldsp_t lds) {
    const int tid = threadIdx.x, lane = tid & 63, wave = tid >> 6, G = gridDim.x, bx = blockIdx.x;
    for (int q = bx; q < 256; q += G) s5_tables(p, q >> 3, q & 7, lds);
    { const float* sw = p.in[22]; unsigned* dst = (unsigned*)(p.ws + WS_SGUW);
      for (size_t e = (size_t)bx * NT + tid; e < 65536; e += (size_t)G * NT) dst[e] = pk2(sw[2 * e], sw[2 * e + 1]);
      u32x4* uc = (u32x4*)(p.ws + WS_UCAT);
      for (size_t e = (size_t)bx * NT + tid; e < (size_t)32 * 12288; e += (size_t)G * NT) { const size_t g = e / 12288, r = e % 12288; uc[(g * UC_ROWS + 2112) * 64 + r] = (u32x4){0u, 0u, 0u, 0u}; } }
    const int gw = bx * 8 + __builtin_amdgcn_readfirstlane(wave), NGW = G * 8;
    for (int r = gw; r < 1536; r += NGW) {
        const int cb = r % 96, ks = r / 96, n = cb * 64 + lane; const float* wm = p.in[4];
        float a0 = 0.f, a1 = 0.f, a2 = 0.f, a3 = 0.f, a4 = 0.f;
#pragma unroll 8
        for (int kk = 0; kk < 64; ++kk) { const int k = ks * 64 + kk; const float w = __builtin_nontemporal_load(wm + (size_t)k * 6144 + n);
            a0 += silu_f(p.in[1][k]) * w; a1 += silu_f(p.in[1][1024 + k]) * w; a2 += silu_f(p.in[1][2048 + k]) * w; a3 += silu_f(p.in[1][3072 + k]) * w; a4 += silu_f(p.in[3][k]) * w; }
        float* mp = (float*)(p.ws + WS_MODP) + (size_t)ks * 5 * 6144 + n;
        mp[0] = a0; mp[6144] = a1; mp[2 * 6144] = a2; mp[3 * 6144] = a3; mp[4 * 6144] = a4;
    }
    LAS float* scr = (LAS float*)(lds + wave * 16640);
    constexpr int N_TR = 16 * 56 + 64 + 128 + 128 + 256 + 64 + 257 * 192;
    int it = __builtin_amdgcn_readfirstlane(gw);
    if (it < N_TR) {
        f32x4 va[16], vb[16];
        TItem ta = tr_decode(p, it), tb; TR_LOAD(va, ta);
        for (;;) {
            bool more = (it + NGW) < N_TR;
            tb = tr_decode(p, more ? it + NGW : it); TR_LOAD(vb, tb);
            TR_STORE(va, ta);
            if (!more) break;
            it += NGW; more = (it + NGW) < N_TR;
            ta = tr_decode(p, more ? it + NGW : it); TR_LOAD(va, ta);
            TR_STORE(vb, tb);
            if (!more) break;
            it += NGW;
        }
    }
}

__device__ __forceinline__ void phase_xn(const Params& p, ldsp_t lds) {
    const int tid = threadIdx.x, lane = tid & 63, wave = tid >> 6, G = gridDim.x, bx = blockIdx.x;
    const float* modp = (const float*)(p.ws + WS_MODP); const float* bmod = p.in[5];
    { float* mod = (float*)(p.ws + WS_MOD);
      for (int e = bx * NT + tid; e < 5 * 6144; e += G * NT) { const int n = e % 6144; float s = bmod[n];
#pragma unroll
          for (int ks = 0; ks < 16; ++ks) s += modp[(size_t)ks * 5 * 6144 + e];
          mod[e] = s; } }
    LAS float* shv = (LAS float*)lds; LAS float* gsc = (LAS float*)(lds + 4096);
    const float* gpre = p.in[6];
    for (int tile = bx; tile < NROWS / 128; tile += G) {
        const int mr = tile < 256 ? (tile >> 6) : 4;
        __syncthreads();
        for (int col = tid; col < 1024; col += NT) { float sh = bmod[col], sc = bmod[1024 + col];
#pragma unroll
            for (int ks = 0; ks < 16; ++ks) { sh += modp[((size_t)ks * 5 + mr) * 6144 + col]; sc += modp[((size_t)ks * 5 + mr) * 6144 + 1024 + col]; }
            shv[col] = sh; gsc[col] = gpre[col] * (1.0f + sc); }
        __syncthreads();
        for (int r0 = wave; r0 < 128; r0 += 32) {
            f32x4 v[4][4]; float ss[4];
#pragma unroll
            for (int q = 0; q < 4; ++q) { const int row = tile * 128 + r0 + 8 * q;
                const float* src = (row < NTOK) ? p.in[0] + (size_t)row * DM : p.in[2] + (size_t)(row - NTOK) * DM;
#pragma unroll
                for (int j = 0; j < 4; ++j) v[q][j] = __builtin_nontemporal_load((const f32x4*)(src + 4 * lane + 256 * j)); }
#pragma unroll
            for (int q = 0; q < 4; ++q) { float s2 = 0.f;
#pragma unroll
                for (int j = 0; j < 4; ++j) s2 += (v[q][j].x * v[q][j].x + v[q][j].y * v[q][j].y) + (v[q][j].z * v[q][j].z + v[q][j].w * v[q][j].w);
                ss[q] = s2; }
#pragma unroll
            for (int o = 1; o < 64; o <<= 1) {
#pragma unroll
                for (int q = 0; q < 4; ++q) ss[q] += __shfl_xor(ss[q], o); }
#pragma unroll
            for (int q = 0; q < 4; ++q) { const int row = tile * 128 + r0 + 8 * q; const float rstd = rsqrtf(ss[q] * (1.0f / DM) + EPS);
                bf16_t* dst = (bf16_t*)(p.ws + WS_XN) + (size_t)row * DM;
#pragma unroll
                for (int j = 0; j < 4; ++j) { const int c = 4 * lane + 256 * j; const f32x4 gs = *(const LAS f32x4*)(gsc + c), sh = *(const LAS f32x4*)(shv + c);
                    u32x2 o; o.x = pk2(v[q][j].x * rstd * gs.x + sh.x, v[q][j].y * rstd * gs.y + sh.y); o.y = pk2(v[q][j].z * rstd * gs.z + sh.z, v[q][j].w * rstd * gs.w + sh.w);
                    *(u32x2*)(dst + c) = o; } }
        }
    }
    __syncthreads();
}

struct SchedG1 { const unsigned char* ws; int G, c, mult;
    __device__ __forceinline__ bool next(int i, Unit& u) const { int L = i * G + c; if (L >= 1800 * mult) return false; if (mult > 1) L %= 1800;
        if (L < 1792) { u.pm = L / 14; u.pn = L % 14; } else { const int q = L - 1792; u.pm = 128 + (q >> 1); u.pn = q & 1; }
        u.A = (const char*)ws + WS_XN + (size_t)u.pm * 256 * 2048; u.B = (const char*)ws + WS_WIN_T + (size_t)u.pn * 256 * 2048; u.arow = nullptr; u.x0 = 0; u.x1 = 0; return true; } };
struct EpiG1 { static constexpr bool PERM = true; unsigned char* ws;
    __device__ __forceinline__ void operator()(const acc_t& acc, const Unit& u, int wr, int wc, int fr, int fq) const {
        const int pn = u.pn;
        EPI_ROWS(ai, m, rowl)
            const int row = u.pm * 256 + rowl; float ssq = 0.f;
#pragma unroll
            for (int bj = 0; bj < 2; ++bj) {
                const int col = pn * 256 + bj * 128 + wc * 32 + 8 * fq; const f32x4 v0 = acc[ai][bj][m][0], v1 = acc[ai][bj][m][1]; u32x4 o;
                if (pn < 2) {
                    const int g = col >> 4, i0 = col & 15; int crow, k;
                    if (row < NTOK) { crow = row >> 4; k = row & 15; } else { const int rc = row - NTOK; crow = 2048 + (rc >> 8) * 16 + ((rc & 255) >> 4); k = rc & 15; }
                    o.x = pk2(v0.x, v0.y); o.y = pk2(v0.z, v0.w); o.z = pk2(v1.x, v1.y); o.w = pk2(v1.z, v1.w);
                    *(u32x4*)((bf16_t*)(ws + WS_UCAT) + ((size_t)(g * UC_ROWS + crow) * 512 + k * 16 + i0)) = o;
                } else if (pn < 6) {
                    const float g0 = gelu_f(v0.x), g1 = gelu_f(v0.y), g2 = gelu_f(v0.z), g3 = gelu_f(v0.w), g4 = gelu_f(v1.x), g5 = gelu_f(v1.y), g6 = gelu_f(v1.z), g7 = gelu_f(v1.w);
                    o.x = pk2(g0, g1); o.y = pk2(g2, g3); o.z = pk2(g4, g5); o.w = pk2(g6, g7);
                    if (pn < 4) *(u32x4*)((bf16_t*)(ws + WS_GU) + (size_t)row * 512 + (col - 512)) = o;
                    else { *(u32x4*)((bf16_t*)(ws + WS_GV) + (size_t)row * 512 + (col - 1024)) = o; ssq += (g0 * g0 + g1 * g1) + (g2 * g2 + g3 * g3) + (g4 * g4 + g5 * g5) + (g6 * g6 + g7 * g7); }
                } else {
                    o.x = pk2(sigmoid_f(v0.x), sigmoid_f(v0.y)); o.y = pk2(sigmoid_f(v0.z), sigmoid_f(v0.w)); o.z = pk2(sigmoid_f(v1.x), sigmoid_f(v1.y)); o.w = pk2(sigmoid_f(v1.z), sigmoid_f(v1.w));
                    if (pn < 10) *(u32x4*)((bf16_t*)(ws + WS_SG5) + (size_t)row * 1024 + (col - 1536)) = o;
                    else *(u32x4*)((bf16_t*)(ws + WS_SGS) + (size_t)row * 1024 + (col - 2560)) = o;
                }
            }
            if (pn == 4 || pn == 5) { ssq += __shfl_xor(ssq, 16); ssq += __shfl_xor(ssq, 32); if (fq == 0) ((float*)(ws + WS_SSQV))[(size_t)row * 8 + (pn - 4) * 4 + wc] = ssq; }
        EPI_END
    } };
struct SchedG2 { const unsigned char* ws; int G, c, mult;
    __device__ __forceinline__ bool next(int i, Unit& u) const { int L = i * G + c; if (L >= 288 * mult) return false; if (mult > 1) L %= 288; const int g = L / 9; u.pm = L % 9; u.pn = 0; u.x0 = g; u.x1 = 0; u.arow = nullptr;
        u.A = (const char*)ws + WS_UCAT + ((size_t)g * UC_ROWS + (size_t)u.pm * 256) * 1024; u.B = (const char*)ws + WS_WEND_T + (size_t)g * 256 * 512; return true; } };
struct EpiG2 { static constexpr bool PERM = false; unsigned char* ws;
    __device__ __forceinline__ void operator()(const acc_t& acc, const Unit& u, int wr, int wc, int fr, int fq) const {
        float* Eo = (float*)(ws + WS_E) + (size_t)u.x0 * UC_ROWS * 256;
        EPI_ROWS(ai, m, rowl)
            float* rp = Eo + (size_t)(u.pm * 256 + rowl) * 256 + wc * 32 + 4 * fq;
#pragma unroll
            for (int bj = 0; bj < 2; ++bj)
#pragma unroll
                for (int n = 0; n < 2; ++n) *(f32x4*)(rp + bj * 128 + n * 16) = acc[ai][bj][m][n];
        EPI_END
    } };
struct SchedG3 { const unsigned char* ws; int G, c, mult;
    __device__ __forceinline__ bool next(int i, Unit& u) const { int L = i * G + c; if (L >= 256 * mult) return false; if (mult > 1) L %= 256; const int g = L >> 3; u.pm = L & 7; u.pn = 0; u.x0 = g; u.x1 = 0; u.arow = nullptr;
        u.A = (const char*)ws + WS_UCAT + ((size_t)g * UC_ROWS + (size_t)u.pm * 256) * 1024; u.B = (const char*)ws + WS_BCAT_T + (size_t)g * 256 * 1024; return true; } };
struct EpiG3 { static constexpr bool PERM = true; unsigned char* ws;
    __device__ __forceinline__ void operator()(const acc_t& acc, const Unit& u, int wr, int wc, int fr, int fq) const {
        bf16_t* ys = (bf16_t*)(ws + WS_YS);
        EPI_ROWS(ai, m, rowl)
            const int crow = u.pm * 256 + rowl;
#pragma unroll
            for (int bj = 0; bj < 2; ++bj) { const int col = bj * 128 + wc * 32 + 8 * fq; const f32x4 v0 = acc[ai][bj][m][0], v1 = acc[ai][bj][m][1]; u32x4 o;
                o.x = pk2(gelu_f(v0.x), gelu_f(v0.y)); o.y = pk2(gelu_f(v0.z), gelu_f(v0.w)); o.z = pk2(gelu_f(v1.x), gelu_f(v1.y)); o.w = pk2(gelu_f(v1.z), gelu_f(v1.w));
                *(u32x4*)(ys + ((size_t)crow * 16 + (col >> 4)) * 512 + u.x0 * 16 + (col & 15)) = o; }
        EPI_END
    } };
struct SchedG4 { const unsigned char* ws; int G, c, mult;
    __device__ __forceinline__ bool next(int i, Unit& u) const { int L = i * G + c; if (L >= 256 * mult) return false; if (mult > 1) L %= 256; u.pm = L >> 1; u.pn = L & 1; u.x0 = 0; u.x1 = 0; u.arow = nullptr;
        u.A = (const char*)ws + WS_YS + (size_t)u.pm * 256 * 1024; u.B = (const char*)ws + WS_WGLU_T + (size_t)u.pn * 256 * 1024; return true; } };
struct EpiG4 { static constexpr bool PERM = true; unsigned char* ws; const float* bglu;
    __device__ __forceinline__ void operator()(const acc_t& acc, const Unit& u, int wr, int wc, int fr, int fq) const {
        const int colb = u.pn * 256 + wc * 32 + 8 * fq;
        const f32x4 b00 = *(const f32x4*)(bglu + colb), b01 = *(const f32x4*)(bglu + colb + 4), b10 = *(const f32x4*)(bglu + colb + 128), b11 = *(const f32x4*)(bglu + colb + 132);
#pragma unroll
        for (int ai = 0; ai < 2; ++ai) {
            u32x4 y[4][2];
#pragma unroll
            for (int m = 0; m < 4; ++m)
#pragma unroll
                for (int bj = 0; bj < 2; ++bj) y[m][bj] = *(const u32x4*)((const bf16_t*)(ws + WS_YS) + ((size_t)u.pm * 256 + ai * 128 + wr * 64 + m * 16 + fr) * 512 + colb + bj * 128);
#pragma unroll
            for (int m = 0; m < 4; ++m)
#pragma unroll
                for (int bj = 0; bj < 2; ++bj) { const f32x4 v0 = acc[ai][bj][m][0], v1 = acc[ai][bj][m][1]; const f32x4 b0 = bj ? b10 : b00, b1 = bj ? b11 : b01; const u32x4 yy = y[m][bj]; u32x4 o;
                    o.x = pk2(bflo(yy.x) * sigmoid_f(v0.x + b0.x), bfhi(yy.x) * sigmoid_f(v0.y + b0.y)); o.y = pk2(bflo(yy.y) * sigmoid_f(v0.z + b0.z), bfhi(yy.y) * sigmoid_f(v0.w + b0.w));
                    o.z = pk2(bflo(yy.z) * sigmoid_f(v1.x + b1.x), bfhi(yy.z) * sigmoid_f(v1.y + b1.y)); o.w = pk2(bflo(yy.w) * sigmoid_f(v1.z + b1.z), bfhi(yy.w) * sigmoid_f(v1.w + b1.w));
                    *(u32x4*)((bf16_t*)(ws + WS_YS5) + ((size_t)u.pm * 256 + ai * 128 + wr * 64 + m * 16 + fr) * 512 + colb + bj * 128) = o; }
        }
    } };
struct SchedG5 { const unsigned char* ws; int G, c, mult;
    __device__ __forceinline__ bool next(int i, Unit& u) const { int tile = (i >> 1) * G + c; if (tile >= 512 * mult) return false; if (mult > 1) tile %= 512; const int which = i & 1; u.pm = tile >> 2; u.pn = tile & 3; u.x0 = which; u.x1 = 0; u.arow = nullptr;
        u.A = (const char*)ws + (which ? WS_YSGU : WS_YS5) + (size_t)u.pm * 256 * 1024; u.B = (const char*)ws + (which ? WS_WBS_T : WS_WB5_T) + (size_t)u.pn * 256 * 1024; return true; } };
struct EpiG5 { static constexpr bool PERM = true; unsigned char* ws;
    __device__ __forceinline__ void operator()(const acc_t& acc, const Unit& u, int wr, int wc, int fr, int fq) const {
        const bf16_t* gate = (const bf16_t*)(ws + (u.x0 ? WS_SGS : WS_SG5)); bf16_t* mg = (bf16_t*)(ws + WS_MERGED);
        const int colb = u.pn * 256 + wc * 32 + 8 * fq;
#pragma unroll
        for (int ai = 0; ai < 2; ++ai) {
            u32x4 sg[4][2], q[4][2];
#pragma unroll
            for (int m = 0; m < 4; ++m)
#pragma unroll
                for (int bj = 0; bj < 2; ++bj) { const size_t off = ((size_t)u.pm * 256 + ai * 128 + wr * 64 + m * 16 + fr) * 1024 + colb + bj * 128;
                    sg[m][bj] = *(const u32x4*)(gate + off); q[m][bj] = u.x0 ? *(const u32x4*)(mg + off) : (u32x4){0u, 0u, 0u, 0u}; }
#pragma unroll
            for (int m = 0; m < 4; ++m)
#pragma unroll
                for (int bj = 0; bj < 2; ++bj) { const size_t off = ((size_t)u.pm * 256 + ai * 128 + wr * 64 + m * 16 + fr) * 1024 + colb + bj * 128;
                    const f32x4 v0 = acc[ai][bj][m][0], v1 = acc[ai][bj][m][1]; const u32x4 g = sg[m][bj], qq = q[m][bj]; u32x4 o;
                    o.x = pk2(v0.x * bflo(g.x) + bflo(qq.x), v0.y * bfhi(g.x) + bfhi(qq.x)); o.y = pk2(v0.z * bflo(g.y) + bflo(qq.y), v0.w * bfhi(g.y) + bfhi(qq.y));
                    o.z = pk2(v1.x * bflo(g.z) + bflo(qq.z), v1.y * bfhi(g.z) + bfhi(qq.z)); o.w = pk2(v1.z * bflo(g.w) + bflo(qq.w), v1.w * bfhi(g.w) + bfhi(qq.w));
                    *(u32x4*)(mg + off) = o; }
        }
    } };
struct SchedG6 { const unsigned char* ws; int G, c, mult;
    __device__ __forceinline__ bool next(int i, Unit& u) const { int L = i * G + c; if (L >= 512 * mult) return false; if (mult > 1) L %= 512; u.pm = L >> 2; u.pn = L & 3; u.x0 = 0; u.x1 = 0; u.arow = nullptr;
        u.A = (const char*)ws + WS_MERGED + (size_t)u.pm * 256 * 2048; u.B = (const char*)ws + WS_WOUT_T + (size_t)u.pn * 256 * 2048; return true; } };
struct EpiG6 { static constexpr bool PERM = true; unsigned char* ws;
    __device__ __forceinline__ void operator()(const acc_t& acc, const Unit& u, int wr, int wc, int fr, int fq) const {
        EPI_ROWS(ai, m, rowl)
            const size_t row = (size_t)u.pm * 256 + rowl; float ssq = 0.f;
#pragma unroll
            for (int bj = 0; bj < 2; ++bj) { const int col = u.pn * 256 + bj * 128 + wc * 32 + 8 * fq; const f32x4 v0 = acc[ai][bj][m][0], v1 = acc[ai][bj][m][1]; u32x4 o;
                o.x = pk2(v0.x, v0.y); o.y = pk2(v0.z, v0.w); o.z = pk2(v1.x, v1.y); o.w = pk2(v1.z, v1.w);
                ssq += (v0.x * v0.x + v0.y * v0.y) + (v0.z * v0.z + v0.w * v0.w) + (v1.x * v1.x + v1.y * v1.y) + (v1.z * v1.z + v1.w * v1.w);
                *(u32x4*)((bf16_t*)(ws + WS_MX) + row * 1024 + col) = o; }
            ssq += __shfl_xor(ssq, 16); ssq += __shfl_xor(ssq, 32); if (fq == 0) ((float*)(ws + WS_SSQM))[row * 16 + u.pn * 4 + wc] = ssq;
        EPI_END
    } };
struct SchedG7 { const unsigned char* ws; int G, c, mult;
    __device__ __forceinline__ bool next(int i, Unit& u) const { int L = i * G + c; if (L >= 128 * mult) return false; if (mult > 1) L %= 128; u.pm = L; u.pn = 0; u.x0 = 0; u.x1 = 0; u.arow = nullptr;
        u.A = (const char*)ws + WS_XN + (size_t)u.pm * 256 * 2048; u.B = (const char*)ws + WS_WR_T; return true; } };
struct EpiG7 { static constexpr bool PERM = false; unsigned char* ws;
    __device__ __forceinline__ void operator()(const acc_t& acc, const Unit& u, int wr, int wc, int fr, int fq) const {
        EPI_ROWS(ai, m, rowl)
            float* rp = (float*)(ws + WS_LOGITS) + ((size_t)u.pm * 256 + rowl) * 256 + wc * 32 + 4 * fq;
#pragma unroll
            for (int bj = 0; bj < 2; ++bj)
#pragma unroll
                for (int n = 0; n < 2; ++n) *(f32x4*)(rp + bj * 128 + n * 16) = acc[ai][bj][m][n];
        EPI_END
    } };
struct SchedG8 { const unsigned char* ws; int G, c, mult;
    __device__ __forceinline__ bool next(int i, Unit& u) const { const int* te = (const int*)(ws + WS_TILEEXP); const int ntile = te[1500]; int L = i * G + c; if (L >= ntile * 2 * mult) return false; if (mult > 1) L %= ntile * 2;
        const int t = L >> 1; u.pm = t; u.pn = L & 1; const int e = te[t]; u.x0 = e; u.x1 = 0; u.arow = (const int*)(ws + WS_TOKSLOT) + (size_t)t * 256;
        u.A = (const char*)ws + WS_XN; u.B = (const char*)ws + WS_WGU_T + ((size_t)e * 512 + (size_t)u.pn * 256) * 2048; return true; } };
struct EpiG8 { static constexpr bool PERM = true; unsigned char* ws;
    __device__ __forceinline__ void operator()(const acc_t& acc, const Unit& u, int wr, int wc, int fr, int fq) const {
        EPI_ROWS(ai, m, rowl)
            const size_t slot = (size_t)u.pm * 256 + rowl; const int col = u.pn * 128 + wc * 32 + 8 * fq;
            const f32x4 g0 = acc[ai][0][m][0], g1 = acc[ai][0][m][1], u0 = acc[ai][1][m][0], u1 = acc[ai][1][m][1]; u32x4 o;
            o.x = pk2(silu_f(g0.x) * u0.x, silu_f(g0.y) * u0.y); o.y = pk2(silu_f(g0.z) * u0.z, silu_f(g0.w) * u0.w);
            o.z = pk2(silu_f(g1.x) * u1.x, silu_f(g1.y) * u1.y); o.w = pk2(silu_f(g1.z) * u1.z, silu_f(g1.w) * u1.w);
            *(u32x4*)((bf16_t*)(ws + WS_H) + slot * 256 + col) = o;
        EPI_END
    } };
struct SchedG9 { const unsigned char* ws; int G, c, mult;
    __device__ __forceinline__ bool next(int i, Unit& u) const { const int* te = (const int*)(ws + WS_TILEEXP); const int ntr = te[1500] - 128; int L = i * G + c; if (L >= ntr * 4 * mult) return false; if (mult > 1) L %= ntr * 4;
        const int t = L >> 2; u.pm = t; u.pn = L & 3; const int e = te[t]; u.x0 = e; u.x1 = 0; u.arow = nullptr;
        u.A = (const char*)ws + WS_H + (size_t)t * 256 * 512; u.B = (const char*)ws + WS_WD_T + ((size_t)e * 1024 + (size_t)u.pn * 256) * 512; return true; } };
__device__ __forceinline__ unsigned pk_fp8x4(f32x4 v) {
    const float a = __builtin_amdgcn_fmed3f(v.x * 8.f, -448.f, 448.f), b = __builtin_amdgcn_fmed3f(v.y * 8.f, -448.f, 448.f), c = __builtin_amdgcn_fmed3f(v.z * 8.f, -448.f, 448.f), d = __builtin_amdgcn_fmed3f(v.w * 8.f, -448.f, 448.f);
    int w = 0; w = __builtin_amdgcn_cvt_pk_fp8_f32(a, b, w, false); w = __builtin_amdgcn_cvt_pk_fp8_f32(c, d, w, true); return (unsigned)w; }
struct EpiG9 { static constexpr bool PERM = true; unsigned char* ws;
    __device__ __forceinline__ void operator()(const acc_t& acc, const Unit& u, int wr, int wc, int fr, int fq) const {
        EPI_ROWS(ai, m, rowl)
            const size_t slot = (size_t)u.pm * 256 + rowl;
            unsigned char* yp = ws + WS_YSLOT + slot * 1024 + u.pn * 256 + wc * 32 + 8 * fq;
#pragma unroll
            for (int bj = 0; bj < 2; ++bj) { u32x2 o; o.x = pk_fp8x4(acc[ai][bj][m][0]); o.y = pk_fp8x4(acc[ai][bj][m][1]); *(u32x2*)(yp + bj * 128) = o; }
        EPI_END
    } };
struct SchedG10 { const unsigned char* ws; int G, c, mult;
    __device__ __forceinline__ bool next(int i, Unit& u) const { const int* te = (const int*)(ws + WS_TILEEXP); const int ntr = te[1500] - 128; int L = i * G + c; if (L >= 512 * mult) return false; if (mult > 1) L %= 512;
        const int t = L >> 2; u.pm = t; u.pn = L & 3; u.x0 = ntr; u.x1 = 0; u.arow = nullptr;
        u.A = (const char*)ws + WS_H + (size_t)(ntr + t) * 256 * 512; u.B = (const char*)ws + WS_WD_T + ((size_t)NEXP * 1024 + (size_t)u.pn * 256) * 512; return true; } };
struct EpiG10 { static constexpr bool PERM = true; unsigned char* ws;
    __device__ __forceinline__ void operator()(const acc_t& acc, const Unit& u, int wr, int wc, int fr, int fq) const {
        EPI_ROWS(ai, m, rowl)
            bf16_t* dp = (bf16_t*)(ws + WS_MERGED) + ((size_t)u.pm * 256 + rowl) * 1024 + u.pn * 256 + wc * 32 + 8 * fq;
#pragma unroll
            for (int bj = 0; bj < 2; ++bj) { const f32x4 v0 = acc[ai][bj][m][0], v1 = acc[ai][bj][m][1]; u32x4 o;
                o.x = pk2(v0.x, v0.y); o.y = pk2(v0.z, v0.w); o.z = pk2(v1.x, v1.y); o.w = pk2(v1.z, v1.w); *(u32x4*)(dp + bj * 128) = o; }
        EPI_END
    } };

__device__ __forceinline__ void phase_sgu(const Params& p, ldsp_t lds) {
    const int tid = threadIdx.x, lane = tid & 63, wave = tid >> 6, fr = lane & 15, fq = lane >> 4, G = gridDim.x;
    constexpr int PITCH = 272;
    ldsp_t Wl = lds; ldsp_t VT = lds + 128 * PITCH; LAS float* rs = (LAS float*)(lds + 128 * PITCH + 64 * PITCH);
    const bf16_t* sguw = (const bf16_t*)(p.ws + WS_SGUW); const bf16_t* gv = (const bf16_t*)(p.ws + WS_GV); const bf16_t* gu = (const bf16_t*)(p.ws + WS_GU);
    const float* ssq = (const float*)(p.ws + WS_SSQV); const float* gn = p.in[21]; const float* bs = p.in[23];
    bf16_t* yo = (bf16_t*)(p.ws + WS_YSGU);
    for (int it = blockIdx.x; it < 2048; it += G) {
        const int chunk = it & 255, h = it >> 8; const size_t tok0 = (size_t)chunk * 128;
        __syncthreads();
        if (tid < 128) { const float* q = ssq + (tok0 + tid) * 8; const f32x4 a = *(const f32x4*)q, b = *(const f32x4*)(q + 4);
            rs[tid] = rsqrtf(((a.x + a.y) + (a.z + a.w) + (b.x + b.y) + (b.z + b.w)) * (1.0f / 512.0f) + EPS); }
#pragma unroll
        for (int i = 0; i < 4; ++i) { const int pc = tid + i * NT, row = pc >> 4, cp = pc & 15;
            *(LAS u32x4*)(Wl + row * PITCH + cp * 16) = *(const u32x4*)(sguw + ((size_t)h * 128 + row) * 128 + cp * 8); }
        __syncthreads();
#pragma unroll
        for (int i = 0; i < 2; ++i) { const int pc = tid + i * NT, s = pc >> 3, c8 = (pc & 7) * 8; const float r = rs[s];
            const u32x4 v = *(const u32x4*)(gv + (tok0 + s) * 512 + h * 64 + c8);
            LAS bf16_t* d = (LAS bf16_t*)(VT + c8 * PITCH + s * 2);
            d[0 * (PITCH / 2)] = (bf16_t)f2bf(bflo(v.x) * r); d[1 * (PITCH / 2)] = (bf16_t)f2bf(bfhi(v.x) * r); d[2 * (PITCH / 2)] = (bf16_t)f2bf(bflo(v.y) * r); d[3 * (PITCH / 2)] = (bf16_t)f2bf(bfhi(v.y) * r);
            d[4 * (PITCH / 2)] = (bf16_t)f2bf(bflo(v.z) * r); d[5 * (PITCH / 2)] = (bf16_t)f2bf(bfhi(v.z) * r); d[6 * (PITCH / 2)] = (bf16_t)f2bf(bflo(v.w) * r); d[7 * (PITCH / 2)] = (bf16_t)f2bf(bfhi(v.w) * r); }
        __syncthreads();
        f32x4 acc[4] = {(f32x4){0.f, 0.f, 0.f, 0.f}, (f32x4){0.f, 0.f, 0.f, 0.f}, (f32x4){0.f, 0.f, 0.f, 0.f}, (f32x4){0.f, 0.f, 0.f, 0.f}};
        const int t0 = wave * 16;
#pragma unroll
        for (int ks = 0; ks < 4; ++ks) {
            const bf16x8 bfr = *(const LAS bf16x8*)(Wl + (t0 + fr) * PITCH + (ks * 32 + 8 * fq) * 2);
#pragma unroll
            for (int mb = 0; mb < 4; ++mb) { const bf16x8 afr = *(const LAS bf16x8*)(VT + (mb * 16 + fr) * PITCH + (ks * 32 + 8 * fq) * 2);
                acc[mb] = __builtin_amdgcn_mfma_f32_16x16x32_bf16(afr, bfr, acc[mb], 0, 0, 0); }
        }
        const int t = t0 + fr; const float bt = bs[h * 128 + t];
#pragma unroll
        for (int mb = 0; mb < 4; ++mb) { const int c = h * 64 + mb * 16 + 4 * fq; const f32x4 gg = *(const f32x4*)(gn + c);
            const u32x2 uu = *(const u32x2*)(gu + (tok0 + t) * 512 + c); u32x2 o;
            o.x = pk2(bflo(uu.x) * (acc[mb].x * gg.x + bt), bfhi(uu.x) * (acc[mb].y * gg.y + bt)); o.y = pk2(bflo(uu.y) * (acc[mb].z * gg.z + bt), bfhi(uu.y) * (acc[mb].w * gg.w + bt));
            *(u32x2*)(yo + (tok0 + t) * 512 + c) = o; }
    }
    __syncthreads();
}

__device__ __forceinline__ size_t carry_row(int b, int d, int q) { return (q < 16) ? (size_t)(2048 + b * 16 + (d ? 15 - q : q)) : (size_t)(b * 512 + (d ? 511 - (q - 16) : (q - 16))); }
__device__ __forceinline__ void phase_carry(const Params& p, ldsp_t lds) {
    const int tid = threadIdx.x, lane = tid & 63, wave = tid >> 6, G = gridDim.x;
    const float* APL = (const float*)(p.ws + WS_APL);
    LAS f32x2* seg = (LAS f32x2*)lds;
    for (int s = blockIdx.x; s < 256; s += G) {
        const int d = s & 1, g = (s >> 1) & 31, b = s >> 6;
        const float ar = APL[((d * 32 + g) * 64 + lane) * 2], ai = APL[((d * 32 + g) * 64 + lane) * 2 + 1];
        const float* Eg = (const float*)(p.ws + WS_E) + (size_t)g * UC_ROWS * 256 + d * 128 + lane;
        bf16_t* Ug = (bf16_t*)(p.ws + WS_UCAT) + (size_t)g * UC_ROWS * 512 + 256 + d * 128 + lane;
        const int q0 = wave * 66;
        float cr = 0.f, ci = 0.f;
#pragma unroll 1
        for (int j0 = 0; j0 < 66; j0 += 11) {
            float er[11], ei[11];
#pragma unroll
            for (int j = 0; j < 11; ++j) { const size_t row = carry_row(b, d, q0 + j0 + j); er[j] = Eg[row * 256]; ei[j] = Eg[row * 256 + 64]; }
#pragma unroll
            for (int j = 0; j < 11; ++j) { const float nr = ar * cr - ai * ci + er[j], ni = ar * ci + ai * cr + ei[j]; cr = nr; ci = ni; }
        }
        __syncthreads();
        seg[wave * 64 + lane] = (f32x2){cr, ci};
        __syncthreads();
        float p2r = ar * ar - ai * ai, p2i = 2.f * ar * ai, pr = p2r, pi = p2i;
#pragma unroll
        for (int k = 0; k < 5; ++k) { const float nr = pr * pr - pi * pi, ni = 2.f * pr * pi; pr = nr; pi = ni; }
        const float Ar = pr * p2r - pi * p2i, Ai = pr * p2i + pi * p2r;
        cr = 0.f; ci = 0.f;
        for (int w = 0; w < wave; ++w) { const f32x2 e = seg[w * 64 + lane]; const float nr = Ar * cr - Ai * ci + e.x, ni = Ar * ci + Ai * cr + e.y; cr = nr; ci = ni; }
#pragma unroll 1
        for (int j0 = 0; j0 < 66; j0 += 11) {
            float er[11], ei[11];
#pragma unroll
            for (int j = 0; j < 11; ++j) { const size_t row = carry_row(b, d, q0 + j0 + j); er[j] = Eg[row * 256]; ei[j] = Eg[row * 256 + 64]; }
#pragma unroll
            for (int j = 0; j < 11; ++j) { const int q = q0 + j0 + j;
                if (q >= 16) { const size_t row = carry_row(b, d, q); Ug[row * 512] = (bf16_t)f2bf(cr); Ug[row * 512 + 64] = (bf16_t)f2bf(ci); }
                const float nr = ar * cr - ai * ci + er[j], ni = ar * ci + ai * cr + ei[j]; cr = nr; ci = ni; }
        }
    }
    __syncthreads();
}

__device__ __forceinline__ void phase_r1(const Params& p) {
    const int tid = threadIdx.x, lane = tid & 63, wave = tid >> 6, G = gridDim.x;
    const float* mod = (const float*)(p.ws + WS_MOD); const float* gpm = p.in[7]; const float* gpf = p.in[8];
    for (int row = blockIdx.x * 8 + wave; row < NTOK; row += G * 8) {
        const float* mb = mod + (size_t)(row >> 13) * 6144;
        f32x4 xv[4], gt[4], gg[4]; u32x2 mv[4];
#pragma unroll
        for (int j = 0; j < 4; ++j) { const int c = 4 * lane + 256 * j; xv[j] = __builtin_nontemporal_load((const f32x4*)(p.in[0] + (size_t)row * DM + c));
            mv[j] = *(const u32x2*)((const bf16_t*)(p.ws + WS_MX) + (size_t)row * DM + c); gt[j] = *(const f32x4*)(mb + 2048 + c); gg[j] = *(const f32x4*)(gpm + c); }
        const float* sq = (const float*)(p.ws + WS_SSQM) + (size_t)row * 16; float s0 = 0.f;
#pragma unroll
        for (int j = 0; j < 4; ++j) { const f32x4 qq = *(const f32x4*)(sq + 4 * j); s0 += (qq.x + qq.y) + (qq.z + qq.w); }
        const float rm = rsqrtf(s0 * (1.0f / DM) + EPS);
        float s = 0.f;
#pragma unroll
        for (int j = 0; j < 4; ++j) { f32x4 x1;
            x1.x = xv[j].x + gt[j].x * (bflo(mv[j].x) * rm * gg[j].x); x1.y = xv[j].y + gt[j].y * (bfhi(mv[j].x) * rm * gg[j].y);
            x1.z = xv[j].z + gt[j].z * (bflo(mv[j].y) * rm * gg[j].z); x1.w = xv[j].w + gt[j].w * (bfhi(mv[j].y) * rm * gg[j].w);
            xv[j] = x1; s += (x1.x * x1.x + x1.y * x1.y) + (x1.z * x1.z + x1.w * x1.w); }
#pragma unroll
        for (int j = 0; j < 4; ++j) { const int c = 4 * lane + 256 * j; gg[j] = *(const f32x4*)(gpf + c); gt[j] = *(const f32x4*)(mb + 3072 + c); }
        f32x4 sc[4];
#pragma unroll
        for (int j = 0; j < 4; ++j) sc[j] = *(const f32x4*)(mb + 4096 + 4 * lane + 256 * j);
        const float r1 = rsqrtf(wave_sum(s) * (1.0f / DM) + EPS);
        u32x2 ov[4];
#pragma unroll
        for (int j = 0; j < 4; ++j) { ov[j].x = pk2(xv[j].x * r1 * gg[j].x * (1.f + sc[j].x) + gt[j].x, xv[j].y * r1 * gg[j].y * (1.f + sc[j].y) + gt[j].y);
            ov[j].y = pk2(xv[j].z * r1 * gg[j].z * (1.f + sc[j].z) + gt[j].z, xv[j].w * r1 * gg[j].w * (1.f + sc[j].w) + gt[j].w); }
        bf16_t* dst = (bf16_t*)(p.ws + WS_XN) + (size_t)row * DM;
#pragma unroll
        for (int j = 0; j < 4; ++j) *(u32x2*)(dst + 4 * lane + 256 * j) = ov[j];
    }
}

__device__ __forceinline__ void phase_route(const Params& p, ldsp_t lds) {
    const int tid = threadIdx.x, lane = tid & 63, wave = tid >> 6, G = gridDim.x, g = lane & 7;
    LAS int* hist = (LAS int*)lds;
    float bs[32];
    { const float* rb = p.in[28] + g * 32;
#pragma unroll
      for (int i = 0; i < 8; ++i) { const f32x4 b4 = *(const f32x4*)(rb + 4 * i); bs[4 * i] = b4.x; bs[4 * i + 1] = b4.y; bs[4 * i + 2] = b4.z; bs[4 * i + 3] = b4.w; } }
    const float NINF = -__builtin_inff();
    for (int tile = blockIdx.x; tile < 256; tile += G) {
        __syncthreads();
        if (tid < 256) hist[tid] = 0;
        __syncthreads();
#pragma unroll 1
        for (int pass = 0; pass < 2; ++pass) {
            const int row = tile * 128 + wave * 16 + pass * 8 + (lane >> 3);
            const float* lp = (const float*)(p.ws + WS_LOGITS) + (size_t)row * 256 + g * 32;
            float sc[32], sel[32];
#pragma unroll
            for (int i = 0; i < 8; ++i) { const f32x4 l4 = *(const f32x4*)(lp + 4 * i);
                sc[4 * i] = sigmoid_f(l4.x); sc[4 * i + 1] = sigmoid_f(l4.y); sc[4 * i + 2] = sigmoid_f(l4.z); sc[4 * i + 3] = sigmoid_f(l4.w); }
            float m1 = NINF, m2 = NINF;
#pragma unroll
            for (int i = 0; i < 32; ++i) { sel[i] = sc[i] + bs[i]; m2 = fmaxf(m2, fminf(m1, sel[i])); m1 = fmaxf(m1, sel[i]); }
            const float gs = m1 + m2; int rank = 0;
#pragma unroll
            for (int m = 1; m < 8; ++m) { const float o = __shfl_xor(gs, m); const int og = g ^ m; rank += (o > gs || (o == gs && og < g)) ? 1 : 0; }
            const bool gsel = rank < 4;
            float wsum = 0.f, myW = 0.f; int myE = 0, rem = -1;
#pragma unroll
            for (int k = 0; k < 8; ++k) {
                float bv = NINF, bsc = 0.f; int bi = 0;
#pragma unroll
                for (int i = 0; i < 32; ++i) { if (k > 0) sel[i] = (i == rem) ? NINF : sel[i]; const bool gt = sel[i] > bv; bv = gt ? sel[i] : bv; bi = gt ? i : bi; bsc = gt ? sc[i] : bsc; }
                if (!gsel) bv = NINF;
                float v = bv; int e = g * 32 + bi;
#pragma unroll
                for (int m = 1; m < 8; m <<= 1) { const float ov = __shfl_xor(v, m); const int oe = __shfl_xor(e, m); const bool tk = (ov > v) || (ov == v && oe < e); v = tk ? ov : v; e = tk ? oe : e; }
                const float s_w = __shfl(bsc, (lane & ~7) | (e >> 5));
                rem = ((e >> 5) == g) ? (e & 31) : -1;
                wsum += s_w; if (g == k) { myW = s_w; myE = e; }
            }
            const float w = myW / wsum * 2.5f;
            ((int*)(p.ws + WS_IDX))[(size_t)row * 8 + g] = myE; ((float*)(p.ws + WS_WT))[(size_t)row * 8 + g] = w;
            __hip_atomic_fetch_add(&hist[myE], 1, __ATOMIC_RELAXED, __HIP_MEMORY_SCOPE_WORKGROUP);
        }
        __syncthreads();
        if (tid < 256) ((int*)(p.ws + WS_BLKCNT))[tile * 256 + tid] = hist[tid];
    }
    __syncthreads();
}
__device__ __forceinline__ void phase_scan(const Params& p, ldsp_t lds) {
    const int tid = threadIdx.x, G = gridDim.x; LAS int* sm = (LAS int*)lds;
    for (int e = blockIdx.x; e < 256; e += G) {
        __syncthreads();
        int v = 0; if (tid < 256) { v = ((const int*)(p.ws + WS_BLKCNT))[tid * 256 + e]; sm[tid] = v; }
        __syncthreads();
        for (int o = 1; o < 256; o <<= 1) { int t = 0; if (tid < 256 && tid >= o) t = sm[tid - o]; __syncthreads(); if (tid < 256) sm[tid] += t; __syncthreads(); }
        if (tid < 256) { ((int*)(p.ws + WS_BLKOFF))[tid * 256 + e] = sm[tid] - v; if (tid == 255) ((int*)(p.ws + WS_TOTAL))[e] = sm[255]; }
    }
    __syncthreads();
}
__device__ __forceinline__ void phase_scatter(const Params& p, ldsp_t lds) {
    const int tid = threadIdx.x, G = gridDim.x; LAS int* pst = (LAS int*)lds; LAS int* cnt = (LAS int*)(lds + 2048); LAS int* tot = (LAS int*)(lds + 4096);
    int* tokslot = (int*)(p.ws + WS_TOKSLOT); float* wslot = (float*)(p.ws + WS_WSLOT); int* te = (int*)(p.ws + WS_TILEEXP);
    int mytot = 0, mypad = 0;
    if (tid < 256) { mytot = ((const int*)(p.ws + WS_TOTAL))[tid]; mypad = (mytot + 255) & ~255; pst[tid] = mypad; tot[tid] = mytot; }
    __syncthreads();
    for (int o = 1; o < 256; o <<= 1) { int t = 0; if (tid < 256 && tid >= o) t = pst[tid - o]; __syncthreads(); if (tid < 256) pst[tid] += t; __syncthreads(); }
    const int pend_all = pst[255];
    __syncthreads();
    if (tid < 256) pst[tid] -= mypad;
    __syncthreads();
    const int ntr = pend_all >> 8;
    if (blockIdx.x == 0 && tid == 0) te[1500] = ntr + 128;
    for (int e = blockIdx.x; e < 256; e += G) { const int s0 = pst[e], n = tot[e], pe = s0 + ((n + 255) & ~255);
        for (int t = (s0 >> 8) + tid; t < (pe >> 8); t += NT) te[t] = e;
        for (int s = s0 + n + tid; s < pe; s += NT) { tokslot[s] = 0; wslot[s] = 0.f; } }
    for (int t = blockIdx.x * NT + tid; t < NTOK; t += G * NT) { tokslot[pend_all + t] = t; wslot[pend_all + t] = 1.0f; if (t < 128) te[ntr + t] = NEXP; }
    for (int tile = blockIdx.x; tile < 256; tile += G) {
        __syncthreads();
        if (tid < 256) cnt[tid] = 0;
        __syncthreads();
        for (int q = tid; q < 1024; q += NT) { const int row = tile * 128 + (q >> 3), k = q & 7; const int e = ((const int*)(p.ws + WS_IDX))[(size_t)row * 8 + k];
            const int r = __hip_atomic_fetch_add(&cnt[e], 1, __ATOMIC_RELAXED, __HIP_MEMORY_SCOPE_WORKGROUP); const int slot = pst[e] + ((const int*)(p.ws + WS_BLKOFF))[tile * 256 + e] + r;
            tokslot[slot] = row; wslot[slot] = ((const float*)(p.ws + WS_WT))[(size_t)row * 8 + k]; ((int*)(p.ws + WS_SLOT))[(size_t)row * 8 + k] = slot; }
    }
    __syncthreads();
}

__device__ __forceinline__ void phase_r3(const Params& p) {
    const int tid = threadIdx.x, lane = tid & 63, wave = __builtin_amdgcn_readfirstlane(tid >> 6), G = gridDim.x;
    const unsigned char* ys = p.ws + WS_YSLOT + 16 * lane; const float* mod = (const float*)(p.ws + WS_MOD); const float* gpm = p.in[7] + 16 * lane; const float* gpo = p.in[9] + 16 * lane;
    int row = blockIdx.x * 8 + wave;
    int slv[8]; float wtv[8];
    if (row < NTOK) {
#pragma unroll
        for (int k = 0; k < 8; ++k) { slv[k] = ((const int*)(p.ws + WS_SLOT))[(size_t)row * 8 + k]; wtv[k] = ((const float*)(p.ws + WS_WT))[(size_t)row * 8 + k]; } }
    for (; row < NTOK; row += G * 8) {
        const float* xrow = p.in[0] + (size_t)row * DM + 16 * lane; float* orow = p.out + (size_t)row * DM + 16 * lane; const bf16_t* mrow = (const bf16_t*)(p.ws + WS_MX) + (size_t)row * DM + 16 * lane;
        u32x4 yv[8]; f32x4 f[4], xa[4]; float wk[8];
#pragma unroll
        for (int k = 0; k < 8; ++k) { yv[k] = __builtin_nontemporal_load((const u32x4*)(ys + (size_t)slv[k] * 1024)); wk[k] = wtv[k] * 0.125f; }
#pragma unroll
        for (int j = 0; j < 4; ++j) xa[j] = __builtin_nontemporal_load((const f32x4*)(xrow + 4 * j));
        { const bf16_t* frow = (const bf16_t*)(p.ws + WS_MERGED) + (size_t)row * DM + 16 * lane;
          const u32x4 h0 = __builtin_nontemporal_load((const u32x4*)frow), h1 = __builtin_nontemporal_load((const u32x4*)(frow + 8));
          f[0] = (f32x4){bflo(h0.x), bfhi(h0.x), bflo(h0.y), bfhi(h0.y)}; f[1] = (f32x4){bflo(h0.z), bfhi(h0.z), bflo(h0.w), bfhi(h0.w)};
          f[2] = (f32x4){bflo(h1.x), bfhi(h1.x), bflo(h1.y), bfhi(h1.y)}; f[3] = (f32x4){bflo(h1.z), bfhi(h1.z), bflo(h1.w), bfhi(h1.w)}; }
        const u32x4 m0 = __builtin_nontemporal_load((const u32x4*)mrow), m1 = __builtin_nontemporal_load((const u32x4*)(mrow + 8));
        const float* sq = (const float*)(p.ws + WS_SSQM) + (size_t)row * 16;
        const f32x4 q0 = *(const f32x4*)sq, q1 = *(const f32x4*)(sq + 4), q2 = *(const f32x4*)(sq + 8), q3 = *(const f32x4*)(sq + 12);
        { const int nrow = row + G * 8;
          if (nrow < NTOK) {
#pragma unroll
              for (int k = 0; k < 8; ++k) { slv[k] = ((const int*)(p.ws + WS_SLOT))[(size_t)nrow * 8 + k]; wtv[k] = ((const float*)(p.ws + WS_WT))[(size_t)nrow * 8 + k]; } } }
#pragma unroll
        for (int k = 0; k < 8; ++k) { const float w = wk[k];
#pragma unroll
            for (int j = 0; j < 4; ++j) { const int wd = (int)yv[k][j]; const f32x2 lo = __builtin_amdgcn_cvt_pk_f32_fp8(wd, false), hi = __builtin_amdgcn_cvt_pk_f32_fp8(wd, true);
                f[j].x += w * lo.x; f[j].y += w * lo.y; f[j].z += w * hi.x; f[j].w += w * hi.y; } }
        float s = 0.f;
#pragma unroll
        for (int j = 0; j < 4; ++j) s += (f[j].x * f[j].x + f[j].y * f[j].y) + (f[j].z * f[j].z + f[j].w * f[j].w);
        const float rf = rsqrtf(wave_sum(s) * (1.0f / DM) + EPS);
        const float rm = rsqrtf((((q0.x + q0.y) + (q0.z + q0.w)) + ((q1.x + q1.y) + (q1.z + q1.w)) + ((q2.x + q2.y) + (q2.z + q2.w)) + ((q3.x + q3.y) + (q3.z + q3.w))) * (1.0f / DM) + EPS);
        const float* mb = mod + (size_t)(row >> 13) * 6144 + 16 * lane;
        const unsigned mw[8] = {m0.x, m0.y, m0.z, m0.w, m1.x, m1.y, m1.z, m1.w};
        f32x4 gma[4], gfa[4], pma[4], poa[4], oa[4];
#pragma unroll
        for (int j = 0; j < 4; ++j) { gma[j] = *(const f32x4*)(mb + 2048 + 4 * j); gfa[j] = *(const f32x4*)(mb + 5120 + 4 * j); pma[j] = *(const f32x4*)(gpm + 4 * j); poa[j] = *(const f32x4*)(gpo + 4 * j); }
#pragma unroll
        for (int j = 0; j < 4; ++j) {
            oa[j].x = xa[j].x + gma[j].x * (bflo(mw[2 * j]) * rm * pma[j].x) + gfa[j].x * (f[j].x * rf * poa[j].x); oa[j].y = xa[j].y + gma[j].y * (bfhi(mw[2 * j]) * rm * pma[j].y) + gfa[j].y * (f[j].y * rf * poa[j].y);
            oa[j].z = xa[j].z + gma[j].z * (bflo(mw[2 * j + 1]) * rm * pma[j].z) + gfa[j].z * (f[j].z * rf * poa[j].z); oa[j].w = xa[j].w + gma[j].w * (bfhi(mw[2 * j + 1]) * rm * pma[j].w) + gfa[j].w * (f[j].w * rf * poa[j].w); }
#pragma unroll
        for (int j = 0; j < 4; ++j) __builtin_nontemporal_store(oa[j], (f32x4*)(orow + 4 * j));
    }
}

#define XB_TMO      128
#define XB_XCNT(j)  (256  + 64 * (j))
#define XB_XSUB(j)  (1280 + 64 * (j))
#define XB_XGEN(j)  (2304 + 64 * (j))
#define XB_TOP      3328
#define XB_TOPGEN   3392
#define XCD_BAR_WORDS 3456
#define XB_SPIN_CAP (1u << 18)
__device__ __forceinline__ unsigned xb_ld(unsigned* p)              { return __hip_atomic_load(p, __ATOMIC_RELAXED, __HIP_MEMORY_SCOPE_AGENT); }
__device__ __forceinline__ unsigned xb_add(unsigned* p, unsigned v) { return __hip_atomic_fetch_add(p, v, __ATOMIC_RELAXED, __HIP_MEMORY_SCOPE_AGENT); }
__device__ __forceinline__ unsigned xb_xcc_id() { return (unsigned)__builtin_amdgcn_s_getreg((3 << 11) | 20) & 0xFu; }
#define XB_SPIN(cond, bar) do { unsigned _sp = 0; while (cond) { __builtin_amdgcn_s_sleep(1); \
    if ((++_sp & 255u) == 0u) { if (xb_ld(&(bar)[XB_TMO])) break; if (_sp > XB_SPIN_CAP) { atomicAdd(&(bar)[XB_TMO], 1u); break; } } } } while (0)
struct XcdBarrier { unsigned* bar; unsigned x; volatile LAS unsigned* st; };
__device__ __forceinline__ XcdBarrier xcd_barrier_post(unsigned* bar, volatile LAS unsigned* st) {
    XcdBarrier b; b.bar = bar; b.x = xb_xcc_id(); b.st = st;
    if (threadIdx.x == 0) (void)xb_add(&bar[XB_XCNT(b.x)], 1u);
    return b;
}
__device__ __forceinline__ void xcd_barrier_complete(unsigned* bar, unsigned x, unsigned& nloc, unsigned& nx) {
    const unsigned G = gridDim.x * gridDim.y * gridDim.z;
    unsigned sum, cnt, mine, sp = 0u;
    for (;;) {
        sum = 0u; cnt = 0u; mine = 0u;
#pragma unroll
        for (unsigned j = 0; j < 16; ++j) { const unsigned c = xb_ld(&bar[XB_XCNT(j)]); sum += c; cnt += (c > 0u) ? 1u : 0u; mine = (j == x) ? c : mine; }
        if (sum == G) break;
        __builtin_amdgcn_s_sleep(1);
        if ((++sp & 255u) == 0u) { if (xb_ld(&bar[XB_TMO])) break; if (sp > XB_SPIN_CAP) { atomicAdd(&bar[XB_TMO], 1u); break; } }
    }
    nloc = mine > 0u ? mine : 1u; nx = cnt > 0u ? cnt : 1u;
}
__device__ __forceinline__ void xcd_barrier(const XcdBarrier& b) {
    asm volatile("s_waitcnt vmcnt(0)" ::: "memory");
    __syncthreads();
    if (threadIdx.x == 0) {
        unsigned* bar = b.bar;
        __builtin_amdgcn_s_waitcnt(0);
        unsigned nloc = b.st[0], nx = b.st[1];
        if (nloc == 0u) { xcd_barrier_complete(bar, b.x, nloc, nx); b.st[0] = nloc; b.st[1] = nx; }
        const unsigned old = xb_add(&bar[XB_XSUB(b.x)], 1u);
        const unsigned gen = old / nloc;
        if (old + 1u == (gen + 1u) * nloc) {
            __builtin_amdgcn_fence(__ATOMIC_RELEASE, "agent");
            asm volatile("s_waitcnt vmcnt(0)" ::: "memory");
            const unsigned og = xb_add(&bar[XB_TOP], 1u);
            const unsigned tg = og / nx;
            if (og + 1u == (tg + 1u) * nx) xb_add(&bar[XB_TOPGEN], 1u);
            else XB_SPIN(xb_ld(&bar[XB_TOPGEN]) == tg, bar);
            __builtin_amdgcn_fence(__ATOMIC_ACQUIRE, "agent");
            xb_add(&bar[XB_XGEN(b.x)], 1u);
            asm volatile("s_waitcnt vmcnt(0)" ::: "memory");
        } else {
            XB_SPIN(xb_ld(&bar[XB_XGEN(b.x)]) == gen, bar);
            __builtin_amdgcn_fence(__ATOMIC_ACQUIRE, "agent");
            asm volatile("s_waitcnt vmcnt(0)" ::: "memory");
        }
    }
    __syncthreads();
}

constexpr int N_PHASES = 17;
__global__ void __launch_bounds__(NT, 2) fwd_kernel(Params p) {
    extern __shared__ __attribute__((aligned(16))) unsigned char lds_raw[];
    ldsp_t lds = (ldsp_t)lds_raw;
    const int G = gridDim.x, c = (G % 8 == 0) ? (int)(blockIdx.x % 8) * (G / 8) + (int)(blockIdx.x / 8) : (int)blockIdx.x;
    const int lo = p.ph_lo, hi = p.ph_hi;
    volatile LAS unsigned* bst = (volatile LAS unsigned*)(lds + LDS_BYTES - 16);
    if (threadIdx.x < 4) bst[threadIdx.x] = 0u;
    __syncthreads();
    XcdBarrier bar = xcd_barrier_post((unsigned*)p.ws, bst);
    unsigned long long spin_acc = 0;
#ifdef ONLY_PHASE
#define IN(k) ((k) == ONLY_PHASE && lo <= (k) && (k) < hi)
#else
#define IN(k) (lo <= (k) && (k) < hi)
#endif
#define TS_BEGIN(k) unsigned long long ts0_ = 0; if (SPIN_PHASE == (k)) ts0_ = __builtin_amdgcn_s_memrealtime();
#define TS_END(k) if (SPIN_PHASE == (k)) spin_acc += __builtin_amdgcn_s_memrealtime() - ts0_;
#define PH(k, ...) if (IN(k)) { TS_BEGIN(k) const int nrep_ = (DUP_PHASE == (k)) ? (1 + DUP_REPS + lo) : 1; _Pragma("nounroll") for (int r_ = 0; r_ < nrep_; ++r_) { if (r_) xcd_barrier(bar); __VA_ARGS__ } SEAM(k); TS_END(k) }
#define PG(k, ...) if (IN(k)) { TS_BEGIN(k) __VA_ARGS__ SEAM(k); TS_END(k) }
#define MULT(k) ((DUP_PHASE == (k)) ? (1 + DUP_REPS) : 1)
#define SEAM(k) do { if (IN((k) + 1)) { if ((k) == 0) cg::this_grid().sync(); else xcd_barrier(bar); } } while (0)
    PH(0, phase_prep(p, lds);)
    PH(1, phase_xn(p, lds);)
    PG(2, SchedG1 S{p.ws, G, c, MULT(2)}; EpiG1 E{p.ws}; pg8::gemm_phase<EpiG1, SchedG1, false>(lds, 1024, 2048u, 2048u, S, E);)
    PG(3, SchedG2 S{p.ws, G, c, MULT(3)}; EpiG2 E{p.ws}; pg8::gemm_phase<EpiG2, SchedG2, false>(lds, 256, 1024u, 512u, S, E);)
    PH(4, if (r_ == 0 || DUP_SUB != 1) phase_carry(p, lds); if (r_ == 0 || DUP_SUB != 0) phase_sgu(p, lds);)
    PG(5, SchedG3 S{p.ws, G, c, MULT(5)}; EpiG3 E{p.ws}; pg8::gemm_phase<EpiG3, SchedG3, false>(lds, 512, 1024u, 1024u, S, E);)
    PG(6, SchedG4 S{p.ws, G, c, MULT(6)}; EpiG4 E{p.ws, p.in[20]}; pg8::gemm_phase<EpiG4, SchedG4, false>(lds, 512, 1024u, 1024u, S, E);)
    PG(7, SchedG5 S{p.ws, G, c, MULT(7)}; EpiG5 E{p.ws}; pg8::gemm_phase<EpiG5, SchedG5, false>(lds, 512, 1024u, 1024u, S, E);)
    PG(8, SchedG6 S{p.ws, G, c, MULT(8)}; EpiG6 E{p.ws}; pg8::gemm_phase<EpiG6, SchedG6, false>(lds, 1024, 2048u, 2048u, S, E);)
    PH(9, phase_r1(p);)
    PG(10, SchedG7 S{p.ws, G, c, MULT(10)}; EpiG7 E{p.ws}; pg8::gemm_phase<EpiG7, SchedG7, false>(lds, 1024, 2048u, 2048u, S, E);)
    PH(11, phase_route(p, lds);)
    PH(12, phase_scan(p, lds);)
    PH(13, phase_scatter(p, lds);)
    PG(14, SchedG8 S{p.ws, G, c, MULT(14)}; EpiG8 E{p.ws}; pg8::gemm_phase<EpiG8, SchedG8, true>(lds, 1024, 2048u, 2048u, S, E);)
    PG(15, { SchedG9 S{p.ws, G, c, MULT(15)}; EpiG9 E{p.ws}; pg8::gemm_phase<EpiG9, SchedG9, false>(lds, 256, 512u, 512u, S, E); } { SchedG10 S{p.ws, G, c, MULT(19)}; EpiG10 E{p.ws}; pg8::gemm_phase<EpiG10, SchedG10, false>(lds, 256, 512u, 512u, S, E); })
    PH(16, phase_r3(p);)
    if (SPIN_PHASE >= 0) { const unsigned long long t0_ = __builtin_amdgcn_s_memrealtime(); while (__builtin_amdgcn_s_memrealtime() - t0_ < spin_acc * SPIN_MULT) __builtin_amdgcn_s_sleep(8); }
#undef IN
#undef SEAM
#undef PH
#undef PG
#undef MULT
}

extern "C" void kernel_launch(void* const* d_in, const int* in_sizes, int n_in, void* d_out, int out_size, void* d_ws, size_t ws_size, hipStream_t stream) {
    static int grid = 0;
    if (grid == 0) {
        if (n_in != 35 || out_size != NTOK * DM || ws_size < WS_NEED) { fprintf(stderr, "kernel_launch: unexpected shapes / workspace (%d inputs, out %d, ws %zu)\n", n_in, out_size, ws_size); grid = -1; return; }
        int dev = 0, cus = 0, per_cu = 0;
        hipGetDevice(&dev); hipDeviceGetAttribute(&cus, hipDeviceAttributeMultiprocessorCount, dev);
        hipFuncSetAttribute((const void*)fwd_kernel, hipFuncAttributeMaxDynamicSharedMemorySize, LDS_BYTES);
        hipOccupancyMaxActiveBlocksPerMultiprocessor(&per_cu, (const void*)fwd_kernel, NT, LDS_BYTES);
        if (per_cu < 1) { fprintf(stderr, "kernel_launch: occupancy query says %d blocks per CU\n", per_cu); per_cu = 1; }
        grid = cus * 1;
        (void)hipGetLastError();
    }
    if (grid < 0) return;
    Params p{};
    for (int i = 0; i < 35; ++i) p.in[i] = (const float*)d_in[i];
    p.out = (float*)d_out; p.ws = (unsigned char*)d_ws;
#if N_LAUNCH_MODE == 1
    hipMemsetAsync(d_ws, 0, 16384, stream);
    p.ph_lo = 0; p.ph_hi = N_PHASES;
    void* args[] = {&p};
    hipError_t e = hipLaunchCooperativeKernel((const void*)fwd_kernel, dim3(grid), dim3(NT), args, LDS_BYTES, stream);
    if (e != hipSuccess) fprintf(stderr, "cooperative launch failed: %s (grid %d)\n", hipGetErrorString(e), grid);
#else
    for (int k = 0; k < N_PHASES; ++k) { p.ph_lo = k; p.ph_hi = k + 1; hipLaunchKernelGGL(fwd_kernel, dim3(grid), dim3(NT), LDS_BYTES, stream, p); }
#endif
}
```

```cpp
#include <hip/hip_runtime.h>
#include <hip/hip_cooperative_groups.h>
#include <cstdio>
namespace cg = cooperative_groups;

#ifndef DUP_PHASE
#define DUP_PHASE -1
#define DUP_REPS 1
#define DUP_SUB -1
#define SPIN_PHASE -1
#define SPIN_MULT 9
#endif
#ifndef N_LAUNCH_MODE
#define N_LAUNCH_MODE 1
#endif

#define LAS __attribute__((address_space(3)))
typedef unsigned short bf16_t;
typedef short bf16x8 __attribute__((ext_vector_type(8)));
typedef float f32x4 __attribute__((ext_vector_type(4)));
typedef float f32x2 __attribute__((ext_vector_type(2)));
typedef unsigned u32x4 __attribute__((ext_vector_type(4)));
typedef unsigned u32x2 __attribute__((ext_vector_type(2)));
typedef LAS unsigned char* ldsp_t;

constexpr int NT = 512;
constexpr int DM = 1024;
constexpr int NTOK = 32768;
constexpr int NCTXR = 1024;
constexpr int NROWS = NTOK + NCTXR;
constexpr int DIN = 3584;
constexpr int UC_ROWS = 2304;
constexpr int NEXP = 256;
constexpr int MAXSLOT = 360448;
constexpr float EPS = 1e-6f;

constexpr size_t MiB = 1u << 20;
constexpr size_t WS_MODP = 1 * MiB;
constexpr size_t WS_MOD = 3 * MiB;
constexpr size_t WS_APL = 3 * MiB + 256 * 1024;
constexpr size_t WS_SGUW = 3 * MiB + 512 * 1024;
constexpr size_t WS_WGLU_T = 4 * MiB;
constexpr size_t WS_WR_T = 4 * MiB + 512 * 1024;
constexpr size_t WS_WB5_T = 5 * MiB;
constexpr size_t WS_WBS_T = 6 * MiB;
constexpr size_t WS_WOUT_T = 7 * MiB;
constexpr size_t WS_WIN_T = 9 * MiB;
constexpr size_t WS_BCAT_T = 16 * MiB;
constexpr size_t WS_WEND_T = 24 * MiB;
constexpr size_t WS_SSQV = 28 * MiB;
constexpr size_t WS_SSQM = 29 * MiB;
constexpr size_t WS_IDX = 31 * MiB;
constexpr size_t WS_WT = 32 * MiB;
constexpr size_t WS_SLOT = 33 * MiB;
constexpr size_t WS_BLKCNT = 34 * MiB;
constexpr size_t WS_BLKOFF = 34 * MiB + 256 * 1024;
constexpr size_t WS_TOTAL = 34 * MiB + 512 * 1024;
constexpr size_t WS_TILEEXP = 34 * MiB + 768 * 1024;
constexpr size_t WS_TOKSLOT = 35 * MiB;
constexpr size_t WS_WSLOT = 36 * MiB + 512 * 1024;
constexpr size_t WS_WD_T = 48 * MiB;
constexpr size_t WS_WGU_T = 177 * MiB;
constexpr size_t WS_XN = 434 * MiB;
constexpr size_t WS_UCAT = 500 * MiB;
constexpr size_t WS_E = 572 * MiB;
constexpr size_t WS_GU = 644 * MiB;
constexpr size_t WS_GV = 676 * MiB;
constexpr size_t WS_SG5 = 708 * MiB;
constexpr size_t WS_SGS = 772 * MiB;
constexpr size_t WS_YS = 836 * MiB;
constexpr size_t WS_YS5 = 868 * MiB;
constexpr size_t WS_YSGU = 900 * MiB;
constexpr size_t WS_MX = 932 * MiB;
constexpr size_t WS_MERGED = 500 * MiB;
constexpr size_t WS_LOGITS = 564 * MiB;
constexpr size_t WS_H = 596 * MiB;
constexpr size_t WS_YSLOT = 177 * MiB;
constexpr size_t WS_NEED = 996 * MiB;

constexpr int LDS_BYTES = 147456;

struct Params { const float* in[35]; float* out; unsigned char* ws; int ph_lo, ph_hi; };

__device__ __forceinline__ unsigned f2bf(float f) { unsigned u = __builtin_bit_cast(unsigned, f); return (u + 0x7fffu + ((u >> 16) & 1u)) >> 16; }
typedef __bf16 bf16v2_t __attribute__((ext_vector_type(2)));
__device__ __forceinline__ unsigned pk2(float lo, float hi) { bf16v2_t v; v.x = (__bf16)lo; v.y = (__bf16)hi; return __builtin_bit_cast(unsigned, v); }
__device__ __forceinline__ float bflo(unsigned w) { return __builtin_bit_cast(float, w << 16); }
__device__ __forceinline__ float bfhi(unsigned w) { return __builtin_bit_cast(float, w & 0xffff0000u); }
__device__ __forceinline__ float bf2f(bf16_t b) { return __builtin_bit_cast(float, ((unsigned)b) << 16); }
__device__ __forceinline__ float sigmoid_f(float x) { return __builtin_amdgcn_rcpf(1.0f + __expf(-x)); }
__device__ __forceinline__ float silu_f(float x) { return x * sigmoid_f(x); }
__device__ __forceinline__ float gelu_f(float x) { const float z = 1.5957691216057308f * (x + 0.044715f * x * x * x); return x * sigmoid_f(z); }
__device__ __forceinline__ float wave_sum(float v) {
#pragma unroll
    for (int o = 1; o < 64; o <<= 1) v += __shfl_xor(v, o);
    return v;
}
template <int CTRL, int RM = 0xf, int BM = 0xf> __device__ __forceinline__ float dpp_f(float oldv, float x) {
    return __builtin_bit_cast(float, __builtin_amdgcn_update_dpp(__builtin_bit_cast(int, oldv), __builtin_bit_cast(int, x), CTRL, RM, BM, false)); }
__device__ __forceinline__ float wave_max_dpp(float v) {
    v = fmaxf(v, dpp_f<0xB1>(v, v)); v = fmaxf(v, dpp_f<0x4E>(v, v)); v = fmaxf(v, dpp_f<0x124>(v, v)); v = fmaxf(v, dpp_f<0x128>(v, v));
    v = fmaxf(v, dpp_f<0x142, 0xa>(v, v)); v = fmaxf(v, dpp_f<0x143, 0xc>(v, v));
    return __builtin_bit_cast(float, __builtin_amdgcn_readlane(__builtin_bit_cast(int, v), 63)); }
#define LDS_WAIT() asm volatile("s_waitcnt lgkmcnt(0)" ::: "memory")

__device__ __forceinline__ double dexp_(double x) {
    const double r = x * (1.0 / 32.0); double t = 1.0, s = 1.0;
#pragma unroll 1
    for (int i = 1; i <= 14; ++i) { t *= r / (double)i; s += t; }
#pragma unroll 1
    for (int i = 0; i < 5; ++i) s *= s;
    return s;
}
__device__ __forceinline__ void dsincos_(double th, double& sn, double& cs) {
    const double TWO_PI_HI = 6.283185307179586232, TWO_PI_LO = 2.4492935982947064e-16;
    const double k = __builtin_rint(th * 0.15915494309189535);
    double r = (th - k * TWO_PI_HI) - k * TWO_PI_LO;
    r *= 0.125;
    const double r2 = r * r; double ts = r, tc = 1.0, s = r, c = 1.0;
#pragma unroll 1
    for (int i = 1; i <= 9; ++i) { tc *= -r2 / (double)((2 * i - 1) * (2 * i)); c += tc; ts *= -r2 / (double)((2 * i) * (2 * i + 1)); s += ts; }
#pragma unroll 1
    for (int i = 0; i < 3; ++i) { const double s2 = 2.0 * s * c, c2 = c * c - s * s; s = s2; c = c2; }
    sn = s; cs = c;
}

namespace pg8 {
constexpr int BM = 256, BK = 64, HALF = 128, HTB = HALF * BK * 2, STAGE_BYTES = 8 * HTB;
__device__ __forceinline__ int lds_byte(int r, int c) { const int st = (r >> 4) * 2 + (c >> 5), rr = r & 15, cc = c & 31, ob = rr * 64 + cc * 2; return st * 1024 + (ob ^ (((ob >> 9) & 1) << 5)); }
__device__ __forceinline__ void stage_rc(int b, int& R, int& C) { const int st = b / 1024, sb = b % 1024, swz = sb ^ (((sb >> 9) & 1) << 5); R = (st >> 1) * 16 + swz / 64; C = (st & 1) * 32 + (swz % 64) / 2; }
__device__ __forceinline__ int perm32(int rho) { const int n = rho >> 4, i = rho & 15; return 8 * (i >> 2) + 4 * n + (i & 3); }

struct Unit { const char* A; const char* B; const int* arow; int pm, pn, x0, x1; };

template <class Epi, class Sched, bool GATHER>
__device__ __forceinline__ void gemm_phase(ldsp_t lds, const int K, const unsigned lda, const unsigned ldb, const Sched& S, const Epi& E) {
    const int tid = threadIdx.x, wid = __builtin_amdgcn_readfirstlane(tid >> 6), lane = tid & 63, wr = wid >> 2, wc = wid & 3, fr = lane & 15, fq = lane >> 4;
    const int nt = K / BK;
    int RA[2], CA[2]; unsigned voffB[2][2];
#pragma unroll
    for (int i = 0; i < 2; ++i) { int R, C; stage_rc(tid * 16 + i * 8192, R, C); RA[i] = R; CA[i] = C; const int Rb = Epi::PERM ? ((R & ~31) + perm32(R & 31)) : R;
        voffB[0][i] = (unsigned)Rb * ldb + (unsigned)C * 2u; voffB[1][i] = (unsigned)(Rb + HALF) * ldb + (unsigned)C * 2u; }
    unsigned vA[2][2], vN[2][2];
#define PG8_SETA(v, u) do { _Pragma("unroll") for (int _h = 0; _h < 2; ++_h) _Pragma("unroll") for (int _i = 0; _i < 2; ++_i) { \
        const int _row = _h * HALF + RA[_i]; const unsigned _src = GATHER ? (unsigned)(u).arow[_row] : (unsigned)_row; (v)[_h][_i] = _src * lda + (unsigned)CA[_i] * 2u; } } while (0)
    const size_t kstep = (size_t)(BK * 2);
    const unsigned ldsw = (unsigned)wid * 1024u;
    const int aoff = lds_byte(wr * 64 + fr, fq * 8), boff = lds_byte(wc * 32 + fr, fq * 8);
#define PG8_SA(b, h) (((b) * 2 + (h)) * HTB)
#define PG8_SB(b, h) ((4 + (b) * 2 + (h)) * HTB)
#define PG8_STAGE(bufoff, gbase, o0, o1) do { \
        __builtin_amdgcn_global_load_lds((const unsigned*)((const char*)(gbase) + (o0)), (LAS unsigned*)(lds + (bufoff) + ldsw), 16, 0, 0); \
        __builtin_amdgcn_global_load_lds((const unsigned*)((const char*)(gbase) + (o1)), (LAS unsigned*)(lds + (bufoff) + ldsw + 8192), 16, 0, 0); } while (0)
#define PG8_LDA(dst, b, h) do { _Pragma("unroll") for (int m = 0; m < 4; ++m) _Pragma("unroll") for (int k = 0; k < 2; ++k) dst[m][k] = *(const LAS bf16x8*)(lds + PG8_SA(b, h) + aoff + m * 2048 + k * 1024); } while (0)
#define PG8_LDB(dst, b, h) do { _Pragma("unroll") for (int n = 0; n < 2; ++n) _Pragma("unroll") for (int k = 0; k < 2; ++k) dst[n][k] = *(const LAS bf16x8*)(lds + PG8_SB(b, h) + boff + n * 2048 + k * 1024); } while (0)
#define PG8_MMA(ai, bj, At, Bt) do { __builtin_amdgcn_s_setprio(1); _Pragma("unroll") for (int m = 0; m < 4; ++m) _Pragma("unroll") for (int n = 0; n < 2; ++n) _Pragma("unroll") for (int k = 0; k < 2; ++k) \
        acc[ai][bj][m][n] = __builtin_amdgcn_mfma_f32_16x16x32_bf16(Bt[n][k], At[m][k], acc[ai][bj][m][n], 0, 0, 0); __builtin_amdgcn_s_setprio(0); } while (0)
#define PG8_WAIT_V(n) asm volatile("s_waitcnt vmcnt(" #n ")" ::: "memory")
#define PG8_WAIT_L(n) asm volatile("s_waitcnt lgkmcnt(" #n ")" ::: "memory")
#define PG8_BAR __builtin_amdgcn_s_barrier()
#define PG8_SCHED __builtin_amdgcn_sched_barrier(0)
    Unit cur, nxt; int ui = 0;
    if (!S.next(0, cur)) return;
    PG8_SETA(vA, cur);
    f32x4 acc[2][2][4][2];
#pragma unroll
    for (int a = 0; a < 2; ++a)
#pragma unroll
        for (int b = 0; b < 2; ++b)
#pragma unroll
            for (int m = 0; m < 4; ++m)
#pragma unroll
                for (int n = 0; n < 2; ++n) acc[a][b][m][n] = (f32x4){0.f, 0.f, 0.f, 0.f};
    bf16x8 At[4][2], B0[2][2], B1[2][2];
    const char* cA = cur.A; const char* cB = cur.B;
    PG8_STAGE(PG8_SB(0, 0), cB, voffB[0][0], voffB[0][1]); PG8_STAGE(PG8_SA(0, 0), cA, vA[0][0], vA[0][1]);
    PG8_STAGE(PG8_SB(0, 1), cB, voffB[1][0], voffB[1][1]); PG8_STAGE(PG8_SA(0, 1), cA, vA[1][0], vA[1][1]);
    if (wr == 1) PG8_BAR;
    PG8_WAIT_V(4); PG8_BAR;
    PG8_STAGE(PG8_SB(1, 0), cB + kstep, voffB[0][0], voffB[0][1]); PG8_STAGE(PG8_SA(1, 0), cA + kstep, vA[0][0], vA[0][1]);
    PG8_STAGE(PG8_SB(1, 1), cB + kstep, voffB[1][0], voffB[1][1]);
    PG8_WAIT_V(6); PG8_BAR;
    for (;;) {
        const bool has_next = S.next(ui + 1, nxt);
        const char* nA = has_next ? nxt.A : cA; const char* nB = has_next ? nxt.B : cB;
        if (GATHER) { if (has_next && nxt.arow != cur.arow) { PG8_SETA(vN, nxt); } else { vN[0][0] = vA[0][0]; vN[0][1] = vA[0][1]; vN[1][0] = vA[1][0]; vN[1][1] = vA[1][1]; } }
#pragma nounroll
        for (int t = 0; t < nt; t += 2) {
            const bool last = (t == nt - 2);
            const char* a1 = cA + (size_t)(t + 1) * kstep;
            const char* a2 = last ? nA : cA + (size_t)(t + 2) * kstep; const char* b2 = last ? nB : cB + (size_t)(t + 2) * kstep;
            const char* a3 = a2 + kstep; const char* b3 = b2 + kstep;
            unsigned o00, o01, o10, o11;
            if (GATHER && last) { o00 = vN[0][0]; o01 = vN[0][1]; o10 = vN[1][0]; o11 = vN[1][1]; } else { o00 = vA[0][0]; o01 = vA[0][1]; o10 = vA[1][0]; o11 = vA[1][1]; }
            PG8_LDB(B0, 0, 0); PG8_SCHED; PG8_LDA(At, 0, 0); PG8_STAGE(PG8_SA(1, 1), a1, vA[1][0], vA[1][1]);
            PG8_WAIT_L(8); PG8_BAR; PG8_WAIT_L(0); PG8_MMA(0, 0, At, B0); PG8_BAR; PG8_SCHED;
            PG8_LDB(B1, 0, 1); PG8_STAGE(PG8_SB(0, 0), b2, voffB[0][0], voffB[0][1]);
            PG8_BAR; PG8_WAIT_L(0); PG8_MMA(0, 1, At, B1); PG8_BAR;
            PG8_LDA(At, 0, 1); PG8_STAGE(PG8_SA(0, 0), a2, o00, o01);
            PG8_BAR; PG8_WAIT_L(0); PG8_MMA(1, 0, At, B0); PG8_BAR; PG8_SCHED;
            PG8_STAGE(PG8_SB(0, 1), b2, voffB[1][0], voffB[1][1]);
            PG8_WAIT_V(6); PG8_BAR; PG8_MMA(1, 1, At, B1); PG8_BAR;
            PG8_LDB(B0, 1, 0); PG8_SCHED; PG8_LDA(At, 1, 0); PG8_STAGE(PG8_SA(0, 1), a2, o10, o11);
            PG8_WAIT_L(8); PG8_BAR; PG8_WAIT_L(0); PG8_MMA(0, 0, At, B0); PG8_BAR; PG8_SCHED;
            PG8_LDB(B1, 1, 1); PG8_STAGE(PG8_SB(1, 0), b3, voffB[0][0], voffB[0][1]);
            PG8_BAR; PG8_WAIT_L(0); PG8_MMA(0, 1, At, B1); PG8_BAR;
            PG8_LDA(At, 1, 1); PG8_STAGE(PG8_SA(1, 0), a3, o00, o01);
            PG8_BAR; PG8_WAIT_L(0); PG8_MMA(1, 0, At, B0); PG8_BAR; PG8_SCHED;
            PG8_STAGE(PG8_SB(1, 1), b3, voffB[1][0], voffB[1][1]);
            PG8_WAIT_V(6); PG8_BAR; PG8_MMA(1, 1, At, B1); PG8_BAR;
        }
        E(acc, cur, wr, wc, fr, fq);
        if (!has_next) break;
#pragma unroll
        for (int a = 0; a < 2; ++a)
#pragma unroll
            for (int b = 0; b < 2; ++b)
#pragma unroll
                for (int m = 0; m < 4; ++m)
#pragma unroll
                    for (int n = 0; n < 2; ++n) acc[a][b][m][n] = (f32x4){0.f, 0.f, 0.f, 0.f};
        cur = nxt; cA = nA; cB = nB; ++ui;
        if (GATHER) { vA[0][0] = vN[0][0]; vA[0][1] = vN[0][1]; vA[1][0] = vN[1][0]; vA[1][1] = vN[1][1]; }
    }
    PG8_WAIT_V(0);
    if (wr == 0) PG8_BAR;
    PG8_BAR;
#undef PG8_SETA
#undef PG8_SA
#undef PG8_SB
#undef PG8_STAGE
#undef PG8_LDA
#undef PG8_LDB
#undef PG8_MMA
#undef PG8_WAIT_V
#undef PG8_WAIT_L
#undef PG8_BAR
#undef PG8_SCHED
}
}
using pg8::Unit;
typedef f32x4 acc_t[2][2][4][2];

#define EPI_ROWS(ai, m, rowl) _Pragma("unroll") for (int ai = 0; ai < 2; ++ai) _Pragma("unroll") for (int m = 0; m < 4; ++m) { const int rowl = ai * 128 + wr * 64 + m * 16 + fr;
#define EPI_END }

struct TItem { const float* src; bf16_t* dst; int ldw, ldt; };
__device__ __forceinline__ TItem tr_make(const float* W, int ldw, int k0, int n0, bf16_t* WT, size_t drow0, int ldt) { TItem t; t.src = W + (size_t)k0 * ldw + n0; t.dst = WT + drow0 * (size_t)ldt + k0; t.ldw = ldw; t.ldt = ldt; return t; }
__device__ __forceinline__ TItem tr_decode(const Params& p, int r) {
    constexpr int I_IN = 16 * 56, I_GLU = 64, I_B5 = 128, I_BS = 128, I_OUT = 256, I_R = 64;
    if (r < I_IN) return tr_make(p.in[10], DIN, (r / 56) * 64, (r % 56) * 64, (bf16_t*)(p.ws + WS_WIN_T), (size_t)(r % 56) * 64, 1024); r -= I_IN;
    if (r < I_GLU) return tr_make(p.in[19], 512, (r / 8) * 64, (r % 8) * 64, (bf16_t*)(p.ws + WS_WGLU_T), (size_t)(r % 8) * 64, 512); r -= I_GLU;
    if (r < I_B5) return tr_make(p.in[24], 1024, (r / 16) * 64, (r % 16) * 64, (bf16_t*)(p.ws + WS_WB5_T), (size_t)(r % 16) * 64, 512); r -= I_B5;
    if (r < I_BS) return tr_make(p.in[25], 1024, (r / 16) * 64, (r % 16) * 64, (bf16_t*)(p.ws + WS_WBS_T), (size_t)(r % 16) * 64, 512); r -= I_BS;
    if (r < I_OUT) return tr_make(p.in[26], 1024, (r / 16) * 64, (r % 16) * 64, (bf16_t*)(p.ws + WS_WOUT_T), (size_t)(r % 16) * 64, 1024); r -= I_OUT;
    if (r < I_R) return tr_make(p.in[27], 256, (r / 4) * 64, (r % 4) * 64, (bf16_t*)(p.ws + WS_WR_T), (size_t)(r % 4) * 64, 1024); r -= I_R;
    const int e = r / 192, q = r % 192;
    if (q < 128) {
        const int up = q >> 6, qq = q & 63, k0 = (qq / 4) * 64, n0 = (qq % 4) * 64;
        const float* W = (e < 256) ? p.in[up ? 30 : 29] + (size_t)e * 262144 : p.in[up ? 33 : 32];
        return tr_make(W, 256, k0, n0, (bf16_t*)(p.ws + WS_WGU_T), (size_t)e * 512 + (size_t)(n0 >> 7) * 256 + up * 128 + (n0 & 127), 1024);
    }
    const int qq = q - 128, k0 = (qq / 16) * 64, n0 = (qq % 16) * 64;
    const float* W = (e < 256) ? p.in[31] + (size_t)e * 262144 : p.in[34];
    return tr_make(W, 1024, k0, n0, (bf16_t*)(p.ws + WS_WD_T), (size_t)e * 1024 + n0, 256);
}
#define TR_LOAD(v, t) do { __builtin_amdgcn_sched_barrier(0); _Pragma("unroll") for (int it_ = 0; it_ < 16; ++it_) (v)[it_] = __builtin_nontemporal_load((const f32x4*)((t).src + (size_t)(it_ * 4 + (lane >> 4)) * (t).ldw + (lane & 15) * 4)); __builtin_amdgcn_sched_barrier(0); } while (0)
#define TR_STORE(v, t) do { \
    _Pragma("unroll") for (int it_ = 0; it_ < 16; ++it_) { LAS float* s_ = scr + (it_ * 4 + (lane >> 4)) * 65 + (lane & 15) * 4; s_[0] = (v)[it_].x; s_[1] = (v)[it_].y; s_[2] = (v)[it_].z; s_[3] = (v)[it_].w; } \
    LDS_WAIT(); \
    _Pragma("unroll") for (int it_ = 0; it_ < 8; ++it_) { const int n_ = it_ * 8 + (lane >> 3), c_ = lane & 7; const LAS float* s_ = scr + (8 * c_) * 65 + n_; \
        u32x4 o_; o_.x = pk2(s_[0], s_[65]); o_.y = pk2(s_[130], s_[195]); o_.z = pk2(s_[260], s_[325]); o_.w = pk2(s_[390], s_[455]); \
        __builtin_nontemporal_store(o_, (u32x4*)((t).dst + (size_t)n_ * (t).ldt + 8 * c_)); } \
    LDS_WAIT(); } while (0)

__device__ __forceinline__ void s5_tables(const Params& p, int g, int sub, ldsp_t lds) {
    LAS f32x2* apow = (LAS f32x2*)lds;
    LAS f32x2* bbar = (LAS f32x2*)(lds + 17408);
    LAS f32x2* cm = (LAS f32x2*)(lds + 17408 + 16384);
    LAS float* Kt = (LAS float*)(lds + 17408 + 32768);
    const int tid = threadIdx.x;
    const float *a_re = p.in[11], *a_im = p.in[12], *log_dt = p.in[13], *b_re = p.in[14], *b_im = p.in[15], *c_re = p.in[16], *c_im = p.in[17], *dsk = p.in[18];
    float* APL = (float*)(p.ws + WS_APL);
    if (tid < 128) {
        const int d = tid >> 6, pp = tid & 63, idx = (d * 32 + g) * 64 + pp;
        const double are = (double)a_re[idx], aim = (double)a_im[idx];
        const double dt = dexp_((double)log_dt[d * 32 + g]);
        const double mag = dexp_(dt * are); double sn, cs; dsincos_(dt * aim, sn, cs);
        const double abr = mag * cs, abi = mag * sn;
        double pr = 1.0, pi = 0.0;
#pragma unroll 1
        for (int m = 0; m <= 16; ++m) { apow[(d * 17 + m) * 64 + pp] = (f32x2){(float)pr, (float)pi}; const double nr = pr * abr - pi * abi, ni = pr * abi + pi * abr; pr = nr; pi = ni; }
        if (sub == 0) { const f32x2 aL = apow[(d * 17 + 16) * 64 + pp]; APL[idx * 2 + 0] = aL.x; APL[idx * 2 + 1] = aL.y; }
        const double nr = abr - 1.0, ni = abi, den = are * are + aim * aim;
        const double qr = (nr * are + ni * aim) / den, qi = (ni * are - nr * aim) / den;
#pragma unroll 1
        for (int i = 0; i < 16; ++i) { const double br = (double)b_re[idx * 16 + i], bi = (double)b_im[idx * 16 + i];
            bbar[(d * 64 + pp) * 16 + i] = (f32x2){(float)(qr * br - qi * bi), (float)(qr * bi + qi * br)}; }
    }
    for (int e = tid; e < 2048; e += NT) { const int d = e >> 10, j = (e >> 6) & 15, pp = e & 63; const int gi = ((d * 32 + g) * 16 + j) * 64 + pp; cm[e] = (f32x2){c_re[gi], c_im[gi]}; }
    __syncthreads();
    for (int e1 = tid; e1 < 1024; e1 += NT) {
        const int d = e1 >> 9, m = (e1 >> 5) & 15, j = 2 * sub + ((e1 >> 4) & 1), i = e1 & 15, e = (d << 12) | (m << 8) | (j << 4) | i; float s = 0.f;
#pragma unroll 4
        for (int pp = 0; pp < 64; ++pp) { const f32x2 a = apow[(d * 17 + m) * 64 + pp], b = bbar[(d * 64 + pp) * 16 + i], c = cm[(d * 16 + j) * 64 + pp];
            const float tr = a.x * b.x - a.y * b.y, ti = a.x * b.y + a.y * b.x; s += c.x * tr - c.y * ti; }
        Kt[e] = s;
    }
    __syncthreads();
    unsigned* BC = (unsigned*)(p.ws + WS_BCAT_T) + (size_t)g * 256 * 256;
    for (int e3 = tid; e3 < 8192; e3 += NT) {
        const int rr = e3 >> 8, tau = rr >> 1, j = 2 * sub + (rr & 1), n = tau * 16 + j, e2 = n * 256 + (e3 & 255), kk0 = (e3 & 255) * 2; float v[2];
#pragma unroll
        for (int q = 0; q < 2; ++q) { const int kk = kk0 + q; float r;
            if (kk < 256) { const int k = kk >> 4, i = kk & 15; r = 0.f;
                if (tau >= k) r += Kt[((0 * 16 + (tau - k)) * 16 + j) * 16 + i];
                if (k >= tau) r += Kt[((1 * 16 + (k - tau)) * 16 + j) * 16 + i];
                if (k == tau && i == j) r += dsk[16 * g + j];
            } else { const int qq = kk - 256, part = qq >> 6, pp = qq & 63, d = part >> 1, m = (d == 0) ? (tau + 1) : (16 - tau);
                const f32x2 c = cm[(d * 16 + j) * 64 + pp], a = apow[(d * 17 + m) * 64 + pp];
                r = (part & 1) ? -(c.x * a.y + c.y * a.x) : (c.x * a.x - c.y * a.y); }
            v[q] = r; }
        BC[e2] = pk2(v[0], v[1]);
    }
    unsigned* WE = (unsigned*)(p.ws + WS_WEND_T) + (size_t)g * 256 * 128;
    for (int e3 = tid; e3 < 4096; e3 += NT) {
        const int n = 32 * sub + (e3 >> 7), e2 = n * 128 + (e3 & 127), kk0 = (e3 & 127) * 2, d = n >> 7, ri = (n >> 6) & 1, pp = n & 63; float v[2];
#pragma unroll
        for (int q = 0; q < 2; ++q) { const int kk = kk0 + q, k = kk >> 4, i = kk & 15, m = (d == 0) ? (15 - k) : k;
            const f32x2 a = apow[(d * 17 + m) * 64 + pp], b = bbar[(d * 64 + pp) * 16 + i];
            v[q] = ri ? (a.x * b.y + a.y * b.x) : (a.x * b.x - a.y * b.y); }
        WE[e2] = pk2(v[0], v[1]);
    }
    __syncthreads();
}

__device__ __forceinline__ void phase_prep(const Params& p, ldsp_t lds) {
    const int tid = threadIdx.x, lane = tid & 63, wave = tid >> 6, G = gridDim.x, bx = blockIdx.x;
    for (int q = bx; q < 256; q += G) s5_tables(p, q >> 3, q & 7, lds);
    { const float* sw = p.in[22]; unsigned* dst = (unsigned*)(p.ws + WS_SGUW);
      for (size_t e = (size_t)bx * NT + tid; e < 65536; e += (size_t)G * NT) dst[e] = pk2(sw[2 * e], sw[2 * e + 1]);
      u32x4* uc = (u32x4*)(p.ws + WS_UCAT);
      for (size_t e = (size_t)bx * NT + tid; e < (size_t)32 * 12288; e += (size_t)G * NT) { const size_t g = e / 12288, r = e % 12288; uc[(g * UC_ROWS + 2112) * 64 + r] = (u32x4){0u, 0u, 0u, 0u}; } }
    const int gw = bx * 8 + __builtin_amdgcn_readfirstlane(wave), NGW = G * 8;
    for (int r = gw; r < 1536; r += NGW) {
        const int cb = r % 96, ks = r / 96, n = cb * 64 + lane; const float* wm = p.in[4];
        float a0 = 0.f, a1 = 0.f, a2 = 0.f, a3 = 0.f, a4 = 0.f;
#pragma unroll 8
        for (int kk = 0; kk < 64; ++kk) { const int k = ks * 64 + kk; const float w = __builtin_nontemporal_load(wm + (size_t)k * 6144 + n);
            a0 += silu_f(p.in[1][k]) * w; a1 += silu_f(p.in[1][1024 + k]) * w; a2 += silu_f(p.in[1][2048 + k]) * w; a3 += silu_f(p.in[1][3072 + k]) * w; a4 += silu_f(p.in[3][k]) * w; }
        float* mp = (float*)(p.ws + WS_MODP) + (size_t)ks * 5 * 6144 + n;
        mp[0] = a0; mp[6144] = a1; mp[2 * 6144] = a2; mp[3 * 6144] = a3; mp[4 * 6144] = a4;
    }
    LAS float* scr = (LAS float*)(lds + wave * 16640);
    constexpr int N_TR = 16 * 56 + 64 + 128 + 128 + 256 + 64 + 257 * 192;
    int it = __builtin_amdgcn_readfirstlane(gw);
    if (it < N_TR) {
        f32x4 va[16], vb[16];
        TItem ta = tr_decode(p, it), tb; TR_LOAD(va, ta);
        for (;;) {
            bool more = (it + NGW) < N_TR;
            tb = tr_decode(p, more ? it + NGW : it); TR_LOAD(vb, tb);
            TR_STORE(va, ta);
            if (!more) break;
            it += NGW; more = (it + NGW) < N_TR;
            ta = tr_decode(p, more ? it + NGW : it); TR_LOAD(va, ta);
            TR_STORE(vb, tb);
            if (!more) break;
            it += NGW;
        }
    }
}

__device__ __forceinline__ void phase_xn(const Params& p, ldsp_t lds) {
    const int tid = threadIdx.x, lane = tid & 63, wave = tid >> 6, G = gridDim.x, bx = blockIdx.x;
    const float* modp = (const float*)(p.ws + WS_MODP); const float* bmod = p.in[5];
    { float* mod = (float*)(p.ws + WS_MOD);
      for (int e = bx * NT + tid; e < 5 * 6144; e += G * NT) { const int n = e % 6144; float s = bmod[n];
#pragma unroll
          for (int ks = 0; ks < 16; ++ks) s += modp[(size_t)ks * 5 * 6144 + e];
          mod[e] = s; } }
    LAS float* shv = (LAS float*)lds; LAS float* gsc = (LAS float*)(lds + 4096);
    const float* gpre = p.in[6];
    for (int tile = bx; tile < NTOK / 128; tile += G) {
        const int mr = tile >> 6;
        __syncthreads();
        for (int col = tid; col < 1024; col += NT) { float sh = bmod[col], sc = bmod[1024 + col];
#pragma unroll
            for (int ks = 0; ks < 16; ++ks) { sh += modp[((size_t)ks * 5 + mr) * 6144 + col]; sc += modp[((size_t)ks * 5 + mr) * 6144 + 1024 + col]; }
            shv[col] = sh; gsc[col] = gpre[col] * (1.0f + sc); }
        __syncthreads();
        for (int r0 = wave; r0 < 128; r0 += 32) {
            f32x4 v[4][4]; float ss[4];
#pragma unroll
            for (int q = 0; q < 4; ++q) { const int row = tile * 128 + r0 + 8 * q;
                const float* src = (row < NTOK) ? p.in[0] + (size_t)row * DM : p.in[2] + (size_t)(row - NTOK) * DM;
#pragma unroll
                for (int j = 0; j < 4; ++j) v[q][j] = __builtin_nontemporal_load((const f32x4*)(src + 4 * lane + 256 * j)); }
#pragma unroll
            for (int q = 0; q < 4; ++q) { float s2 = 0.f;
#pragma unroll
                for (int j = 0; j < 4; ++j) s2 += (v[q][j].x * v[q][j].x + v[q][j].y * v[q][j].y) + (v[q][j].z * v[q][j].z + v[q][j].w * v[q][j].w);
                ss[q] = s2; }
#pragma unroll
            for (int o = 1; o < 64; o <<= 1) {
#pragma unroll
                for (int q = 0; q < 4; ++q) ss[q] += __shfl_xor(ss[q], o); }
#pragma unroll
            for (int q = 0; q < 4; ++q) { const int row = tile * 128 + r0 + 8 * q; const float rstd = rsqrtf(ss[q] * (1.0f / DM) + EPS);
                bf16_t* dst = (bf16_t*)(p.ws + WS_XN) + (size_t)row * DM;
#pragma unroll
                for (int j = 0; j < 4; ++j) { const int c = 4 * lane + 256 * j; const f32x4 gs = *(const LAS f32x4*)(gsc + c), sh = *(const LAS f32x4*)(shv + c);
                    u32x2 o; o.x = pk2(v[q][j].x * rstd * gs.x + sh.x, v[q][j].y * rstd * gs.y + sh.y); o.y = pk2(v[q][j].z * rstd * gs.z + sh.z, v[q][j].w * rstd * gs.w + sh.w);
                    *(u32x2*)(dst + c) = o; } }
        }
    }
    __syncthreads();
    {
        constexpr int APITCH = 2064;
        ldsp_t Al = lds + 8192;
        for (int col = tid; col < 1024; col += NT) { float sh = bmod[col], sc = bmod[1024 + col];
#pragma unroll
            for (int ks = 0; ks < 16; ++ks) { sh += modp[((size_t)ks * 5 + 4) * 6144 + col]; sc += modp[((size_t)ks * 5 + 4) * 6144 + 1024 + col]; }
            shv[col] = sh; gsc[col] = gpre[col] * (1.0f + sc); }
        __syncthreads();
        const int fr = lane & 15, fq = lane >> 4;
        for (int it = bx; it < 256; it += G) {
            const int r0 = (it >> 2) * 16, cq = it & 3;
#pragma unroll
            for (int q = 0; q < 2; ++q) { const int rl = wave * 2 + q;
                const float* src = p.in[2] + (size_t)(r0 + rl) * DM;
                f32x4 v[4]; float s2 = 0.f;
#pragma unroll
                for (int j = 0; j < 4; ++j) { v[j] = *(const f32x4*)(src + 4 * lane + 256 * j); s2 += (v[j].x * v[j].x + v[j].y * v[j].y) + (v[j].z * v[j].z + v[j].w * v[j].w); }
                const float rstd = rsqrtf(wave_sum(s2) * (1.0f / DM) + EPS);
#pragma unroll
                for (int j = 0; j < 4; ++j) { const int c = 4 * lane + 256 * j; const f32x4 gs = *(const LAS f32x4*)(gsc + c), sh = *(const LAS f32x4*)(shv + c);
                    u32x2 o; o.x = pk2(v[j].x * rstd * gs.x + sh.x, v[j].y * rstd * gs.y + sh.y); o.y = pk2(v[j].z * rstd * gs.z + sh.z, v[j].w * rstd * gs.w + sh.w);
                    *(LAS u32x2*)(Al + rl * APITCH + c * 2) = o; }
            }
            __syncthreads();
            f32x4 acc = (f32x4){0.f, 0.f, 0.f, 0.f};
            const bf16_t* wt = (const bf16_t*)(p.ws + WS_WIN_T) + (size_t)(128 * cq + 16 * wave + fr) * 1024 + 8 * fq;
#pragma unroll 1
            for (int kb = 0; kb < 32; kb += 16) {
                bf16x8 bfr[16];
#pragma unroll
                for (int k8 = 0; k8 < 16; ++k8) bfr[k8] = *(const bf16x8*)(wt + (kb + k8) * 32);
#pragma unroll
                for (int k8 = 0; k8 < 16; ++k8) { const bf16x8 af = *(const LAS bf16x8*)(Al + fr * APITCH + ((kb + k8) * 32 + 8 * fq) * 2);
                    acc = __builtin_amdgcn_mfma_f32_16x16x32_bf16(af, bfr[k8], acc, 0, 0, 0); }
            }
            { const int g = 8 * cq + wave;
#pragma unroll
              for (int r = 0; r < 4; ++r) { const int rc = r0 + 4 * fq + r, crow = 2048 + (rc >> 8) * 16 + ((rc & 255) >> 4), k = rc & 15;
                  ((bf16_t*)(p.ws + WS_UCAT))[(size_t)(g * UC_ROWS + crow) * 512 + k * 16 + fr] = (bf16_t)f2bf(acc[r]); } }
            __syncthreads();
        }
    }
}

struct SchedG1 { const unsigned char* ws; int G, c, mult;
    __device__ __forceinline__ bool next(int i, Unit& u) const { int L = i * G + c; if (L >= 1792 * mult) return false; if (mult > 1) L %= 1792;
        u.pm = L / 14; u.pn = L % 14;
        u.A = (const char*)ws + WS_XN + (size_t)u.pm * 256 * 2048; u.B = (const char*)ws + WS_WIN_T + (size_t)u.pn * 256 * 2048; u.arow = nullptr; u.x0 = 0; u.x1 = 0; return true; } };
struct EpiG1 { static constexpr bool PERM = true; unsigned char* ws;
    __device__ __forceinline__ void operator()(const acc_t& acc, const Unit& u, int wr, int wc, int fr, int fq) const {
        const int pn = u.pn;
        EPI_ROWS(ai, m, rowl)
            const int row = u.pm * 256 + rowl; float ssq = 0.f;
#pragma unroll
            for (int bj = 0; bj < 2; ++bj) {
                const int col = pn * 256 + bj * 128 + wc * 32 + 8 * fq; const f32x4 v0 = acc[ai][bj][m][0], v1 = acc[ai][bj][m][1]; u32x4 o;
                if (pn < 2) {
                    const int g = col >> 4, i0 = col & 15; int crow, k;
                    if (row < NTOK) { crow = row >> 4; k = row & 15; } else { const int rc = row - NTOK; crow = 2048 + (rc >> 8) * 16 + ((rc & 255) >> 4); k = rc & 15; }
                    o.x = pk2(v0.x, v0.y); o.y = pk2(v0.z, v0.w); o.z = pk2(v1.x, v1.y); o.w = pk2(v1.z, v1.w);
                    *(u32x4*)((bf16_t*)(ws + WS_UCAT) + ((size_t)(g * UC_ROWS + crow) * 512 + k * 16 + i0)) = o;
                } else if (pn < 6) {
                    const float g0 = gelu_f(v0.x), g1 = gelu_f(v0.y), g2 = gelu_f(v0.z), g3 = gelu_f(v0.w), g4 = gelu_f(v1.x), g5 = gelu_f(v1.y), g6 = gelu_f(v1.z), g7 = gelu_f(v1.w);
                    o.x = pk2(g0, g1); o.y = pk2(g2, g3); o.z = pk2(g4, g5); o.w = pk2(g6, g7);
                    if (pn < 4) *(u32x4*)((bf16_t*)(ws + WS_GU) + (size_t)row * 512 + (col - 512)) = o;
                    else { *(u32x4*)((bf16_t*)(ws + WS_GV) + (size_t)row * 512 + (col - 1024)) = o; ssq += (g0 * g0 + g1 * g1) + (g2 * g2 + g3 * g3) + (g4 * g4 + g5 * g5) + (g6 * g6 + g7 * g7); }
                } else {
                    o.x = pk2(sigmoid_f(v0.x), sigmoid_f(v0.y)); o.y = pk2(sigmoid_f(v0.z), sigmoid_f(v0.w)); o.z = pk2(sigmoid_f(v1.x), sigmoid_f(v1.y)); o.w = pk2(sigmoid_f(v1.z), sigmoid_f(v1.w));
                    if (pn < 10) *(u32x4*)((bf16_t*)(ws + WS_SG5) + (size_t)row * 1024 + (col - 1536)) = o;
                    else *(u32x4*)((bf16_t*)(ws + WS_SGS) + (size_t)row * 1024 + (col - 2560)) = o;
                }
            }
            if (pn == 4 || pn == 5) { ssq += __shfl_xor(ssq, 16); ssq += __shfl_xor(ssq, 32); if (fq == 0) ((float*)(ws + WS_SSQV))[(size_t)row * 8 + (pn - 4) * 4 + wc] = ssq; }
        EPI_END
    } };
struct SchedG2 { const unsigned char* ws; int G, c, mult;
    __device__ __forceinline__ bool next(int i, Unit& u) const { int L = i * G + c; if (L >= 256 * mult) return false; if (mult > 1) L %= 256; const int g = L >> 3; u.pm = L & 7; u.pn = 0; u.x0 = g; u.x1 = 0; u.arow = nullptr;
        u.A = (const char*)ws + WS_UCAT + ((size_t)g * UC_ROWS + (size_t)u.pm * 256) * 1024; u.B = (const char*)ws + WS_WEND_T + (size_t)g * 256 * 512; return true; } };
struct EpiG2 { static constexpr bool PERM = false; unsigned char* ws;
    __device__ __forceinline__ void operator()(const acc_t& acc, const Unit& u, int wr, int wc, int fr, int fq) const {
        float* Eo = (float*)(ws + WS_E) + (size_t)u.x0 * UC_ROWS * 256;
        EPI_ROWS(ai, m, rowl)
            float* rp = Eo + (size_t)(u.pm * 256 + rowl) * 256 + wc * 32 + 4 * fq;
#pragma unroll
            for (int bj = 0; bj < 2; ++bj)
#pragma unroll
                for (int n = 0; n < 2; ++n) *(f32x4*)(rp + bj * 128 + n * 16) = acc[ai][bj][m][n];
        EPI_END
    } };
struct SchedG3 { const unsigned char* ws; int G, c, mult;
    __device__ __forceinline__ bool next(int i, Unit& u) const { int L = i * G + c; if (L >= 256 * mult) return false; if (mult > 1) L %= 256; const int g = L >> 3; u.pm = L & 7; u.pn = 0; u.x0 = g; u.x1 = 0; u.arow = nullptr;
        u.A = (const char*)ws + WS_UCAT + ((size_t)g * UC_ROWS + (size_t)u.pm * 256) * 1024; u.B = (const char*)ws + WS_BCAT_T + (size_t)g * 256 * 1024; return true; } };
struct EpiG3 { static constexpr bool PERM = true; unsigned char* ws;
    __device__ __forceinline__ void operator()(const acc_t& acc, const Unit& u, int wr, int wc, int fr, int fq) const {
        bf16_t* ys = (bf16_t*)(ws + WS_YS);
        EPI_ROWS(ai, m, rowl)
            const int crow = u.pm * 256 + rowl;
#pragma unroll
            for (int bj = 0; bj < 2; ++bj) { const int col = bj * 128 + wc * 32 + 8 * fq; const f32x4 v0 = acc[ai][bj][m][0], v1 = acc[ai][bj][m][1]; u32x4 o;
                o.x = pk2(gelu_f(v0.x), gelu_f(v0.y)); o.y = pk2(gelu_f(v0.z), gelu_f(v0.w)); o.z = pk2(gelu_f(v1.x), gelu_f(v1.y)); o.w = pk2(gelu_f(v1.z), gelu_f(v1.w));
                *(u32x4*)(ys + ((size_t)crow * 16 + (col >> 4)) * 512 + u.x0 * 16 + (col & 15)) = o; }
        EPI_END
    } };
struct SchedG4 { const unsigned char* ws; int G, c, mult;
    __device__ __forceinline__ bool next(int i, Unit& u) const { int L = i * G + c; if (L >= 256 * mult) return false; if (mult > 1) L %= 256; u.pm = L >> 1; u.pn = L & 1; u.x0 = 0; u.x1 = 0; u.arow = nullptr;
        u.A = (const char*)ws + WS_YS + (size_t)u.pm * 256 * 1024; u.B = (const char*)ws + WS_WGLU_T + (size_t)u.pn * 256 * 1024; return true; } };
struct EpiG4 { static constexpr bool PERM = true; unsigned char* ws; const float* bglu;
    __device__ __forceinline__ void operator()(const acc_t& acc, const Unit& u, int wr, int wc, int fr, int fq) const {
        const int colb = u.pn * 256 + wc * 32 + 8 * fq;
        const f32x4 b00 = *(const f32x4*)(bglu + colb), b01 = *(const f32x4*)(bglu + colb + 4), b10 = *(const f32x4*)(bglu + colb + 128), b11 = *(const f32x4*)(bglu + colb + 132);
#pragma unroll
        for (int ai = 0; ai < 2; ++ai) {
            u32x4 y[4][2];
#pragma unroll
            for (int m = 0; m < 4; ++m)
#pragma unroll
                for (int bj = 0; bj < 2; ++bj) y[m][bj] = *(const u32x4*)((const bf16_t*)(ws + WS_YS) + ((size_t)u.pm * 256 + ai * 128 + wr * 64 + m * 16 + fr) * 512 + colb + bj * 128);
#pragma unroll
            for (int m = 0; m < 4; ++m)
#pragma unroll
                for (int bj = 0; bj < 2; ++bj) { const f32x4 v0 = acc[ai][bj][m][0], v1 = acc[ai][bj][m][1]; const f32x4 b0 = bj ? b10 : b00, b1 = bj ? b11 : b01; const u32x4 yy = y[m][bj]; u32x4 o;
                    o.x = pk2(bflo(yy.x) * sigmoid_f(v0.x + b0.x), bfhi(yy.x) * sigmoid_f(v0.y + b0.y)); o.y = pk2(bflo(yy.y) * sigmoid_f(v0.z + b0.z), bfhi(yy.y) * sigmoid_f(v0.w + b0.w));
                    o.z = pk2(bflo(yy.z) * sigmoid_f(v1.x + b1.x), bfhi(yy.z) * sigmoid_f(v1.y + b1.y)); o.w = pk2(bflo(yy.w) * sigmoid_f(v1.z + b1.z), bfhi(yy.w) * sigmoid_f(v1.w + b1.w));
                    *(u32x4*)((bf16_t*)(ws + WS_YS5) + ((size_t)u.pm * 256 + ai * 128 + wr * 64 + m * 16 + fr) * 512 + colb + bj * 128) = o; }
        }
    } };
struct SchedG5 { const unsigned char* ws; int G, c, mult;
    __device__ __forceinline__ bool next(int i, Unit& u) const { int tile = (i >> 1) * G + c; if (tile >= 512 * mult) return false; if (mult > 1) tile %= 512; const int which = i & 1; u.pm = tile >> 2; u.pn = tile & 3; u.x0 = which; u.x1 = 0; u.arow = nullptr;
        u.A = (const char*)ws + (which ? WS_YSGU : WS_YS5) + (size_t)u.pm * 256 * 1024; u.B = (const char*)ws + (which ? WS_WBS_T : WS_WB5_T) + (size_t)u.pn * 256 * 1024; return true; } };
struct EpiG5 { static constexpr bool PERM = true; unsigned char* ws;
    __device__ __forceinline__ void operator()(const acc_t& acc, const Unit& u, int wr, int wc, int fr, int fq) const {
        const bf16_t* gate = (const bf16_t*)(ws + (u.x0 ? WS_SGS : WS_SG5)); bf16_t* mg = (bf16_t*)(ws + WS_MERGED);
        const int colb = u.pn * 256 + wc * 32 + 8 * fq;
#pragma unroll
        for (int ai = 0; ai < 2; ++ai) {
            u32x4 sg[4][2], q[4][2];
#pragma unroll
            for (int m = 0; m < 4; ++m)
#pragma unroll
                for (int bj = 0; bj < 2; ++bj) { const size_t off = ((size_t)u.pm * 256 + ai * 128 + wr * 64 + m * 16 + fr) * 1024 + colb + bj * 128;
                    sg[m][bj] = *(const u32x4*)(gate + off); q[m][bj] = u.x0 ? *(const u32x4*)(mg + off) : (u32x4){0u, 0u, 0u, 0u}; }
#pragma unroll
            for (int m = 0; m < 4; ++m)
#pragma unroll
                for (int bj = 0; bj < 2; ++bj) { const size_t off = ((size_t)u.pm * 256 + ai * 128 + wr * 64 + m * 16 + fr) * 1024 + colb + bj * 128;
                    const f32x4 v0 = acc[ai][bj][m][0], v1 = acc[ai][bj][m][1]; const u32x4 g = sg[m][bj], qq = q[m][bj]; u32x4 o;
                    o.x = pk2(v0.x * bflo(g.x) + bflo(qq.x), v0.y * bfhi(g.x) + bfhi(qq.x)); o.y = pk2(v0.z * bflo(g.y) + bflo(qq.y), v0.w * bfhi(g.y) + bfhi(qq.y));
                    o.z = pk2(v1.x * bflo(g.z) + bflo(qq.z), v1.y * bfhi(g.z) + bfhi(qq.z)); o.w = pk2(v1.z * bflo(g.w) + bflo(qq.w), v1.w * bfhi(g.w) + bfhi(qq.w));
                    *(u32x4*)(mg + off) = o; }
        }
    } };
struct SchedG6 { const unsigned char* ws; int G, c, mult;
    __device__ __forceinline__ bool next(int i, Unit& u) const { int L = i * G + c; if (L >= 512 * mult) return false; if (mult > 1) L %= 512; u.pm = L >> 2; u.pn = L & 3; u.x0 = 0; u.x1 = 0; u.arow = nullptr;
        u.A = (const char*)ws + WS_MERGED + (size_t)u.pm * 256 * 2048; u.B = (const char*)ws + WS_WOUT_T + (size_t)u.pn * 256 * 2048; return true; } };
struct EpiG6 { static constexpr bool PERM = true; unsigned char* ws;
    __device__ __forceinline__ void operator()(const acc_t& acc, const Unit& u, int wr, int wc, int fr, int fq) const {
        EPI_ROWS(ai, m, rowl)
            const size_t row = (size_t)u.pm * 256 + rowl; float ssq = 0.f;
#pragma unroll
            for (int bj = 0; bj < 2; ++bj) { const int col = u.pn * 256 + bj * 128 + wc * 32 + 8 * fq; const f32x4 v0 = acc[ai][bj][m][0], v1 = acc[ai][bj][m][1]; u32x4 o;
                o.x = pk2(v0.x, v0.y); o.y = pk2(v0.z, v0.w); o.z = pk2(v1.x, v1.y); o.w = pk2(v1.z, v1.w);
                ssq += (v0.x * v0.x + v0.y * v0.y) + (v0.z * v0.z + v0.w * v0.w) + (v1.x * v1.x + v1.y * v1.y) + (v1.z * v1.z + v1.w * v1.w);
                *(u32x4*)((bf16_t*)(ws + WS_MX) + row * 1024 + col) = o; }
            ssq += __shfl_xor(ssq, 16); ssq += __shfl_xor(ssq, 32); if (fq == 0) ((float*)(ws + WS_SSQM))[row * 16 + u.pn * 4 + wc] = ssq;
        EPI_END
    } };
struct SchedG7 { const unsigned char* ws; int G, c, mult;
    __device__ __forceinline__ bool next(int i, Unit& u) const { int L = i * G + c; if (L >= 128 * mult) return false; if (mult > 1) L %= 128; u.pm = L; u.pn = 0; u.x0 = 0; u.x1 = 0; u.arow = nullptr;
        u.A = (const char*)ws + WS_XN + (size_t)u.pm * 256 * 2048; u.B = (const char*)ws + WS_WR_T; return true; } };
struct EpiG7 { static constexpr bool PERM = false; unsigned char* ws;
    __device__ __forceinline__ void operator()(const acc_t& acc, const Unit& u, int wr, int wc, int fr, int fq) const {
        EPI_ROWS(ai, m, rowl)
            float* rp = (float*)(ws + WS_LOGITS) + ((size_t)u.pm * 256 + rowl) * 256 + wc * 32 + 4 * fq;
#pragma unroll
            for (int bj = 0; bj < 2; ++bj)
#pragma unroll
                for (int n = 0; n < 2; ++n) *(f32x4*)(rp + bj * 128 + n * 16) = acc[ai][bj][m][n];
        EPI_END
    } };
struct SchedG8 { const unsigned char* ws; int G, c, mult;
    __device__ __forceinline__ bool next(int i, Unit& u) const { const int* te = (const int*)(ws + WS_TILEEXP); const int ntile = te[1500]; int L = i * G + c; if (L >= ntile * 2 * mult) return false; if (mult > 1) L %= ntile * 2;
        const int t = L >> 1; u.pm = t; u.pn = L & 1; const int e = te[t]; u.x0 = e; u.x1 = 0; u.arow = (const int*)(ws + WS_TOKSLOT) + (size_t)t * 256;
        u.A = (const char*)ws + WS_XN; u.B = (const char*)ws + WS_WGU_T + ((size_t)e * 512 + (size_t)u.pn * 256) * 2048; return true; } };
struct EpiG8 { static constexpr bool PERM = true; unsigned char* ws;
    __device__ __forceinline__ void operator()(const acc_t& acc, const Unit& u, int wr, int wc, int fr, int fq) const {
        EPI_ROWS(ai, m, rowl)
            const size_t slot = (size_t)u.pm * 256 + rowl; const int col = u.pn * 128 + wc * 32 + 8 * fq;
            const f32x4 g0 = acc[ai][0][m][0], g1 = acc[ai][0][m][1], u0 = acc[ai][1][m][0], u1 = acc[ai][1][m][1]; u32x4 o;
            o.x = pk2(silu_f(g0.x) * u0.x, silu_f(g0.y) * u0.y); o.y = pk2(silu_f(g0.z) * u0.z, silu_f(g0.w) * u0.w);
            o.z = pk2(silu_f(g1.x) * u1.x, silu_f(g1.y) * u1.y); o.w = pk2(silu_f(g1.z) * u1.z, silu_f(g1.w) * u1.w);
            *(u32x4*)((bf16_t*)(ws + WS_H) + slot * 256 + col) = o;
        EPI_END
    } };
struct SchedG9 { const unsigned char* ws; int G, c, mult;
    __device__ __forceinline__ bool next(int i, Unit& u) const { const int* te = (const int*)(ws + WS_TILEEXP); const int ntr = te[1500] - 128; int L = i * G + c; if (L >= ntr * 4 * mult) return false; if (mult > 1) L %= ntr * 4;
        const int t = L >> 2; u.pm = t; u.pn = L & 3; const int e = te[t]; u.x0 = e; u.x1 = 0; u.arow = nullptr;
        u.A = (const char*)ws + WS_H + (size_t)t * 256 * 512; u.B = (const char*)ws + WS_WD_T + ((size_t)e * 1024 + (size_t)u.pn * 256) * 512; return true; } };
__device__ __forceinline__ unsigned pk_fp8x4(f32x4 v) {
    const float a = __builtin_amdgcn_fmed3f(v.x * 8.f, -448.f, 448.f), b = __builtin_amdgcn_fmed3f(v.y * 8.f, -448.f, 448.f), c = __builtin_amdgcn_fmed3f(v.z * 8.f, -448.f, 448.f), d = __builtin_amdgcn_fmed3f(v.w * 8.f, -448.f, 448.f);
    int w = 0; w = __builtin_amdgcn_cvt_pk_fp8_f32(a, b, w, false); w = __builtin_amdgcn_cvt_pk_fp8_f32(c, d, w, true); return (unsigned)w; }
struct EpiG9 { static constexpr bool PERM = true; unsigned char* ws;
    __device__ __forceinline__ void operator()(const acc_t& acc, const Unit& u, int wr, int wc, int fr, int fq) const {
        EPI_ROWS(ai, m, rowl)
            const size_t slot = (size_t)u.pm * 256 + rowl;
            unsigned char* yp = ws + WS_YSLOT + slot * 1024 + u.pn * 256 + wc * 32 + 8 * fq;
#pragma unroll
            for (int bj = 0; bj < 2; ++bj) { u32x2 o; o.x = pk_fp8x4(acc[ai][bj][m][0]); o.y = pk_fp8x4(acc[ai][bj][m][1]); *(u32x2*)(yp + bj * 128) = o; }
        EPI_END
    } };
struct SchedG10 { const unsigned char* ws; int G, c, mult;
    __device__ __forceinline__ bool next(int i, Unit& u) const { const int* te = (const int*)(ws + WS_TILEEXP); const int ntr = te[1500] - 128; int L = i * G + c; if (L >= 512 * mult) return false; if (mult > 1) L %= 512;
        const int t = L >> 2; u.pm = t; u.pn = L & 3; u.x0 = ntr; u.x1 = 0; u.arow = nullptr;
        u.A = (const char*)ws + WS_H + (size_t)(ntr + t) * 256 * 512; u.B = (const char*)ws + WS_WD_T + ((size_t)NEXP * 1024 + (size_t)u.pn * 256) * 512; return true; } };
struct EpiG10 { static constexpr bool PERM = true; unsigned char* ws;
    __device__ __forceinline__ void operator()(const acc_t& acc, const Unit& u, int wr, int wc, int fr, int fq) const {
        EPI_ROWS(ai, m, rowl)
            bf16_t* dp = (bf16_t*)(ws + WS_MERGED) + ((size_t)u.pm * 256 + rowl) * 1024 + u.pn * 256 + wc * 32 + 8 * fq;
#pragma unroll
            for (int bj = 0; bj < 2; ++bj) { const f32x4 v0 = acc[ai][bj][m][0], v1 = acc[ai][bj][m][1]; u32x4 o;
                o.x = pk2(v0.x, v0.y); o.y = pk2(v0.z, v0.w); o.z = pk2(v1.x, v1.y); o.w = pk2(v1.z, v1.w); *(u32x4*)(dp + bj * 128) = o; }
        EPI_END
    } };

__device__ __forceinline__ void phase_sgu(const Params& p, ldsp_t lds) {
    const int tid = threadIdx.x, lane = tid & 63, wave = tid >> 6, fr = lane & 15, fq = lane >> 4, G = gridDim.x;
    constexpr int PITCH = 272;
    ldsp_t Wl = lds; ldsp_t VT = lds + 128 * PITCH; LAS float* rs = (LAS float*)(lds + 128 * PITCH + 64 * PITCH);
    const bf16_t* sguw = (const bf16_t*)(p.ws + WS_SGUW); const bf16_t* gv = (const bf16_t*)(p.ws + WS_GV); const bf16_t* gu = (const bf16_t*)(p.ws + WS_GU);
    const float* ssq = (const float*)(p.ws + WS_SSQV); const float* gn = p.in[21]; const float* bs = p.in[23];
    bf16_t* yo = (bf16_t*)(p.ws + WS_YSGU);
    for (int it = blockIdx.x; it < 2048; it += G) {
        const int chunk = it & 255, h = it >> 8; const size_t tok0 = (size_t)chunk * 128;
        __syncthreads();
        if (tid < 128) { const float* q = ssq + (tok0 + tid) * 8; const f32x4 a = *(const f32x4*)q, b = *(const f32x4*)(q + 4);
            rs[tid] = rsqrtf(((a.x + a.y) + (a.z + a.w) + (b.x + b.y) + (b.z + b.w)) * (1.0f / 512.0f) + EPS); }
#pragma unroll
        for (int i = 0; i < 4; ++i) { const int pc = tid + i * NT, row = pc >> 4, cp = pc & 15;
            *(LAS u32x4*)(Wl + row * PITCH + cp * 16) = *(const u32x4*)(sguw + ((size_t)h * 128 + row) * 128 + cp * 8); }
        __syncthreads();
#pragma unroll
        for (int i = 0; i < 2; ++i) { const int pc = tid + i * NT, s = pc >> 3, c8 = (pc & 7) * 8; const float r = rs[s];
            const u32x4 v = *(const u32x4*)(gv + (tok0 + s) * 512 + h * 64 + c8);
            LAS bf16_t* d = (LAS bf16_t*)(VT + c8 * PITCH + s * 2);
            d[0 * (PITCH / 2)] = (bf16_t)f2bf(bflo(v.x) * r); d[1 * (PITCH / 2)] = (bf16_t)f2bf(bfhi(v.x) * r); d[2 * (PITCH / 2)] = (bf16_t)f2bf(bflo(v.y) * r); d[3 * (PITCH / 2)] = (bf16_t)f2bf(bfhi(v.y) * r);
            d[4 * (PITCH / 2)] = (bf16_t)f2bf(bflo(v.z) * r); d[5 * (PITCH / 2)] = (bf16_t)f2bf(bfhi(v.z) * r); d[6 * (PITCH / 2)] = (bf16_t)f2bf(bflo(v.w) * r); d[7 * (PITCH / 2)] = (bf16_t)f2bf(bfhi(v.w) * r); }
        __syncthreads();
        f32x4 acc[4] = {(f32x4){0.f, 0.f, 0.f, 0.f}, (f32x4){0.f, 0.f, 0.f, 0.f}, (f32x4){0.f, 0.f, 0.f, 0.f}, (f32x4){0.f, 0.f, 0.f, 0.f}};
        const int t0 = wave * 16;
#pragma unroll
        for (int ks = 0; ks < 4; ++ks) {
            const bf16x8 bfr = *(const LAS bf16x8*)(Wl + (t0 + fr) * PITCH + (ks * 32 + 8 * fq) * 2);
#pragma unroll
            for (int mb = 0; mb < 4; ++mb) { const bf16x8 afr = *(const LAS bf16x8*)(VT + (mb * 16 + fr) * PITCH + (ks * 32 + 8 * fq) * 2);
                acc[mb] = __builtin_amdgcn_mfma_f32_16x16x32_bf16(afr, bfr, acc[mb], 0, 0, 0); }
        }
        const int t = t0 + fr; const float bt = bs[h * 128 + t];
#pragma unroll
        for (int mb = 0; mb < 4; ++mb) { const int c = h * 64 + mb * 16 + 4 * fq; const f32x4 gg = *(const f32x4*)(gn + c);
            const u32x2 uu = *(const u32x2*)(gu + (tok0 + t) * 512 + c); u32x2 o;
            o.x = pk2(bflo(uu.x) * (acc[mb].x * gg.x + bt), bfhi(uu.x) * (acc[mb].y * gg.y + bt)); o.y = pk2(bflo(uu.y) * (acc[mb].z * gg.z + bt), bfhi(uu.y) * (acc[mb].w * gg.w + bt));
            *(u32x2*)(yo + (tok0 + t) * 512 + c) = o; }
    }
    __syncthreads();
}

__device__ __forceinline__ size_t carry_row(int b, int d, int q) { return (q < 16) ? (size_t)(2048 + b * 16 + (d ? 15 - q : q)) : (size_t)(b * 512 + (d ? 511 - (q - 16) : (q - 16))); }
__device__ __forceinline__ void phase_carry(const Params& p, ldsp_t lds) {
    const int tid = threadIdx.x, lane = tid & 63, wave = tid >> 6, G = gridDim.x;
    const float* APL = (const float*)(p.ws + WS_APL);
    LAS f32x2* seg = (LAS f32x2*)lds;
    LAS float* ectx = (LAS float*)(lds + 4096);
    for (int s = blockIdx.x; s < 256; s += G) {
        const int d = s & 1, g = (s >> 1) & 31, b = s >> 6;
        const float ar = APL[((d * 32 + g) * 64 + lane) * 2], ai = APL[((d * 32 + g) * 64 + lane) * 2 + 1];
        const float* Eg = (const float*)(p.ws + WS_E) + (size_t)g * UC_ROWS * 256 + d * 128 + lane;
        bf16_t* Ug = (bf16_t*)(p.ws + WS_UCAT) + (size_t)g * UC_ROWS * 512 + 256 + d * 128 + lane;
        const int q0 = wave * 66;
        __syncthreads();
        { const int fr = lane & 15, fq = lane >> 4; f32x4 acc = (f32x4){0.f, 0.f, 0.f, 0.f};
          const bf16_t* ua = (const bf16_t*)(p.ws + WS_UCAT) + ((size_t)g * UC_ROWS + 2048 + b * 16 + fr) * 512 + 8 * fq;
          const bf16_t* wb = (const bf16_t*)(p.ws + WS_WEND_T) + ((size_t)g * 256 + d * 128 + 16 * wave + fr) * 256 + 8 * fq;
          bf16x8 af[8], bfv[8];
#pragma unroll
          for (int ks = 0; ks < 8; ++ks) { af[ks] = *(const bf16x8*)(ua + ks * 32); bfv[ks] = *(const bf16x8*)(wb + ks * 32); }
#pragma unroll
          for (int ks = 0; ks < 8; ++ks) acc = __builtin_amdgcn_mfma_f32_16x16x32_bf16(af[ks], bfv[ks], acc, 0, 0, 0);
#pragma unroll
          for (int r = 0; r < 4; ++r) ectx[(4 * fq + r) * 128 + 16 * wave + fr] = acc[r]; }
        __syncthreads();
        float cr = 0.f, ci = 0.f;
#pragma unroll 1
        for (int j0 = 0; j0 < 66; j0 += 11) {
            float er[11], ei[11];
#pragma unroll
            for (int j = 0; j < 11; ++j) { const int q = q0 + j0 + j; if (q < 16) { const int cc = d ? 15 - q : q; er[j] = ectx[cc * 128 + lane]; ei[j] = ectx[cc * 128 + 64 + lane]; } else { const size_t row = carry_row(b, d, q); er[j] = Eg[row * 256]; ei[j] = Eg[row * 256 + 64]; } }
#pragma unroll
            for (int j = 0; j < 11; ++j) { const float nr = ar * cr - ai * ci + er[j], ni = ar * ci + ai * cr + ei[j]; cr = nr; ci = ni; }
        }
        __syncthreads();
        seg[wave * 64 + lane] = (f32x2){cr, ci};
        __syncthreads();
        float p2r = ar * ar - ai * ai, p2i = 2.f * ar * ai, pr = p2r, pi = p2i;
#pragma unroll
        for (int k = 0; k < 5; ++k) { const float nr = pr * pr - pi * pi, ni = 2.f * pr * pi; pr = nr; pi = ni; }
        const float Ar = pr * p2r - pi * p2i, Ai = pr * p2i + pi * p2r;
        cr = 0.f; ci = 0.f;
        for (int w = 0; w < wave; ++w) { const f32x2 e = seg[w * 64 + lane]; const float nr = Ar * cr - Ai * ci + e.x, ni = Ar * ci + Ai * cr + e.y; cr = nr; ci = ni; }
#pragma unroll 1
        for (int j0 = 0; j0 < 66; j0 += 11) {
            float er[11], ei[11];
#pragma unroll
            for (int j = 0; j < 11; ++j) { const int q = q0 + j0 + j; if (q < 16) { const int cc = d ? 15 - q : q; er[j] = ectx[cc * 128 + lane]; ei[j] = ectx[cc * 128 + 64 + lane]; } else { const size_t row = carry_row(b, d, q); er[j] = Eg[row * 256]; ei[j] = Eg[row * 256 + 64]; } }
#pragma unroll
            for (int j = 0; j < 11; ++j) { const int q = q0 + j0 + j;
                if (q >= 16) { const size_t row = carry_row(b, d, q); Ug[row * 512] = (bf16_t)f2bf(cr); Ug[row * 512 + 64] = (bf16_t)f2bf(ci); }
                const float nr = ar * cr - ai * ci + er[j], ni = ar * ci + ai * cr + ei[j]; cr = nr; ci = ni; }
        }
    }
    __syncthreads();
}

__device__ __forceinline__ void phase_r1(const Params& p) {
    const int tid = threadIdx.x, lane = tid & 63, wave = tid >> 6, G = gridDim.x;
    const float* mod = (const float*)(p.ws + WS_MOD); const float* gpm = p.in[7]; const float* gpf = p.in[8];
    for (int row = blockIdx.x * 8 + wave; row < NTOK; row += G * 8) {
        const float* mb = mod + (size_t)(row >> 13) * 6144;
        f32x4 xv[4], gt[4], gg[4]; u32x2 mv[4];
#pragma unroll
        for (int j = 0; j < 4; ++j) { const int c = 4 * lane + 256 * j; xv[j] = __builtin_nontemporal_load((const f32x4*)(p.in[0] + (size_t)row * DM + c));
            mv[j] = *(const u32x2*)((const bf16_t*)(p.ws + WS_MX) + (size_t)row * DM + c); gt[j] = *(const f32x4*)(mb + 2048 + c); gg[j] = *(const f32x4*)(gpm + c); }
        const float* sq = (const float*)(p.ws + WS_SSQM) + (size_t)row * 16; float s0 = 0.f;
#pragma unroll
        for (int j = 0; j < 4; ++j) { const f32x4 qq = *(const f32x4*)(sq + 4 * j); s0 += (qq.x + qq.y) + (qq.z + qq.w); }
        const float rm = rsqrtf(s0 * (1.0f / DM) + EPS);
        float s = 0.f;
#pragma unroll
        for (int j = 0; j < 4; ++j) { f32x4 x1;
            x1.x = xv[j].x + gt[j].x * (bflo(mv[j].x) * rm * gg[j].x); x1.y = xv[j].y + gt[j].y * (bfhi(mv[j].x) * rm * gg[j].y);
            x1.z = xv[j].z + gt[j].z * (bflo(mv[j].y) * rm * gg[j].z); x1.w = xv[j].w + gt[j].w * (bfhi(mv[j].y) * rm * gg[j].w);
            xv[j] = x1; s += (x1.x * x1.x + x1.y * x1.y) + (x1.z * x1.z + x1.w * x1.w); }
#pragma unroll
        for (int j = 0; j < 4; ++j) { const int c = 4 * lane + 256 * j; gg[j] = *(const f32x4*)(gpf + c); gt[j] = *(const f32x4*)(mb + 3072 + c); }
        f32x4 sc[4];
#pragma unroll
        for (int j = 0; j < 4; ++j) sc[j] = *(const f32x4*)(mb + 4096 + 4 * lane + 256 * j);
        const float r1 = rsqrtf(wave_sum(s) * (1.0f / DM) + EPS);
        u32x2 ov[4];
#pragma unroll
        for (int j = 0; j < 4; ++j) { ov[j].x = pk2(xv[j].x * r1 * gg[j].x * (1.f + sc[j].x) + gt[j].x, xv[j].y * r1 * gg[j].y * (1.f + sc[j].y) + gt[j].y);
            ov[j].y = pk2(xv[j].z * r1 * gg[j].z * (1.f + sc[j].z) + gt[j].z, xv[j].w * r1 * gg[j].w * (1.f + sc[j].w) + gt[j].w); }
        bf16_t* dst = (bf16_t*)(p.ws + WS_XN) + (size_t)row * DM;
#pragma unroll
        for (int j = 0; j < 4; ++j) *(u32x2*)(dst + 4 * lane + 256 * j) = ov[j];
    }
}

__device__ __forceinline__ void phase_route(const Params& p, ldsp_t lds) {
    const int tid = threadIdx.x, lane = tid & 63, wave = tid >> 6, G = gridDim.x, g = lane & 7;
    LAS int* hist = (LAS int*)lds;
    float bs[32];
    { const float* rb = p.in[28] + g * 32;
#pragma unroll
      for (int i = 0; i < 8; ++i) { const f32x4 b4 = *(const f32x4*)(rb + 4 * i); bs[4 * i] = b4.x; bs[4 * i + 1] = b4.y; bs[4 * i + 2] = b4.z; bs[4 * i + 3] = b4.w; } }
    const float NINF = -__builtin_inff();
    for (int tile = blockIdx.x; tile < 256; tile += G) {
        __syncthreads();
        if (tid < 256) hist[tid] = 0;
        __syncthreads();
#pragma unroll 1
        for (int pass = 0; pass < 2; ++pass) {
            const int row = tile * 128 + wave * 16 + pass * 8 + (lane >> 3);
            const float* lp = (const float*)(p.ws + WS_LOGITS) + (size_t)row * 256 + g * 32;
            float sc[32], sel[32];
#pragma unroll
            for (int i = 0; i < 8; ++i) { const f32x4 l4 = *(const f32x4*)(lp + 4 * i);
                sc[4 * i] = sigmoid_f(l4.x); sc[4 * i + 1] = sigmoid_f(l4.y); sc[4 * i + 2] = sigmoid_f(l4.z); sc[4 * i + 3] = sigmoid_f(l4.w); }
            float m1 = NINF, m2 = NINF;
#pragma unroll
            for (int i = 0; i < 32; ++i) { sel[i] = sc[i] + bs[i]; m2 = fmaxf(m2, fminf(m1, sel[i])); m1 = fmaxf(m1, sel[i]); }
            const float gs = m1 + m2; int rank = 0;
#pragma unroll
            for (int m = 1; m < 8; ++m) { const float o = __shfl_xor(gs, m); const int og = g ^ m; rank += (o > gs || (o == gs && og < g)) ? 1 : 0; }
            const bool gsel = rank < 4;
            float wsum = 0.f, myW = 0.f; int myE = 0, rem = -1;
#pragma unroll
            for (int k = 0; k < 8; ++k) {
                float bv = NINF, bsc = 0.f; int bi = 0;
#pragma unroll
                for (int i = 0; i < 32; ++i) { if (k > 0) sel[i] = (i == rem) ? NINF : sel[i]; const bool gt = sel[i] > bv; bv = gt ? sel[i] : bv; bi = gt ? i : bi; bsc = gt ? sc[i] : bsc; }
                if (!gsel) bv = NINF;
                float v = bv; int e = g * 32 + bi;
#pragma unroll
                for (int m = 1; m < 8; m <<= 1) { const float ov = __shfl_xor(v, m); const int oe = __shfl_xor(e, m); const bool tk = (ov > v) || (ov == v && oe < e); v = tk ? ov : v; e = tk ? oe : e; }
                const float s_w = __shfl(bsc, (lane & ~7) | (e >> 5));
                rem = ((e >> 5) == g) ? (e & 31) : -1;
                wsum += s_w; if (g == k) { myW = s_w; myE = e; }
            }
            const float w = myW / wsum * 2.5f;
            ((int*)(p.ws + WS_IDX))[(size_t)row * 8 + g] = myE; ((float*)(p.ws + WS_WT))[(size_t)row * 8 + g] = w;
            __hip_atomic_fetch_add(&hist[myE], 1, __ATOMIC_RELAXED, __HIP_MEMORY_SCOPE_WORKGROUP);
        }
        __syncthreads();
        if (tid < 256) ((int*)(p.ws + WS_BLKCNT))[tile * 256 + tid] = hist[tid];
    }
    __syncthreads();
}
__device__ __forceinline__ void phase_scan(const Params& p, ldsp_t lds) {
    const int tid = threadIdx.x, G = gridDim.x; LAS int* sm = (LAS int*)lds;
    for (int e = blockIdx.x; e < 256; e += G) {
        __syncthreads();
        int v = 0; if (tid < 256) { v = ((const int*)(p.ws + WS_BLKCNT))[tid * 256 + e]; sm[tid] = v; }
        __syncthreads();
        for (int o = 1; o < 256; o <<= 1) { int t = 0; if (tid < 256 && tid >= o) t = sm[tid - o]; __syncthreads(); if (tid < 256) sm[tid] += t; __syncthreads(); }
        if (tid < 256) { ((int*)(p.ws + WS_BLKOFF))[tid * 256 + e] = sm[tid] - v; if (tid == 255) ((int*)(p.ws + WS_TOTAL))[e] = sm[255]; }
    }
    __syncthreads();
}
__device__ __forceinline__ void phase_scatter(const Params& p, ldsp_t lds) {
    const int tid = threadIdx.x, G = gridDim.x; LAS int* pst = (LAS int*)lds; LAS int* cnt = (LAS int*)(lds + 2048); LAS int* tot = (LAS int*)(lds + 4096);
    int* tokslot = (int*)(p.ws + WS_TOKSLOT); float* wslot = (float*)(p.ws + WS_WSLOT); int* te = (int*)(p.ws + WS_TILEEXP);
    int mytot = 0, mypad = 0;
    if (tid < 256) { mytot = ((const int*)(p.ws + WS_TOTAL))[tid]; mypad = (mytot + 255) & ~255; pst[tid] = mypad; tot[tid] = mytot; }
    __syncthreads();
    for (int o = 1; o < 256; o <<= 1) { int t = 0; if (tid < 256 && tid >= o) t = pst[tid - o]; __syncthreads(); if (tid < 256) pst[tid] += t; __syncthreads(); }
    const int pend_all = pst[255];
    __syncthreads();
    if (tid < 256) pst[tid] -= mypad;
    __syncthreads();
    const int ntr = pend_all >> 8;
    if (blockIdx.x == 0 && tid == 0) te[1500] = ntr + 128;
    for (int e = blockIdx.x; e < 256; e += G) { const int s0 = pst[e], n = tot[e], pe = s0 + ((n + 255) & ~255);
        for (int t = (s0 >> 8) + tid; t < (pe >> 8); t += NT) te[t] = e;
        for (int s = s0 + n + tid; s < pe; s += NT) { tokslot[s] = 0; wslot[s] = 0.f; } }
    for (int t = blockIdx.x * NT + tid; t < NTOK; t += G * NT) { tokslot[pend_all + t] = t; wslot[pend_all + t] = 1.0f; if (t < 128) te[ntr + t] = NEXP; }
    for (int tile = blockIdx.x; tile < 256; tile += G) {
        __syncthreads();
        if (tid < 256) cnt[tid] = 0;
        __syncthreads();
        for (int q = tid; q < 1024; q += NT) { const int row = tile * 128 + (q >> 3), k = q & 7; const int e = ((const int*)(p.ws + WS_IDX))[(size_t)row * 8 + k];
            const int r = __hip_atomic_fetch_add(&cnt[e], 1, __ATOMIC_RELAXED, __HIP_MEMORY_SCOPE_WORKGROUP); const int slot = pst[e] + ((const int*)(p.ws + WS_BLKOFF))[tile * 256 + e] + r;
            tokslot[slot] = row; wslot[slot] = ((const float*)(p.ws + WS_WT))[(size_t)row * 8 + k]; ((int*)(p.ws + WS_SLOT))[(size_t)row * 8 + k] = slot; }
    }
    __syncthreads();
}

__device__ __forceinline__ void phase_r3(const Params& p) {
    const int tid = threadIdx.x, lane = tid & 63, wave = __builtin_amdgcn_readfirstlane(tid >> 6), G = gridDim.x;
    const unsigned char* ys = p.ws + WS_YSLOT + 16 * lane; const float* mod = (const float*)(p.ws + WS_MOD); const float* gpm = p.in[7] + 16 * lane; const float* gpo = p.in[9] + 16 * lane;
    int row = blockIdx.x * 8 + wave;
    int slv[8]; float wtv[8];
    if (row < NTOK) {
#pragma unroll
        for (int k = 0; k < 8; ++k) { slv[k] = ((const int*)(p.ws + WS_SLOT))[(size_t)row * 8 + k]; wtv[k] = ((const float*)(p.ws + WS_WT))[(size_t)row * 8 + k]; } }
    for (; row < NTOK; row += G * 8) {
        const float* xrow = p.in[0] + (size_t)row * DM + 16 * lane; float* orow = p.out + (size_t)row * DM + 16 * lane; const bf16_t* mrow = (const bf16_t*)(p.ws + WS_MX) + (size_t)row * DM + 16 * lane;
        u32x4 yv[8]; f32x4 f[4], xa[4]; float wk[8];
#pragma unroll
        for (int k = 0; k < 8; ++k) { yv[k] = __builtin_nontemporal_load((const u32x4*)(ys + (size_t)slv[k] * 1024)); wk[k] = wtv[k] * 0.125f; }
#pragma unroll
        for (int j = 0; j < 4; ++j) xa[j] = *(const f32x4*)(xrow + 4 * j);
        { const bf16_t* frow = (const bf16_t*)(p.ws + WS_MERGED) + (size_t)row * DM + 16 * lane;
          const u32x4 h0 = *(const u32x4*)frow, h1 = *(const u32x4*)(frow + 8);
          f[0] = (f32x4){bflo(h0.x), bfhi(h0.x), bflo(h0.y), bfhi(h0.y)}; f[1] = (f32x4){bflo(h0.z), bfhi(h0.z), bflo(h0.w), bfhi(h0.w)};
          f[2] = (f32x4){bflo(h1.x), bfhi(h1.x), bflo(h1.y), bfhi(h1.y)}; f[3] = (f32x4){bflo(h1.z), bfhi(h1.z), bflo(h1.w), bfhi(h1.w)}; }
        const u32x4 m0 = *(const u32x4*)mrow, m1 = *(const u32x4*)(mrow + 8);
        const float* sq = (const float*)(p.ws + WS_SSQM) + (size_t)row * 16;
        const f32x4 q0 = *(const f32x4*)sq, q1 = *(const f32x4*)(sq + 4), q2 = *(const f32x4*)(sq + 8), q3 = *(const f32x4*)(sq + 12);
        { const int nrow = row + G * 8;
          if (nrow < NTOK) {
#pragma unroll
              for (int k = 0; k < 8; ++k) { slv[k] = ((const int*)(p.ws + WS_SLOT))[(size_t)nrow * 8 + k]; wtv[k] = ((const float*)(p.ws + WS_WT))[(size_t)nrow * 8 + k]; } } }
#pragma unroll
        for (int k = 0; k < 8; ++k) { const float w = wk[k];
#pragma unroll
            for (int j = 0; j < 4; ++j) { const int wd = (int)yv[k][j]; const f32x2 lo = __builtin_amdgcn_cvt_pk_f32_fp8(wd, false), hi = __builtin_amdgcn_cvt_pk_f32_fp8(wd, true);
                f[j].x += w * lo.x; f[j].y += w * lo.y; f[j].z += w * hi.x; f[j].w += w * hi.y; } }
        float s = 0.f;
#pragma unroll
        for (int j = 0; j < 4; ++j) s += (f[j].x * f[j].x + f[j].y * f[j].y) + (f[j].z * f[j].z + f[j].w * f[j].w);
        const float rf = rsqrtf(wave_sum(s) * (1.0f / DM) + EPS);
        const float rm = rsqrtf((((q0.x + q0.y) + (q0.z + q0.w)) + ((q1.x + q1.y) + (q1.z + q1.w)) + ((q2.x + q2.y) + (q2.z + q2.w)) + ((q3.x + q3.y) + (q3.z + q3.w))) * (1.0f / DM) + EPS);
        const float* mb = mod + (size_t)(row >> 13) * 6144 + 16 * lane;
        const unsigned mw[8] = {m0.x, m0.y, m0.z, m0.w, m1.x, m1.y, m1.z, m1.w};
        f32x4 gma[4], gfa[4], pma[4], poa[4], oa[4];
#pragma unroll
        for (int j = 0; j < 4; ++j) { gma[j] = *(const f32x4*)(mb + 2048 + 4 * j); gfa[j] = *(const f32x4*)(mb + 5120 + 4 * j); pma[j] = *(const f32x4*)(gpm + 4 * j); poa[j] = *(const f32x4*)(gpo + 4 * j); }
#pragma unroll
        for (int j = 0; j < 4; ++j) {
            oa[j].x = xa[j].x + gma[j].x * (bflo(mw[2 * j]) * rm * pma[j].x) + gfa[j].x * (f[j].x * rf * poa[j].x); oa[j].y = xa[j].y + gma[j].y * (bfhi(mw[2 * j]) * rm * pma[j].y) + gfa[j].y * (f[j].y * rf * poa[j].y);
            oa[j].z = xa[j].z + gma[j].z * (bflo(mw[2 * j + 1]) * rm * pma[j].z) + gfa[j].z * (f[j].z * rf * poa[j].z); oa[j].w = xa[j].w + gma[j].w * (bfhi(mw[2 * j + 1]) * rm * pma[j].w) + gfa[j].w * (f[j].w * rf * poa[j].w); }
#pragma unroll
        for (int j = 0; j < 4; ++j) *(f32x4*)(orow + 4 * j) = oa[j];
    }
}

#define XB_TMO      128
#define XB_XCNT(j)  (256  + 64 * (j))
#define XB_XSUB(j)  (1280 + 64 * (j))
#define XB_XGEN(j)  (2304 + 64 * (j))
#define XB_TOP      3328
#define XB_TOPGEN   3392
#define XCD_BAR_WORDS 3456
#define XB_SPIN_CAP (1u << 18)
__device__ __forceinline__ unsigned xb_ld(unsigned* p)              { return __hip_atomic_load(p, __ATOMIC_RELAXED, __HIP_MEMORY_SCOPE_AGENT); }
__device__ __forceinline__ unsigned xb_add(unsigned* p, unsigned v) { return __hip_atomic_fetch_add(p, v, __ATOMIC_RELAXED, __HIP_MEMORY_SCOPE_AGENT); }
__device__ __forceinline__ unsigned xb_xcc_id() { return (unsigned)__builtin_amdgcn_s_getreg((3 << 11) | 20) & 0xFu; }
#define XB_SPIN(cond, bar) do { unsigned _sp = 0; while (cond) { __builtin_amdgcn_s_sleep(1); \
    if ((++_sp & 255u) == 0u) { if (xb_ld(&(bar)[XB_TMO])) break; if (_sp > XB_SPIN_CAP) { atomicAdd(&(bar)[XB_TMO], 1u); break; } } } } while (0)
struct XcdBarrier { unsigned* bar; unsigned x; volatile LAS unsigned* st; };
__device__ __forceinline__ XcdBarrier xcd_barrier_post(unsigned* bar, volatile LAS unsigned* st) {
    XcdBarrier b; b.bar = bar; b.x = xb_xcc_id(); b.st = st;
    if (threadIdx.x == 0) (void)xb_add(&bar[XB_XCNT(b.x)], 1u);
    return b;
}
__device__ __forceinline__ void xcd_barrier_complete(unsigned* bar, unsigned x, unsigned& nloc, unsigned& nx) {
    const unsigned G = gridDim.x * gridDim.y * gridDim.z;
    unsigned sum, cnt, mine, sp = 0u;
    for (;;) {
        sum = 0u; cnt = 0u; mine = 0u;
#pragma unroll
        for (unsigned j = 0; j < 16; ++j) { const unsigned c = xb_ld(&bar[XB_XCNT(j)]); sum += c; cnt += (c > 0u) ? 1u : 0u; mine = (j == x) ? c : mine; }
        if (sum == G) break;
        __builtin_amdgcn_s_sleep(1);
        if ((++sp & 255u) == 0u) { if (xb_ld(&bar[XB_TMO])) break; if (sp > XB_SPIN_CAP) { atomicAdd(&bar[XB_TMO], 1u); break; } }
    }
    nloc = mine > 0u ? mine : 1u; nx = cnt > 0u ? cnt : 1u;
}
__device__ __forceinline__ void xcd_barrier(const XcdBarrier& b) {
    asm volatile("s_waitcnt vmcnt(0)" ::: "memory");
    __syncthreads();
    if (threadIdx.x == 0) {
        unsigned* bar = b.bar;
        __builtin_amdgcn_s_waitcnt(0);
        unsigned nloc = b.st[0], nx = b.st[1];
        if (nloc == 0u) { xcd_barrier_complete(bar, b.x, nloc, nx); b.st[0] = nloc; b.st[1] = nx; }
        const unsigned old = xb_add(&bar[XB_XSUB(b.x)], 1u);
        const unsigned gen = old / nloc;
        if (old + 1u == (gen + 1u) * nloc) {
            __builtin_amdgcn_fence(__ATOMIC_RELEASE, "agent");
            asm volatile("s_waitcnt vmcnt(0)" ::: "memory");
            const unsigned og = xb_add(&bar[XB_TOP], 1u);
            const unsigned tg = og / nx;
            if (og + 1u == (tg + 1u) * nx) xb_add(&bar[XB_TOPGEN], 1u);
            else XB_SPIN(xb_ld(&bar[XB_TOPGEN]) == tg, bar);
            __builtin_amdgcn_fence(__ATOMIC_ACQUIRE, "agent");
            xb_add(&bar[XB_XGEN(b.x)], 1u);
            asm volatile("s_waitcnt vmcnt(0)" ::: "memory");
        } else {
            XB_SPIN(xb_ld(&bar[XB_XGEN(b.x)]) == gen, bar);
            __builtin_amdgcn_fence(__ATOMIC_ACQUIRE, "agent");
            asm volatile("s_waitcnt vmcnt(0)" ::: "memory");
        }
    }
    __syncthreads();
}

constexpr int N_PHASES = 17;
__global__ void __launch_bounds__(NT, 2) fwd_kernel(Params p) {
    extern __shared__ __attribute__((aligned(16))) unsigned char lds_raw[];
    ldsp_t lds = (ldsp_t)lds_raw;
    const int G = gridDim.x, c = (G % 8 == 0) ? (int)(blockIdx.x % 8) * (G / 8) + (int)(blockIdx.x / 8) : (int)blockIdx.x;
    const int lo = p.ph_lo, hi = p.ph_hi;
    volatile LAS unsigned* bst = (volatile LAS unsigned*)(lds + LDS_BYTES - 16);
    if (threadIdx.x < 4) bst[threadIdx.x] = 0u;
    __syncthreads();
    XcdBarrier bar = xcd_barrier_post((unsigned*)p.ws, bst);
    unsigned long long spin_acc = 0;
#ifdef ONLY_PHASE
#define IN(k) ((k) == ONLY_PHASE && lo <= (k) && (k) < hi)
#else
#define IN(k) (lo <= (k) && (k) < hi)
#endif
#define TS_BEGIN(k) unsigned long long ts0_ = 0; if (SPIN_PHASE == (k)) ts0_ = __builtin_amdgcn_s_memrealtime();
#define TS_END(k) if (SPIN_PHASE == (k)) spin_acc += __builtin_amdgcn_s_memrealtime() - ts0_;
#define PH(k, ...) if (IN(k)) { TS_BEGIN(k) const int nrep_ = (DUP_PHASE == (k)) ? (1 + DUP_REPS + lo) : 1; _Pragma("nounroll") for (int r_ = 0; r_ < nrep_; ++r_) { if (r_) xcd_barrier(bar); __VA_ARGS__ } SEAM(k); TS_END(k) }
#define PG(k, ...) if (IN(k)) { TS_BEGIN(k) __VA_ARGS__ SEAM(k); TS_END(k) }
#define MULT(k) ((DUP_PHASE == (k)) ? (1 + DUP_REPS) : 1)
#define SEAM(k) do { if (IN((k) + 1)) { if ((k) == 0) cg::this_grid().sync(); else xcd_barrier(bar); } } while (0)
    PH(0, phase_prep(p, lds);)
    PH(1, phase_xn(p, lds);)
    PG(2, SchedG1 S{p.ws, G, c, MULT(2)}; EpiG1 E{p.ws}; pg8::gemm_phase<EpiG1, SchedG1, false>(lds, 1024, 2048u, 2048u, S, E);)
    PG(3, SchedG2 S{p.ws, G, c, MULT(3)}; EpiG2 E{p.ws}; pg8::gemm_phase<EpiG2, SchedG2, false>(lds, 256, 1024u, 512u, S, E);)
    PH(4, if (r_ == 0 || DUP_SUB != 1) phase_carry(p, lds); if (r_ == 0 || DUP_SUB != 0) phase_sgu(p, lds);)
    PG(5, SchedG3 S{p.ws, G, c, MULT(5)}; EpiG3 E{p.ws}; pg8::gemm_phase<EpiG3, SchedG3, false>(lds, 512, 1024u, 1024u, S, E);)
    PG(6, SchedG4 S{p.ws, G, c, MULT(6)}; EpiG4 E{p.ws, p.in[20]}; pg8::gemm_phase<EpiG4, SchedG4, false>(lds, 512, 1024u, 1024u, S, E);)
    PG(7, SchedG5 S{p.ws, G, c, MULT(7)}; EpiG5 E{p.ws}; pg8::gemm_phase<EpiG5, SchedG5, false>(lds, 512, 1024u, 1024u, S, E);)
    PG(8, SchedG6 S{p.ws, G, c, MULT(8)}; EpiG6 E{p.ws}; pg8::gemm_phase<EpiG6, SchedG6, false>(lds, 1024, 2048u, 2048u, S, E);)
    PH(9, phase_r1(p);)
    PG(10, SchedG7 S{p.ws, G, c, MULT(10)}; EpiG7 E{p.ws}; pg8::gemm_phase<EpiG7, SchedG7, false>(lds, 1024, 2048u, 2048u, S, E);)
    PH(11, phase_route(p, lds);)
    PH(12, phase_scan(p, lds);)
    PH(13, phase_scatter(p, lds);)
    PG(14, SchedG8 S{p.ws, G, c, MULT(14)}; EpiG8 E{p.ws}; pg8::gemm_phase<EpiG8, SchedG8, true>(lds, 1024, 2048u, 2048u, S, E);)
    PG(15, { SchedG9 S{p.ws, G, c, MULT(15)}; EpiG9 E{p.ws}; pg8::gemm_phase<EpiG9, SchedG9, false>(lds, 256, 512u, 512u, S, E); } { SchedG10 S{p.ws, G, c, MULT(19)}; EpiG10 E{p.ws}; pg8::gemm_phase<EpiG10, SchedG10, false>(lds, 256, 512u, 512u, S, E); })
    PH(16, phase_r3(p);)
    if (SPIN_PHASE >= 0) { const unsigned long long t0_ = __builtin_amdgcn_s_memrealtime(); while (__builtin_amdgcn_s_memrealtime() - t0_ < spin_acc * SPIN_MULT) __builtin_amdgcn_s_sleep(8); }
#undef IN
#undef SEAM
#undef PH
#undef PG
#undef MULT
}

extern "C" void kernel_launch(void* const* d_in, const int* in_sizes, int n_in, void* d_out, int out_size, void* d_ws, size_t ws_size, hipStream_t stream) {
    static int grid = 0;
    if (grid == 0) {
        if (n_in != 35 || out_size != NTOK * DM || ws_size < WS_NEED) { fprintf(stderr, "kernel_launch: unexpected shapes / workspace (%d inputs, out %d, ws %zu)\n", n_in, out_size, ws_size); grid = -1; return; }
        int dev = 0, cus = 0, per_cu = 0;
        hipGetDevice(&dev); hipDeviceGetAttribute(&cus, hipDeviceAttributeMultiprocessorCount, dev);
        hipFuncSetAttribute((const void*)fwd_kernel, hipFuncAttributeMaxDynamicSharedMemorySize, LDS_BYTES);
        hipOccupancyMaxActiveBlocksPerMultiprocessor(&per_cu, (const void*)fwd_kernel, NT, LDS_BYTES);
        if (per_cu < 1) { fprintf(stderr, "kernel_launch: occupancy query says %d blocks per CU\n", per_cu); per_cu = 1; }
        grid = cus * 1;
        (void)hipGetLastError();
    }
    if (grid < 0) return;
    Params p{};
    for (int i = 0; i < 35; ++i) p.in[i] = (const float*)d_in[i];
    p.out = (float*)d_out; p.ws = (unsigned char*)d_ws;
#if N_LAUNCH_MODE == 1
    hipMemsetAsync(d_ws, 0, 16384, stream);
    p.ph_lo = 0; p.ph_hi = N_PHASES;
    void* args[] = {&p};
    hipError_t e = hipLaunchCooperativeKernel((const void*)fwd_kernel, dim3(grid), dim3(NT), args, LDS_BYTES, stream);
    if (e != hipSuccess) fprintf(stderr, "cooperative launch failed: %s (grid %d)\n", hipGetErrorString(e), grid);
#else
    for (int k = 0; k < N_PHASES; ++k) { p.ph_lo = k; p.ph_hi = k + 1; hipLaunchKernelGGL(fwd_kernel, dim3(grid), dim3(NT), LDS_BYTES, stream, p); }
#endif
}
```

```cpp
#include <hip/hip_runtime.h>
#include <hip/hip_cooperative_groups.h>
#include <cstdio>
namespace cg = cooperative_groups;

#ifndef DUP_PHASE
#define DUP_PHASE -1
#define DUP_REPS 1
#define DUP_SUB -1
#define SPIN_PHASE -1
#define SPIN_MULT 9
#endif
#ifndef N_LAUNCH_MODE
#define N_LAUNCH_MODE 1
#endif

#define LAS __attribute__((address_space(3)))
typedef unsigned short bf16_t;
typedef short bf16x8 __attribute__((ext_vector_type(8)));
typedef float f32x4 __attribute__((ext_vector_type(4)));
typedef float f32x2 __attribute__((ext_vector_type(2)));
typedef unsigned u32x4 __attribute__((ext_vector_type(4)));
typedef unsigned u32x2 __attribute__((ext_vector_type(2)));
typedef LAS unsigned char* ldsp_t;

constexpr int NT = 512;
constexpr int DM = 1024;
constexpr int NTOK = 32768;
constexpr int NCTXR = 1024;
constexpr int NROWS = NTOK + NCTXR;
constexpr int DIN = 3584;
constexpr int UC_ROWS = 2304;
constexpr int NEXP = 256;
constexpr int MAXSLOT = 360448;
constexpr float EPS = 1e-6f;

constexpr size_t MiB = 1u << 20;
constexpr size_t WS_MODP = 1 * MiB;
constexpr size_t WS_MOD = 3 * MiB;
constexpr size_t WS_APL = 3 * MiB + 256 * 1024;
constexpr size_t WS_SGUW = 3 * MiB + 512 * 1024;
constexpr size_t WS_WGLU_T = 4 * MiB;
constexpr size_t WS_WR_T = 4 * MiB + 512 * 1024;
constexpr size_t WS_WB5_T = 5 * MiB;
constexpr size_t WS_WBS_T = 6 * MiB;
constexpr size_t WS_WOUT_T = 7 * MiB;
constexpr size_t WS_WIN_T = 9 * MiB;
constexpr size_t WS_BCAT_T = 16 * MiB;
constexpr size_t WS_WEND_T = 24 * MiB;
constexpr size_t WS_SSQV = 28 * MiB;
constexpr size_t WS_SSQM = 29 * MiB;
constexpr size_t WS_IDX = 31 * MiB;
constexpr size_t WS_WT = 32 * MiB;
constexpr size_t WS_SLOT = 33 * MiB;
constexpr size_t WS_BLKCNT = 34 * MiB;
constexpr size_t WS_BLKOFF = 34 * MiB + 256 * 1024;
constexpr size_t WS_TOTAL = 34 * MiB + 512 * 1024;
constexpr size_t WS_TILEEXP = 34 * MiB + 768 * 1024;
constexpr size_t WS_TOKSLOT = 35 * MiB;
constexpr size_t WS_WSLOT = 36 * MiB + 512 * 1024;
constexpr size_t WS_WD_T = 48 * MiB;
constexpr size_t WS_WGU_T = 177 * MiB;
constexpr size_t WS_XN = 434 * MiB;
constexpr size_t WS_UCAT = 500 * MiB;
constexpr size_t WS_E = 572 * MiB;
constexpr size_t WS_GU = 644 * MiB;
constexpr size_t WS_GV = 676 * MiB;
constexpr size_t WS_SG5 = 708 * MiB;
constexpr size_t WS_SGS = 772 * MiB;
constexpr size_t WS_YS = 836 * MiB;
constexpr size_t WS_YS5 = 868 * MiB;
constexpr size_t WS_YSGU = 900 * MiB;
constexpr size_t WS_MX = 932 * MiB;
constexpr size_t WS_MERGED = 500 * MiB;
constexpr size_t WS_LOGITS = 564 * MiB;
constexpr size_t WS_H = 596 * MiB;
constexpr size_t WS_YSLOT = 177 * MiB;
constexpr size_t WS_NEED = 996 * MiB;

constexpr int LDS_BYTES = 147456;

struct Params { const float* in[35]; float* out; unsigned char* ws; int ph_lo, ph_hi; };

__device__ __forceinline__ unsigned f2bf(float f) { unsigned u = __builtin_bit_cast(unsigned, f); return (u + 0x7fffu + ((u >> 16) & 1u)) >> 16; }
typedef __bf16 bf16v2_t __attribute__((ext_vector_type(2)));
__device__ __forceinline__ unsigned pk2(float lo, float hi) { bf16v2_t v; v.x = (__bf16)lo; v.y = (__bf16)hi; return __builtin_bit_cast(unsigned, v); }
__device__ __forceinline__ float bflo(unsigned w) { return __builtin_bit_cast(float, w << 16); }
__device__ __forceinline__ float bfhi(unsigned w) { return __builtin_bit_cast(float, w & 0xffff0000u); }
__device__ __forceinline__ float bf2f(bf16_t b) { return __builtin_bit_cast(float, ((unsigned)b) << 16); }
__device__ __forceinline__ float sigmoid_f(float x) { return __builtin_amdgcn_rcpf(1.0f + __expf(-x)); }
__device__ __forceinline__ float silu_f(float x) { return x * sigmoid_f(x); }
__device__ __forceinline__ float gelu_f(float x) { const float z = 1.5957691216057308f * (x + 0.044715f * x * x * x); return x * sigmoid_f(z); }
__device__ __forceinline__ float wave_sum(float v) {
#pragma unroll
    for (int o = 1; o < 64; o <<= 1) v += __shfl_xor(v, o);
    return v;
}
template <int CTRL, int RM = 0xf, int BM = 0xf> __device__ __forceinline__ float dpp_f(float oldv, float x) {
    return __builtin_bit_cast(float, __builtin_amdgcn_update_dpp(__builtin_bit_cast(int, oldv), __builtin_bit_cast(int, x), CTRL, RM, BM, false)); }
__device__ __forceinline__ float wave_max_dpp(float v) {
    v = fmaxf(v, dpp_f<0xB1>(v, v)); v = fmaxf(v, dpp_f<0x4E>(v, v)); v = fmaxf(v, dpp_f<0x124>(v, v)); v = fmaxf(v, dpp_f<0x128>(v, v));
    v = fmaxf(v, dpp_f<0x142, 0xa>(v, v)); v = fmaxf(v, dpp_f<0x143, 0xc>(v, v));
    return __builtin_bit_cast(float, __builtin_amdgcn_readlane(__builtin_bit_cast(int, v), 63)); }
#define LDS_WAIT() asm volatile("s_waitcnt lgkmcnt(0)" ::: "memory")

__device__ __forceinline__ double dexp_(double x) {
    const double r = x * (1.0 / 32.0); double t = 1.0, s = 1.0;
#pragma unroll 1
    for (int i = 1; i <= 14; ++i) { t *= r / (double)i; s += t; }
#pragma unroll 1
    for (int i = 0; i < 5; ++i) s *= s;
    return s;
}
__device__ __forceinline__ void dsincos_(double th, double& sn, double& cs) {
    const double TWO_PI_HI = 6.283185307179586232, TWO_PI_LO = 2.4492935982947064e-16;
    const double k = __builtin_rint(th * 0.15915494309189535);
    double r = (th - k * TWO_PI_HI) - k * TWO_PI_LO;
    r *= 0.125;
    const double r2 = r * r; double ts = r, tc = 1.0, s = r, c = 1.0;
#pragma unroll 1
    for (int i = 1; i <= 9; ++i) { tc *= -r2 / (double)((2 * i - 1) * (2 * i)); c += tc; ts *= -r2 / (double)((2 * i) * (2 * i + 1)); s += ts; }
#pragma unroll 1
    for (int i = 0; i < 3; ++i) { const double s2 = 2.0 * s * c, c2 = c * c - s * s; s = s2; c = c2; }
    sn = s; cs = c;
}

namespace pg8 {
constexpr int BM = 256, BK = 64, HALF = 128, HTB = HALF * BK * 2, STAGE_BYTES = 8 * HTB;
__device__ __forceinline__ int lds_byte(int r, int c) { const int st = (r >> 4) * 2 + (c >> 5), rr = r & 15, cc = c & 31, ob = rr * 64 + cc * 2; return st * 1024 + (ob ^ (((ob >> 9) & 1) << 5)); }
__device__ __forceinline__ void stage_rc(int b, int& R, int& C) { const int st = b / 1024, sb = b % 1024, swz = sb ^ (((sb >> 9) & 1) << 5); R = (st >> 1) * 16 + swz / 64; C = (st & 1) * 32 + (swz % 64) / 2; }
__device__ __forceinline__ int perm32(int rho) { const int n = rho >> 4, i = rho & 15; return 8 * (i >> 2) + 4 * n + (i & 3); }
__device__ __forceinline__ int perm256(int rho) { const int bj = rho >> 7, wc = (rho >> 5) & 3, n = (rho >> 4) & 1, q = (rho >> 2) & 3, reg = rho & 3; return 64 * wc + 16 * q + 8 * bj + 4 * n + reg; }

struct Unit { const char* A; const char* B; const int* arow; int pm, pn, x0, x1; };

template <class Epi, class Sched, bool GATHER>
__device__ __forceinline__ void gemm_phase(ldsp_t lds, const int K, const unsigned lda, const unsigned ldb, const Sched& S, const Epi& E) {
    const int tid = threadIdx.x, wid = __builtin_amdgcn_readfirstlane(tid >> 6), lane = tid & 63, wr = wid >> 2, wc = wid & 3, fr = lane & 15, fq = lane >> 4;
    const int nt = K / BK;
    int RA[2], CA[2]; unsigned voffB[2][2];
#pragma unroll
    for (int i = 0; i < 2; ++i) { int R, C; stage_rc(tid * 16 + i * 8192, R, C); RA[i] = R; CA[i] = C;
        const int Rb0 = ((int)Epi::PERM == 2) ? perm256(R) : ((int)Epi::PERM == 1) ? ((R & ~31) + perm32(R & 31)) : R;
        const int Rb1 = ((int)Epi::PERM == 2) ? perm256(R + HALF) : Rb0 + HALF;
        voffB[0][i] = (unsigned)Rb0 * ldb + (unsigned)C * 2u; voffB[1][i] = (unsigned)Rb1 * ldb + (unsigned)C * 2u; }
    unsigned vA[2][2], vN[2][2];
#define PG8_SETA(v, u) do { _Pragma("unroll") for (int _h = 0; _h < 2; ++_h) _Pragma("unroll") for (int _i = 0; _i < 2; ++_i) { \
        const int _row = _h * HALF + RA[_i]; const unsigned _src = GATHER ? (unsigned)(u).arow[_row] : (unsigned)_row; (v)[_h][_i] = _src * lda + (unsigned)CA[_i] * 2u; } } while (0)
    const size_t kstep = (size_t)(BK * 2);
    const unsigned ldsw = (unsigned)wid * 1024u;
    const int aoff = lds_byte(wr * 64 + fr, fq * 8), boff = lds_byte(wc * 32 + fr, fq * 8);
#define PG8_SA(b, h) (((b) * 2 + (h)) * HTB)
#define PG8_SB(b, h) ((4 + (b) * 2 + (h)) * HTB)
#define PG8_STAGE(bufoff, gbase, o0, o1) do { \
        __builtin_amdgcn_global_load_lds((const unsigned*)((const char*)(gbase) + (o0)), (LAS unsigned*)(lds + (bufoff) + ldsw), 16, 0, 0); \
        __builtin_amdgcn_global_load_lds((const unsigned*)((const char*)(gbase) + (o1)), (LAS unsigned*)(lds + (bufoff) + ldsw + 8192), 16, 0, 0); } while (0)
#define PG8_LDA(dst, b, h) do { _Pragma("unroll") for (int m = 0; m < 4; ++m) _Pragma("unroll") for (int k = 0; k < 2; ++k) dst[m][k] = *(const LAS bf16x8*)(lds + PG8_SA(b, h) + aoff + m * 2048 + k * 1024); } while (0)
#define PG8_LDB(dst, b, h) do { _Pragma("unroll") for (int n = 0; n < 2; ++n) _Pragma("unroll") for (int k = 0; k < 2; ++k) dst[n][k] = *(const LAS bf16x8*)(lds + PG8_SB(b, h) + boff + n * 2048 + k * 1024); } while (0)
#define PG8_MMA(ai, bj, At, Bt) do { __builtin_amdgcn_s_setprio(1); _Pragma("unroll") for (int m = 0; m < 4; ++m) _Pragma("unroll") for (int n = 0; n < 2; ++n) _Pragma("unroll") for (int k = 0; k < 2; ++k) \
        acc[ai][bj][m][n] = __builtin_amdgcn_mfma_f32_16x16x32_bf16(Bt[n][k], At[m][k], acc[ai][bj][m][n], 0, 0, 0); __builtin_amdgcn_s_setprio(0); } while (0)
#define PG8_WAIT_V(n) asm volatile("s_waitcnt vmcnt(" #n ")" ::: "memory")
#define PG8_WAIT_L(n) asm volatile("s_waitcnt lgkmcnt(" #n ")" ::: "memory")
#define PG8_BAR __builtin_amdgcn_s_barrier()
#define PG8_SCHED __builtin_amdgcn_sched_barrier(0)
    Unit cur, nxt; int ui = 0;
    if (!S.next(0, cur)) return;
    PG8_SETA(vA, cur);
    f32x4 acc[2][2][4][2];
#pragma unroll
    for (int a = 0; a < 2; ++a)
#pragma unroll
        for (int b = 0; b < 2; ++b)
#pragma unroll
            for (int m = 0; m < 4; ++m)
#pragma unroll
                for (int n = 0; n < 2; ++n) acc[a][b][m][n] = (f32x4){0.f, 0.f, 0.f, 0.f};
    bf16x8 At[4][2], B0[2][2], B1[2][2];
    const char* cA = cur.A; const char* cB = cur.B;
    PG8_STAGE(PG8_SB(0, 0), cB, voffB[0][0], voffB[0][1]); PG8_STAGE(PG8_SA(0, 0), cA, vA[0][0], vA[0][1]);
    PG8_STAGE(PG8_SB(0, 1), cB, voffB[1][0], voffB[1][1]); PG8_STAGE(PG8_SA(0, 1), cA, vA[1][0], vA[1][1]);
    if (wr == 1) PG8_BAR;
    PG8_WAIT_V(4); PG8_BAR;
    PG8_STAGE(PG8_SB(1, 0), cB + kstep, voffB[0][0], voffB[0][1]); PG8_STAGE(PG8_SA(1, 0), cA + kstep, vA[0][0], vA[0][1]);
    PG8_STAGE(PG8_SB(1, 1), cB + kstep, voffB[1][0], voffB[1][1]);
    PG8_WAIT_V(6); PG8_BAR;
    for (;;) {
        const bool has_next = S.next(ui + 1, nxt);
        const char* nA = has_next ? nxt.A : cA; const char* nB = has_next ? nxt.B : cB;
        if (GATHER) { if (has_next && nxt.arow != cur.arow) { PG8_SETA(vN, nxt); } else { vN[0][0] = vA[0][0]; vN[0][1] = vA[0][1]; vN[1][0] = vA[1][0]; vN[1][1] = vA[1][1]; } }
#pragma nounroll
        for (int t = 0; t < nt; t += 2) {
            const bool last = (t == nt - 2);
            const char* a1 = cA + (size_t)(t + 1) * kstep;
            const char* a2 = last ? nA : cA + (size_t)(t + 2) * kstep; const char* b2 = last ? nB : cB + (size_t)(t + 2) * kstep;
            const char* a3 = a2 + kstep; const char* b3 = b2 + kstep;
            unsigned o00, o01, o10, o11;
            if (GATHER && last) { o00 = vN[0][0]; o01 = vN[0][1]; o10 = vN[1][0]; o11 = vN[1][1]; } else { o00 = vA[0][0]; o01 = vA[0][1]; o10 = vA[1][0]; o11 = vA[1][1]; }
            PG8_LDB(B0, 0, 0); PG8_SCHED; PG8_LDA(At, 0, 0); PG8_STAGE(PG8_SA(1, 1), a1, vA[1][0], vA[1][1]);
            PG8_WAIT_L(8); PG8_BAR; PG8_WAIT_L(0); PG8_MMA(0, 0, At, B0); PG8_BAR; PG8_SCHED;
            PG8_LDB(B1, 0, 1); PG8_STAGE(PG8_SB(0, 0), b2, voffB[0][0], voffB[0][1]);
            PG8_BAR; PG8_WAIT_L(0); PG8_MMA(0, 1, At, B1); PG8_BAR;
            PG8_LDA(At, 0, 1); PG8_STAGE(PG8_SA(0, 0), a2, o00, o01);
            PG8_BAR; PG8_WAIT_L(0); PG8_MMA(1, 0, At, B0); PG8_BAR; PG8_SCHED;
            PG8_STAGE(PG8_SB(0, 1), b2, voffB[1][0], voffB[1][1]);
            PG8_WAIT_V(6); PG8_BAR; PG8_MMA(1, 1, At, B1); PG8_BAR;
            PG8_LDB(B0, 1, 0); PG8_SCHED; PG8_LDA(At, 1, 0); PG8_STAGE(PG8_SA(0, 1), a2, o10, o11);
            PG8_WAIT_L(8); PG8_BAR; PG8_WAIT_L(0); PG8_MMA(0, 0, At, B0); PG8_BAR; PG8_SCHED;
            PG8_LDB(B1, 1, 1); PG8_STAGE(PG8_SB(1, 0), b3, voffB[0][0], voffB[0][1]);
            PG8_BAR; PG8_WAIT_L(0); PG8_MMA(0, 1, At, B1); PG8_BAR;
            PG8_LDA(At, 1, 1); PG8_STAGE(PG8_SA(1, 0), a3, o00, o01);
            PG8_BAR; PG8_WAIT_L(0); PG8_MMA(1, 0, At, B0); PG8_BAR; PG8_SCHED;
            PG8_STAGE(PG8_SB(1, 1), b3, voffB[1][0], voffB[1][1]);
            PG8_WAIT_V(6); PG8_BAR; PG8_MMA(1, 1, At, B1); PG8_BAR;
        }
        E(acc, cur, wr, wc, fr, fq);
        if (!has_next) break;
#pragma unroll
        for (int a = 0; a < 2; ++a)
#pragma unroll
            for (int b = 0; b < 2; ++b)
#pragma unroll
                for (int m = 0; m < 4; ++m)
#pragma unroll
                    for (int n = 0; n < 2; ++n) acc[a][b][m][n] = (f32x4){0.f, 0.f, 0.f, 0.f};
        cur = nxt; cA = nA; cB = nB; ++ui;
        if (GATHER) { vA[0][0] = vN[0][0]; vA[0][1] = vN[0][1]; vA[1][0] = vN[1][0]; vA[1][1] = vN[1][1]; }
    }
    PG8_WAIT_V(0);
    if (wr == 0) PG8_BAR;
    PG8_BAR;
#undef PG8_SETA
#undef PG8_SA
#undef PG8_SB
#undef PG8_STAGE
#undef PG8_LDA
#undef PG8_LDB
#undef PG8_MMA
#undef PG8_WAIT_V
#undef PG8_WAIT_L
#undef PG8_BAR
#undef PG8_SCHED
}
}
using pg8::Unit;
typedef f32x4 acc_t[2][2][4][2];

#define ACC16(ai, m, k) acc[ai][(k) >> 3][m][((k) >> 2) & 1][(k) & 3]
#define EPI_ROWS(ai, m, rowl) _Pragma("unroll") for (int ai = 0; ai < 2; ++ai) _Pragma("unroll") for (int m = 0; m < 4; ++m) { const int rowl = ai * 128 + wr * 64 + m * 16 + fr;
#define EPI_END }

struct TItem { const float* src; bf16_t* dst; int ldw, ldt; };
__device__ __forceinline__ TItem tr_make(const float* W, int ldw, int k0, int n0, bf16_t* WT, size_t drow0, int ldt) { TItem t; t.src = W + (size_t)k0 * ldw + n0; t.dst = WT + drow0 * (size_t)ldt + k0; t.ldw = ldw; t.ldt = ldt; return t; }
__device__ __forceinline__ TItem tr_decode(const Params& p, int r) {
    constexpr int I_IN = 16 * 56, I_GLU = 64, I_B5 = 128, I_BS = 128, I_OUT = 256, I_R = 64;
    if (r < I_IN) return tr_make(p.in[10], DIN, (r / 56) * 64, (r % 56) * 64, (bf16_t*)(p.ws + WS_WIN_T), (size_t)(r % 56) * 64, 1024); r -= I_IN;
    if (r < I_GLU) return tr_make(p.in[19], 512, (r / 8) * 64, (r % 8) * 64, (bf16_t*)(p.ws + WS_WGLU_T), (size_t)(r % 8) * 64, 512); r -= I_GLU;
    if (r < I_B5) return tr_make(p.in[24], 1024, (r / 16) * 64, (r % 16) * 64, (bf16_t*)(p.ws + WS_WB5_T), (size_t)(r % 16) * 64, 512); r -= I_B5;
    if (r < I_BS) return tr_make(p.in[25], 1024, (r / 16) * 64, (r % 16) * 64, (bf16_t*)(p.ws + WS_WBS_T), (size_t)(r % 16) * 64, 512); r -= I_BS;
    if (r < I_OUT) return tr_make(p.in[26], 1024, (r / 16) * 64, (r % 16) * 64, (bf16_t*)(p.ws + WS_WOUT_T), (size_t)(r % 16) * 64, 1024); r -= I_OUT;
    if (r < I_R) return tr_make(p.in[27], 256, (r / 4) * 64, (r % 4) * 64, (bf16_t*)(p.ws + WS_WR_T), (size_t)(r % 4) * 64, 1024); r -= I_R;
    const int e = r / 192, q = r % 192;
    if (q < 128) {
        const int up = q >> 6, qq = q & 63, k0 = (qq / 4) * 64, n0 = (qq % 4) * 64;
        const float* W = (e < 256) ? p.in[up ? 30 : 29] + (size_t)e * 262144 : p.in[up ? 33 : 32];
        return tr_make(W, 256, k0, n0, (bf16_t*)(p.ws + WS_WGU_T), (size_t)e * 512 + (size_t)(n0 >> 7) * 256 + up * 128 + (n0 & 127), 1024);
    }
    const int qq = q - 128, k0 = (qq / 16) * 64, n0 = (qq % 16) * 64;
    const float* W = (e < 256) ? p.in[31] + (size_t)e * 262144 : p.in[34];
    return tr_make(W, 1024, k0, n0, (bf16_t*)(p.ws + WS_WD_T), (size_t)e * 1024 + n0, 256);
}
#define TR_LOAD(v, t) do { __builtin_amdgcn_sched_barrier(0); _Pragma("unroll") for (int it_ = 0; it_ < 16; ++it_) (v)[it_] = __builtin_nontemporal_load((const f32x4*)((t).src + (size_t)(it_ * 4 + (lane >> 4)) * (t).ldw + (lane & 15) * 4)); __builtin_amdgcn_sched_barrier(0); } while (0)
#define TR_STORE(v, t) do { \
    _Pragma("unroll") for (int it_ = 0; it_ < 16; ++it_) { LAS float* s_ = scr + (it_ * 4 + (lane >> 4)) * 65 + (lane & 15) * 4; s_[0] = (v)[it_].x; s_[1] = (v)[it_].y; s_[2] = (v)[it_].z; s_[3] = (v)[it_].w; } \
    LDS_WAIT(); \
    _Pragma("unroll") for (int it_ = 0; it_ < 8; ++it_) { const int n_ = it_ * 8 + (lane >> 3), c_ = lane & 7; const LAS float* s_ = scr + (8 * c_) * 65 + n_; \
        u32x4 o_; o_.x = pk2(s_[0], s_[65]); o_.y = pk2(s_[130], s_[195]); o_.z = pk2(s_[260], s_[325]); o_.w = pk2(s_[390], s_[455]); \
        __builtin_nontemporal_store(o_, (u32x4*)((t).dst + (size_t)n_ * (t).ldt + 8 * c_)); } \
    LDS_WAIT(); } while (0)

__device__ __forceinline__ void s5_tables(const Params& p, int g, int sub, ldsp_t lds) {
    LAS f32x2* apow = (LAS f32x2*)lds;
    LAS f32x2* bbar = (LAS f32x2*)(lds + 17408);
    LAS f32x2* cm = (LAS f32x2*)(lds + 17408 + 16384);
    LAS float* Kt = (LAS float*)(lds + 17408 + 32768);
    const int tid = threadIdx.x;
    const float *a_re = p.in[11], *a_im = p.in[12], *log_dt = p.in[13], *b_re = p.in[14], *b_im = p.in[15], *c_re = p.in[16], *c_im = p.in[17], *dsk = p.in[18];
    float* APL = (float*)(p.ws + WS_APL);
    if (tid < 128) {
        const int d = tid >> 6, pp = tid & 63, idx = (d * 32 + g) * 64 + pp;
        const double are = (double)a_re[idx], aim = (double)a_im[idx];
        const double dt = dexp_((double)log_dt[d * 32 + g]);
        const double mag = dexp_(dt * are); double sn, cs; dsincos_(dt * aim, sn, cs);
        const double abr = mag * cs, abi = mag * sn;
        double pr = 1.0, pi = 0.0;
#pragma unroll 1
        for (int m = 0; m <= 16; ++m) { apow[(d * 17 + m) * 64 + pp] = (f32x2){(float)pr, (float)pi}; const double nr = pr * abr - pi * abi, ni = pr * abi + pi * abr; pr = nr; pi = ni; }
        if (sub == 0) { const f32x2 aL = apow[(d * 17 + 16) * 64 + pp]; APL[idx * 2 + 0] = aL.x; APL[idx * 2 + 1] = aL.y; }
        const double nr = abr - 1.0, ni = abi, den = are * are + aim * aim;
        const double qr = (nr * are + ni * aim) / den, qi = (ni * are - nr * aim) / den;
#pragma unroll 1
        for (int i = 0; i < 16; ++i) { const double br = (double)b_re[idx * 16 + i], bi = (double)b_im[idx * 16 + i];
            bbar[(d * 64 + pp) * 16 + i] = (f32x2){(float)(qr * br - qi * bi), (float)(qr * bi + qi * br)}; }
    }
    for (int e = tid; e < 2048; e += NT) { const int d = e >> 10, j = (e >> 6) & 15, pp = e & 63; const int gi = ((d * 32 + g) * 16 + j) * 64 + pp; cm[e] = (f32x2){c_re[gi], c_im[gi]}; }
    __syncthreads();
    for (int e1 = tid; e1 < 1024; e1 += NT) {
        const int d = e1 >> 9, m = (e1 >> 5) & 15, j = 2 * sub + ((e1 >> 4) & 1), i = e1 & 15, e = (d << 12) | (m << 8) | (j << 4) | i; float s = 0.f;
#pragma unroll 4
        for (int pp = 0; pp < 64; ++pp) { const f32x2 a = apow[(d * 17 + m) * 64 + pp], b = bbar[(d * 64 + pp) * 16 + i], c = cm[(d * 16 + j) * 64 + pp];
            const float tr = a.x * b.x - a.y * b.y, ti = a.x * b.y + a.y * b.x; s += c.x * tr - c.y * ti; }
        Kt[e] = s;
    }
    __syncthreads();
    unsigned* BC = (unsigned*)(p.ws + WS_BCAT_T) + (size_t)g * 256 * 256;
    for (int e3 = tid; e3 < 8192; e3 += NT) {
        const int rr = e3 >> 8, tau = rr >> 1, j = 2 * sub + (rr & 1), n = tau * 16 + j, e2 = n * 256 + (e3 & 255), kk0 = (e3 & 255) * 2; float v[2];
#pragma unroll
        for (int q = 0; q < 2; ++q) { const int kk = kk0 + q; float r;
            if (kk < 256) { const int k = kk >> 4, i = kk & 15; r = 0.f;
                if (tau >= k) r += Kt[((0 * 16 + (tau - k)) * 16 + j) * 16 + i];
                if (k >= tau) r += Kt[((1 * 16 + (k - tau)) * 16 + j) * 16 + i];
                if (k == tau && i == j) r += dsk[16 * g + j];
            } else { const int qq = kk - 256, part = qq >> 6, pp = qq & 63, d = part >> 1, m = (d == 0) ? (tau + 1) : (16 - tau);
                const f32x2 c = cm[(d * 16 + j) * 64 + pp], a = apow[(d * 17 + m) * 64 + pp];
                r = (part & 1) ? -(c.x * a.y + c.y * a.x) : (c.x * a.x - c.y * a.y); }
            v[q] = r; }
        BC[e2] = pk2(v[0], v[1]);
    }
    unsigned* WE = (unsigned*)(p.ws + WS_WEND_T) + (size_t)g * 256 * 128;
    for (int e3 = tid; e3 < 4096; e3 += NT) {
        const int n = 32 * sub + (e3 >> 7), e2 = n * 128 + (e3 & 127), kk0 = (e3 & 127) * 2, d = n >> 7, ri = (n >> 6) & 1, pp = n & 63; float v[2];
#pragma unroll
        for (int q = 0; q < 2; ++q) { const int kk = kk0 + q, k = kk >> 4, i = kk & 15, m = (d == 0) ? (15 - k) : k;
            const f32x2 a = apow[(d * 17 + m) * 64 + pp], b = bbar[(d * 64 + pp) * 16 + i];
            v[q] = ri ? (a.x * b.y + a.y * b.x) : (a.x * b.x - a.y * b.y); }
        WE[e2] = pk2(v[0], v[1]);
    }
    __syncthreads();
}

__device__ __forceinline__ void phase_prep(const Params& p, ldsp_t lds) {
    const int tid = threadIdx.x, lane = tid & 63, wave = tid >> 6, G = gridDim.x, bx = blockIdx.x;
    for (int q = bx; q < 256; q += G) s5_tables(p, q >> 3, q & 7, lds);
    { const float* sw = p.in[22]; unsigned* dst = (unsigned*)(p.ws + WS_SGUW);
      for (size_t e = (size_t)bx * NT + tid; e < 65536; e += (size_t)G * NT) dst[e] = pk2(sw[2 * e], sw[2 * e + 1]);
      u32x4* uc = (u32x4*)(p.ws + WS_UCAT);
      for (size_t e = (size_t)bx * NT + tid; e < (size_t)32 * 12288; e += (size_t)G * NT) { const size_t g = e / 12288, r = e % 12288; uc[(g * UC_ROWS + 2112) * 64 + r] = (u32x4){0u, 0u, 0u, 0u}; } }
    const int gw = bx * 8 + __builtin_amdgcn_readfirstlane(wave), NGW = G * 8;
    for (int r = gw; r < 1536; r += NGW) {
        const int cb = r % 96, ks = r / 96, n = cb * 64 + lane; const float* wm = p.in[4];
        float a0 = 0.f, a1 = 0.f, a2 = 0.f, a3 = 0.f, a4 = 0.f;
#pragma unroll 8
        for (int kk = 0; kk < 64; ++kk) { const int k = ks * 64 + kk; const float w = __builtin_nontemporal_load(wm + (size_t)k * 6144 + n);
            a0 += silu_f(p.in[1][k]) * w; a1 += silu_f(p.in[1][1024 + k]) * w; a2 += silu_f(p.in[1][2048 + k]) * w; a3 += silu_f(p.in[1][3072 + k]) * w; a4 += silu_f(p.in[3][k]) * w; }
        float* mp = (float*)(p.ws + WS_MODP) + (size_t)ks * 5 * 6144 + n;
        mp[0] = a0; mp[6144] = a1; mp[2 * 6144] = a2; mp[3 * 6144] = a3; mp[4 * 6144] = a4;
    }
    LAS float* scr = (LAS float*)(lds + wave * 16640);
    constexpr int N_TR = 16 * 56 + 64 + 128 + 128 + 256 + 64 + 257 * 192;
    int it = __builtin_amdgcn_readfirstlane(gw);
    if (it < N_TR) {
        f32x4 va[16], vb[16];
        TItem ta = tr_decode(p, it), tb; TR_LOAD(va, ta);
        for (;;) {
            bool more = (it + NGW) < N_TR;
            tb = tr_decode(p, more ? it + NGW : it); TR_LOAD(vb, tb);
            TR_STORE(va, ta);
            if (!more) break;
            it += NGW; more = (it + NGW) < N_TR;
            ta = tr_decode(p, more ? it + NGW : it); TR_LOAD(va, ta);
            TR_STORE(vb, tb);
            if (!more) break;
            it += NGW;
        }
    }
}

__device__ __forceinline__ void phase_xn(const Params& p, ldsp_t lds) {
    const int tid = threadIdx.x, lane = tid & 63, wave = tid >> 6, G = gridDim.x, bx = blockIdx.x;
    const float* modp = (const float*)(p.ws + WS_MODP); const float* bmod = p.in[5];
    { float* mod = (float*)(p.ws + WS_MOD);
      for (int e = bx * NT + tid; e < 5 * 6144; e += G * NT) { const int n = e % 6144; float s = bmod[n];
#pragma unroll
          for (int ks = 0; ks < 16; ++ks) s += modp[(size_t)ks * 5 * 6144 + e];
          mod[e] = s; } }
    LAS float* shv = (LAS float*)lds; LAS float* gsc = (LAS float*)(lds + 4096);
    const float* gpre = p.in[6];
    for (int tile = bx; tile < NTOK / 128; tile += G) {
        const int mr = tile >> 6;
        __syncthreads();
        for (int col = tid; col < 1024; col += NT) { float sh = bmod[col], sc = bmod[1024 + col];
#pragma unroll
            for (int ks = 0; ks < 16; ++ks) { sh += modp[((size_t)ks * 5 + mr) * 6144 + col]; sc += modp[((size_t)ks * 5 + mr) * 6144 + 1024 + col]; }
            shv[col] = sh; gsc[col] = gpre[col] * (1.0f + sc); }
        __syncthreads();
        for (int r0 = wave; r0 < 128; r0 += 32) {
            f32x4 v[4][4]; float ss[4];
#pragma unroll
            for (int q = 0; q < 4; ++q) { const int row = tile * 128 + r0 + 8 * q;
                const float* src = (row < NTOK) ? p.in[0] + (size_t)row * DM : p.in[2] + (size_t)(row - NTOK) * DM;
#pragma unroll
                for (int j = 0; j < 4; ++j) v[q][j] = __builtin_nontemporal_load((const f32x4*)(src + 4 * lane + 256 * j)); }
#pragma unroll
            for (int q = 0; q < 4; ++q) { float s2 = 0.f;
#pragma unroll
                for (int j = 0; j < 4; ++j) s2 += (v[q][j].x * v[q][j].x + v[q][j].y * v[q][j].y) + (v[q][j].z * v[q][j].z + v[q][j].w * v[q][j].w);
                ss[q] = s2; }
#pragma unroll
            for (int o = 1; o < 64; o <<= 1) {
#pragma unroll
                for (int q = 0; q < 4; ++q) ss[q] += __shfl_xor(ss[q], o); }
#pragma unroll
            for (int q = 0; q < 4; ++q) { const int row = tile * 128 + r0 + 8 * q; const float rstd = rsqrtf(ss[q] * (1.0f / DM) + EPS);
                bf16_t* dst = (bf16_t*)(p.ws + WS_XN) + (size_t)row * DM;
#pragma unroll
                for (int j = 0; j < 4; ++j) { const int c = 4 * lane + 256 * j; const f32x4 gs = *(const LAS f32x4*)(gsc + c), sh = *(const LAS f32x4*)(shv + c);
                    u32x2 o; o.x = pk2(v[q][j].x * rstd * gs.x + sh.x, v[q][j].y * rstd * gs.y + sh.y); o.y = pk2(v[q][j].z * rstd * gs.z + sh.z, v[q][j].w * rstd * gs.w + sh.w);
                    *(u32x2*)(dst + c) = o; } }
        }
    }
    __syncthreads();
    {
        constexpr int APITCH = 2064;
        ldsp_t Al = lds + 8192;
        for (int col = tid; col < 1024; col += NT) { float sh = bmod[col], sc = bmod[1024 + col];
#pragma unroll
            for (int ks = 0; ks < 16; ++ks) { sh += modp[((size_t)ks * 5 + 4) * 6144 + col]; sc += modp[((size_t)ks * 5 + 4) * 6144 + 1024 + col]; }
            shv[col] = sh; gsc[col] = gpre[col] * (1.0f + sc); }
        __syncthreads();
        const int fr = lane & 15, fq = lane >> 4;
        for (int it = bx; it < 256; it += G) {
            const int r0 = (it >> 2) * 16, cq = it & 3;
#pragma unroll
            for (int q = 0; q < 2; ++q) { const int rl = wave * 2 + q;
                const float* src = p.in[2] + (size_t)(r0 + rl) * DM;
                f32x4 v[4]; float s2 = 0.f;
#pragma unroll
                for (int j = 0; j < 4; ++j) { v[j] = *(const f32x4*)(src + 4 * lane + 256 * j); s2 += (v[j].x * v[j].x + v[j].y * v[j].y) + (v[j].z * v[j].z + v[j].w * v[j].w); }
                const float rstd = rsqrtf(wave_sum(s2) * (1.0f / DM) + EPS);
#pragma unroll
                for (int j = 0; j < 4; ++j) { const int c = 4 * lane + 256 * j; const f32x4 gs = *(const LAS f32x4*)(gsc + c), sh = *(const LAS f32x4*)(shv + c);
                    u32x2 o; o.x = pk2(v[j].x * rstd * gs.x + sh.x, v[j].y * rstd * gs.y + sh.y); o.y = pk2(v[j].z * rstd * gs.z + sh.z, v[j].w * rstd * gs.w + sh.w);
                    *(LAS u32x2*)(Al + rl * APITCH + c * 2) = o; }
            }
            __syncthreads();
            f32x4 acc = (f32x4){0.f, 0.f, 0.f, 0.f};
            const bf16_t* wt = (const bf16_t*)(p.ws + WS_WIN_T) + (size_t)(128 * cq + 16 * wave + fr) * 1024 + 8 * fq;
#pragma unroll 1
            for (int kb = 0; kb < 32; kb += 16) {
                bf16x8 bfr[16];
#pragma unroll
                for (int k8 = 0; k8 < 16; ++k8) bfr[k8] = *(const bf16x8*)(wt + (kb + k8) * 32);
#pragma unroll
                for (int k8 = 0; k8 < 16; ++k8) { const bf16x8 af = *(const LAS bf16x8*)(Al + fr * APITCH + ((kb + k8) * 32 + 8 * fq) * 2);
                    acc = __builtin_amdgcn_mfma_f32_16x16x32_bf16(af, bfr[k8], acc, 0, 0, 0); }
            }
            { const int g = 8 * cq + wave;
#pragma unroll
              for (int r = 0; r < 4; ++r) { const int rc = r0 + 4 * fq + r, crow = 2048 + (rc >> 8) * 16 + ((rc & 255) >> 4), k = rc & 15;
                  ((bf16_t*)(p.ws + WS_UCAT))[(size_t)(g * UC_ROWS + crow) * 512 + k * 16 + fr] = (bf16_t)f2bf(acc[r]); } }
            __syncthreads();
        }
    }
}

struct SchedG1 { const unsigned char* ws; int G, c, mult;
    __device__ __forceinline__ bool next(int i, Unit& u) const { int L = i * G + c; if (L >= 1792 * mult) return false; if (mult > 1) L %= 1792;
        u.pm = L / 14; u.pn = L % 14;
        u.A = (const char*)ws + WS_XN + (size_t)u.pm * 256 * 2048; u.B = (const char*)ws + WS_WIN_T + (size_t)u.pn * 256 * 2048; u.arow = nullptr; u.x0 = 0; u.x1 = 0; return true; } };
struct EpiG1 { static constexpr int PERM = 2; unsigned char* ws;
    __device__ __forceinline__ void operator()(const acc_t& acc, const Unit& u, int wr, int wc, int fr, int fq) const {
        const int pn = u.pn, col = pn * 256 + wc * 64 + 16 * fq;
        EPI_ROWS(ai, m, rowl)
            const int row = u.pm * 256 + rowl; float v[16];
#pragma unroll
            for (int k = 0; k < 16; ++k) v[k] = ACC16(ai, m, k);
            u32x4 o0, o1;
            if (pn < 2) {
                const int g = col >> 4, crow = row >> 4, kk = row & 15;
                o0.x = pk2(v[0], v[1]); o0.y = pk2(v[2], v[3]); o0.z = pk2(v[4], v[5]); o0.w = pk2(v[6], v[7]); o1.x = pk2(v[8], v[9]); o1.y = pk2(v[10], v[11]); o1.z = pk2(v[12], v[13]); o1.w = pk2(v[14], v[15]);
                bf16_t* dp = (bf16_t*)(ws + WS_UCAT) + ((size_t)(g * UC_ROWS + crow) * 512 + kk * 16); *(u32x4*)dp = o0; *(u32x4*)(dp + 8) = o1;
            } else if (pn < 6) {
                float ssq = 0.f;
#pragma unroll
                for (int k = 0; k < 16; ++k) { v[k] = gelu_f(v[k]); ssq += v[k] * v[k]; }
                o0.x = pk2(v[0], v[1]); o0.y = pk2(v[2], v[3]); o0.z = pk2(v[4], v[5]); o0.w = pk2(v[6], v[7]); o1.x = pk2(v[8], v[9]); o1.y = pk2(v[10], v[11]); o1.z = pk2(v[12], v[13]); o1.w = pk2(v[14], v[15]);
                if (pn < 4) { bf16_t* dp = (bf16_t*)(ws + WS_GU) + (size_t)row * 512 + (col - 512); *(u32x4*)dp = o0; *(u32x4*)(dp + 8) = o1; }
                else { bf16_t* dp = (bf16_t*)(ws + WS_GV) + (size_t)row * 512 + (col - 1024); *(u32x4*)dp = o0; *(u32x4*)(dp + 8) = o1;
                    ssq += __shfl_xor(ssq, 16); ssq += __shfl_xor(ssq, 32); if (fq == 0) ((float*)(ws + WS_SSQV))[(size_t)row * 8 + (pn - 4) * 4 + wc] = ssq; }
            } else {
#pragma unroll
                for (int k = 0; k < 16; ++k) v[k] = sigmoid_f(v[k]);
                o0.x = pk2(v[0], v[1]); o0.y = pk2(v[2], v[3]); o0.z = pk2(v[4], v[5]); o0.w = pk2(v[6], v[7]); o1.x = pk2(v[8], v[9]); o1.y = pk2(v[10], v[11]); o1.z = pk2(v[12], v[13]); o1.w = pk2(v[14], v[15]);
                bf16_t* dp = (pn < 10) ? (bf16_t*)(ws + WS_SG5) + (size_t)row * 1024 + (col - 1536) : (bf16_t*)(ws + WS_SGS) + (size_t)row * 1024 + (col - 2560);
                *(u32x4*)dp = o0; *(u32x4*)(dp + 8) = o1;
            }
        EPI_END
    } };
struct SchedG2 { const unsigned char* ws; int G, c, mult;
    __device__ __forceinline__ bool next(int i, Unit& u) const { int L = i * G + c; if (L >= 256 * mult) return false; if (mult > 1) L %= 256; const int g = L >> 3; u.pm = L & 7; u.pn = 0; u.x0 = g; u.x1 = 0; u.arow = nullptr;
        u.A = (const char*)ws + WS_UCAT + ((size_t)g * UC_ROWS + (size_t)u.pm * 256) * 1024; u.B = (const char*)ws + WS_WEND_T + (size_t)g * 256 * 512; return true; } };
struct EpiG2 { static constexpr int PERM = 0; unsigned char* ws;
    __device__ __forceinline__ void operator()(const acc_t& acc, const Unit& u, int wr, int wc, int fr, int fq) const {
        float* Eo = (float*)(ws + WS_E) + (size_t)u.x0 * UC_ROWS * 256;
        EPI_ROWS(ai, m, rowl)
            float* rp = Eo + (size_t)(u.pm * 256 + rowl) * 256 + wc * 32 + 4 * fq;
#pragma unroll
            for (int bj = 0; bj < 2; ++bj)
#pragma unroll
                for (int n = 0; n < 2; ++n) *(f32x4*)(rp + bj * 128 + n * 16) = acc[ai][bj][m][n];
        EPI_END
    } };
struct SchedG3 { const unsigned char* ws; int G, c, mult;
    __device__ __forceinline__ bool next(int i, Unit& u) const { int L = i * G + c; if (L >= 256 * mult) return false; if (mult > 1) L %= 256; const int g = L >> 3; u.pm = L & 7; u.pn = 0; u.x0 = g; u.x1 = 0; u.arow = nullptr;
        u.A = (const char*)ws + WS_UCAT + ((size_t)g * UC_ROWS + (size_t)u.pm * 256) * 1024; u.B = (const char*)ws + WS_BCAT_T + (size_t)g * 256 * 1024; return true; } };
struct EpiG3 { static constexpr int PERM = 2; unsigned char* ws;
    __device__ __forceinline__ void operator()(const acc_t& acc, const Unit& u, int wr, int wc, int fr, int fq) const {
        bf16_t* ys = (bf16_t*)(ws + WS_YS); const int tau = wc * 4 + fq;
        EPI_ROWS(ai, m, rowl)
            const int crow = u.pm * 256 + rowl; float v[16];
#pragma unroll
            for (int k = 0; k < 16; ++k) v[k] = gelu_f(ACC16(ai, m, k));
            u32x4 o0, o1; o0.x = pk2(v[0], v[1]); o0.y = pk2(v[2], v[3]); o0.z = pk2(v[4], v[5]); o0.w = pk2(v[6], v[7]); o1.x = pk2(v[8], v[9]); o1.y = pk2(v[10], v[11]); o1.z = pk2(v[12], v[13]); o1.w = pk2(v[14], v[15]);
            bf16_t* dp = ys + ((size_t)crow * 16 + tau) * 512 + u.x0 * 16; *(u32x4*)dp = o0; *(u32x4*)(dp + 8) = o1;
        EPI_END
    } };
struct SchedG4 { const unsigned char* ws; int G, c, mult;
    __device__ __forceinline__ bool next(int i, Unit& u) const { int L = i * G + c; if (L >= 256 * mult) return false; if (mult > 1) L %= 256; u.pm = L >> 1; u.pn = L & 1; u.x0 = 0; u.x1 = 0; u.arow = nullptr;
        u.A = (const char*)ws + WS_YS + (size_t)u.pm * 256 * 1024; u.B = (const char*)ws + WS_WGLU_T + (size_t)u.pn * 256 * 1024; return true; } };
struct EpiG4 { static constexpr int PERM = 2; unsigned char* ws; const float* bglu;
    __device__ __forceinline__ void operator()(const acc_t& acc, const Unit& u, int wr, int wc, int fr, int fq) const {
        const int col = u.pn * 256 + wc * 64 + 16 * fq; float bb[16];
#pragma unroll
        for (int q = 0; q < 4; ++q) { const f32x4 b4 = *(const f32x4*)(bglu + col + 4 * q); bb[4 * q] = b4.x; bb[4 * q + 1] = b4.y; bb[4 * q + 2] = b4.z; bb[4 * q + 3] = b4.w; }
#pragma unroll
        for (int ai = 0; ai < 2; ++ai) {
            u32x4 y[4][2];
#pragma unroll
            for (int m = 0; m < 4; ++m) { const bf16_t* yp = (const bf16_t*)(ws + WS_YS) + ((size_t)u.pm * 256 + ai * 128 + wr * 64 + m * 16 + fr) * 512 + col; y[m][0] = *(const u32x4*)yp; y[m][1] = *(const u32x4*)(yp + 8); }
#pragma unroll
            for (int m = 0; m < 4; ++m) { float v[16];
#pragma unroll
                for (int k = 0; k < 16; ++k) { const unsigned w = y[m][k >> 3][(k >> 1) & 3]; const float yy = (k & 1) ? bfhi(w) : bflo(w); v[k] = yy * sigmoid_f(ACC16(ai, m, k) + bb[k]); }
                u32x4 o0, o1; o0.x = pk2(v[0], v[1]); o0.y = pk2(v[2], v[3]); o0.z = pk2(v[4], v[5]); o0.w = pk2(v[6], v[7]); o1.x = pk2(v[8], v[9]); o1.y = pk2(v[10], v[11]); o1.z = pk2(v[12], v[13]); o1.w = pk2(v[14], v[15]);
                bf16_t* dp = (bf16_t*)(ws + WS_YS5) + ((size_t)u.pm * 256 + ai * 128 + wr * 64 + m * 16 + fr) * 512 + col; *(u32x4*)dp = o0; *(u32x4*)(dp + 8) = o1; }
        }
    } };
struct SchedG5 { const unsigned char* ws; int G, c, mult;
    __device__ __forceinline__ bool next(int i, Unit& u) const { int tile = (i >> 1) * G + c; if (tile >= 512 * mult) return false; if (mult > 1) tile %= 512; const int which = i & 1; u.pm = tile >> 2; u.pn = tile & 3; u.x0 = which; u.x1 = 0; u.arow = nullptr;
        u.A = (const char*)ws + (which ? WS_YSGU : WS_YS5) + (size_t)u.pm * 256 * 1024; u.B = (const char*)ws + (which ? WS_WBS_T : WS_WB5_T) + (size_t)u.pn * 256 * 1024; return true; } };
struct EpiG5 { static constexpr int PERM = 2; unsigned char* ws;
    __device__ __forceinline__ void operator()(const acc_t& acc, const Unit& u, int wr, int wc, int fr, int fq) const {
        const bf16_t* gate = (const bf16_t*)(ws + (u.x0 ? WS_SGS : WS_SG5)); bf16_t* mg = (bf16_t*)(ws + WS_MERGED);
        const int col = u.pn * 256 + wc * 64 + 16 * fq;
#pragma unroll
        for (int ai = 0; ai < 2; ++ai) {
            u32x4 sg[4][2], q[4][2];
#pragma unroll
            for (int m = 0; m < 4; ++m) { const size_t off = ((size_t)u.pm * 256 + ai * 128 + wr * 64 + m * 16 + fr) * 1024 + col;
                sg[m][0] = *(const u32x4*)(gate + off); sg[m][1] = *(const u32x4*)(gate + off + 8);
                q[m][0] = u.x0 ? *(const u32x4*)(mg + off) : (u32x4){0u, 0u, 0u, 0u}; q[m][1] = u.x0 ? *(const u32x4*)(mg + off + 8) : (u32x4){0u, 0u, 0u, 0u}; }
#pragma unroll
            for (int m = 0; m < 4; ++m) { const size_t off = ((size_t)u.pm * 256 + ai * 128 + wr * 64 + m * 16 + fr) * 1024 + col; float v[16];
#pragma unroll
                for (int k = 0; k < 16; ++k) { const unsigned gw = sg[m][k >> 3][(k >> 1) & 3], qw = q[m][k >> 3][(k >> 1) & 3];
                    v[k] = ACC16(ai, m, k) * ((k & 1) ? bfhi(gw) : bflo(gw)) + ((k & 1) ? bfhi(qw) : bflo(qw)); }
                u32x4 o0, o1; o0.x = pk2(v[0], v[1]); o0.y = pk2(v[2], v[3]); o0.z = pk2(v[4], v[5]); o0.w = pk2(v[6], v[7]); o1.x = pk2(v[8], v[9]); o1.y = pk2(v[10], v[11]); o1.z = pk2(v[12], v[13]); o1.w = pk2(v[14], v[15]);
                *(u32x4*)(mg + off) = o0; *(u32x4*)(mg + off + 8) = o1; }
        }
    } };
struct SchedG6 { const unsigned char* ws; int G, c, mult;
    __device__ __forceinline__ bool next(int i, Unit& u) const { int L = i * G + c; if (L >= 512 * mult) return false; if (mult > 1) L %= 512; u.pm = L >> 2; u.pn = L & 3; u.x0 = 0; u.x1 = 0; u.arow = nullptr;
        u.A = (const char*)ws + WS_MERGED + (size_t)u.pm * 256 * 2048; u.B = (const char*)ws + WS_WOUT_T + (size_t)u.pn * 256 * 2048; return true; } };
struct EpiG6 { static constexpr int PERM = 2; unsigned char* ws;
    __device__ __forceinline__ void operator()(const acc_t& acc, const Unit& u, int wr, int wc, int fr, int fq) const {
        const int col = u.pn * 256 + wc * 64 + 16 * fq;
        EPI_ROWS(ai, m, rowl)
            const size_t row = (size_t)u.pm * 256 + rowl; float v[16]; float ssq = 0.f;
#pragma unroll
            for (int k = 0; k < 16; ++k) { v[k] = ACC16(ai, m, k); ssq += v[k] * v[k]; }
            u32x4 o0, o1; o0.x = pk2(v[0], v[1]); o0.y = pk2(v[2], v[3]); o0.z = pk2(v[4], v[5]); o0.w = pk2(v[6], v[7]); o1.x = pk2(v[8], v[9]); o1.y = pk2(v[10], v[11]); o1.z = pk2(v[12], v[13]); o1.w = pk2(v[14], v[15]);
            bf16_t* dp = (bf16_t*)(ws + WS_MX) + row * 1024 + col; *(u32x4*)dp = o0; *(u32x4*)(dp + 8) = o1;
            ssq += __shfl_xor(ssq, 16); ssq += __shfl_xor(ssq, 32); if (fq == 0) ((float*)(ws + WS_SSQM))[row * 16 + u.pn * 4 + wc] = ssq;
        EPI_END
    } };
struct SchedG7 { const unsigned char* ws; int G, c, mult;
    __device__ __forceinline__ bool next(int i, Unit& u) const { int L = i * G + c; if (L >= 128 * mult) return false; if (mult > 1) L %= 128; u.pm = L; u.pn = 0; u.x0 = 0; u.x1 = 0; u.arow = nullptr;
        u.A = (const char*)ws + WS_XN + (size_t)u.pm * 256 * 2048; u.B = (const char*)ws + WS_WR_T; return true; } };
struct EpiG7 { static constexpr int PERM = 0; unsigned char* ws;
    __device__ __forceinline__ void operator()(const acc_t& acc, const Unit& u, int wr, int wc, int fr, int fq) const {
        EPI_ROWS(ai, m, rowl)
            float* rp = (float*)(ws + WS_LOGITS) + ((size_t)u.pm * 256 + rowl) * 256 + wc * 32 + 4 * fq;
#pragma unroll
            for (int bj = 0; bj < 2; ++bj)
#pragma unroll
                for (int n = 0; n < 2; ++n) *(f32x4*)(rp + bj * 128 + n * 16) = acc[ai][bj][m][n];
        EPI_END
    } };
struct SchedG8 { const unsigned char* ws; int G, c, mult;
    __device__ __forceinline__ bool next(int i, Unit& u) const { const int* te = (const int*)(ws + WS_TILEEXP); const int ntile = te[1500]; int L = i * G + c; if (L >= ntile * 2 * mult) return false; if (mult > 1) L %= ntile * 2;
        const int t = L >> 1; u.pm = t; u.pn = L & 1; const int e = te[t]; u.x0 = e; u.x1 = 0; u.arow = (const int*)(ws + WS_TOKSLOT) + (size_t)t * 256;
        u.A = (const char*)ws + WS_XN; u.B = (const char*)ws + WS_WGU_T + ((size_t)e * 512 + (size_t)u.pn * 256) * 2048; return true; } };
struct EpiG8 { static constexpr int PERM = 1; unsigned char* ws;
    __device__ __forceinline__ void operator()(const acc_t& acc, const Unit& u, int wr, int wc, int fr, int fq) const {
        EPI_ROWS(ai, m, rowl)
            const size_t slot = (size_t)u.pm * 256 + rowl; const int col = u.pn * 128 + wc * 32 + 8 * fq;
            const f32x4 g0 = acc[ai][0][m][0], g1 = acc[ai][0][m][1], u0 = acc[ai][1][m][0], u1 = acc[ai][1][m][1]; u32x4 o;
            o.x = pk2(silu_f(g0.x) * u0.x, silu_f(g0.y) * u0.y); o.y = pk2(silu_f(g0.z) * u0.z, silu_f(g0.w) * u0.w);
            o.z = pk2(silu_f(g1.x) * u1.x, silu_f(g1.y) * u1.y); o.w = pk2(silu_f(g1.z) * u1.z, silu_f(g1.w) * u1.w);
            *(u32x4*)((bf16_t*)(ws + WS_H) + slot * 256 + col) = o;
        EPI_END
    } };
struct SchedG9 { const unsigned char* ws; int G, c, mult;
    __device__ __forceinline__ bool next(int i, Unit& u) const { const int* te = (const int*)(ws + WS_TILEEXP); const int ntr = te[1500] - 128; int L = i * G + c; if (L >= ntr * 4 * mult) return false; if (mult > 1) L %= ntr * 4;
        const int t = L >> 2; u.pm = t; u.pn = L & 3; const int e = te[t]; u.x0 = e; u.x1 = 0; u.arow = nullptr;
        u.A = (const char*)ws + WS_H + (size_t)t * 256 * 512; u.B = (const char*)ws + WS_WD_T + ((size_t)e * 1024 + (size_t)u.pn * 256) * 512; return true; } };
__device__ __forceinline__ unsigned pk_fp8x4(f32x4 v) {
    const float a = __builtin_amdgcn_fmed3f(v.x * 8.f, -448.f, 448.f), b = __builtin_amdgcn_fmed3f(v.y * 8.f, -448.f, 448.f), c = __builtin_amdgcn_fmed3f(v.z * 8.f, -448.f, 448.f), d = __builtin_amdgcn_fmed3f(v.w * 8.f, -448.f, 448.f);
    int w = 0; w = __builtin_amdgcn_cvt_pk_fp8_f32(a, b, w, false); w = __builtin_amdgcn_cvt_pk_fp8_f32(c, d, w, true); return (unsigned)w; }
struct EpiG9 { static constexpr int PERM = 2; unsigned char* ws;
    __device__ __forceinline__ void operator()(const acc_t& acc, const Unit& u, int wr, int wc, int fr, int fq) const {
        EPI_ROWS(ai, m, rowl)
            const size_t slot = (size_t)u.pm * 256 + rowl;
            u32x4 o; o.x = pk_fp8x4(acc[ai][0][m][0]); o.y = pk_fp8x4(acc[ai][0][m][1]); o.z = pk_fp8x4(acc[ai][1][m][0]); o.w = pk_fp8x4(acc[ai][1][m][1]);
            *(u32x4*)(ws + WS_YSLOT + slot * 1024 + u.pn * 256 + wc * 64 + 16 * fq) = o;
        EPI_END
    } };
struct SchedG10 { const unsigned char* ws; int G, c, mult;
    __device__ __forceinline__ bool next(int i, Unit& u) const { const int* te = (const int*)(ws + WS_TILEEXP); const int ntr = te[1500] - 128; int L = i * G + c; if (L >= 512 * mult) return false; if (mult > 1) L %= 512;
        const int t = L >> 2; u.pm = t; u.pn = L & 3; u.x0 = ntr; u.x1 = 0; u.arow = nullptr;
        u.A = (const char*)ws + WS_H + (size_t)(ntr + t) * 256 * 512; u.B = (const char*)ws + WS_WD_T + ((size_t)NEXP * 1024 + (size_t)u.pn * 256) * 512; return true; } };
struct EpiG10 { static constexpr int PERM = 2; unsigned char* ws;
    __device__ __forceinline__ void operator()(const acc_t& acc, const Unit& u, int wr, int wc, int fr, int fq) const {
        EPI_ROWS(ai, m, rowl)
            bf16_t* dp = (bf16_t*)(ws + WS_MERGED) + ((size_t)u.pm * 256 + rowl) * 1024 + u.pn * 256 + wc * 64 + 16 * fq;
#pragma unroll
            for (int bj = 0; bj < 2; ++bj) { const f32x4 v0 = acc[ai][bj][m][0], v1 = acc[ai][bj][m][1]; u32x4 o;
                o.x = pk2(v0.x, v0.y); o.y = pk2(v0.z, v0.w); o.z = pk2(v1.x, v1.y); o.w = pk2(v1.z, v1.w); *(u32x4*)(dp + bj * 8) = o; }
        EPI_END
    } };

__device__ __forceinline__ void phase_sgu(const Params& p, ldsp_t lds) {
    const int tid = threadIdx.x, lane = tid & 63, wave = tid >> 6, fr = lane & 15, fq = lane >> 4, G = gridDim.x;
    constexpr int PITCH = 272;
    ldsp_t Wl = lds; ldsp_t VT = lds + 128 * PITCH; LAS float* rs = (LAS float*)(lds + 128 * PITCH + 64 * PITCH);
    const bf16_t* sguw = (const bf16_t*)(p.ws + WS_SGUW); const bf16_t* gv = (const bf16_t*)(p.ws + WS_GV); const bf16_t* gu = (const bf16_t*)(p.ws + WS_GU);
    const float* ssq = (const float*)(p.ws + WS_SSQV); const float* gn = p.in[21]; const float* bs = p.in[23];
    bf16_t* yo = (bf16_t*)(p.ws + WS_YSGU);
    for (int it = blockIdx.x; it < 2048; it += G) {
        const int chunk = it & 255, h = it >> 8; const size_t tok0 = (size_t)chunk * 128;
        __syncthreads();
        if (tid < 128) { const float* q = ssq + (tok0 + tid) * 8; const f32x4 a = *(const f32x4*)q, b = *(const f32x4*)(q + 4);
            rs[tid] = rsqrtf(((a.x + a.y) + (a.z + a.w) + (b.x + b.y) + (b.z + b.w)) * (1.0f / 512.0f) + EPS); }
#pragma unroll
        for (int i = 0; i < 4; ++i) { const int pc = tid + i * NT, row = pc >> 4, cp = pc & 15;
            *(LAS u32x4*)(Wl + row * PITCH + cp * 16) = *(const u32x4*)(sguw + ((size_t)h * 128 + row) * 128 + cp * 8); }
        __syncthreads();
#pragma unroll
        for (int i = 0; i < 2; ++i) { const int pc = tid + i * NT, s = pc >> 3, c8 = (pc & 7) * 8; const float r = rs[s];
            const u32x4 v = *(const u32x4*)(gv + (tok0 + s) * 512 + h * 64 + c8);
            LAS bf16_t* d = (LAS bf16_t*)(VT + c8 * PITCH + s * 2);
            d[0 * (PITCH / 2)] = (bf16_t)f2bf(bflo(v.x) * r); d[1 * (PITCH / 2)] = (bf16_t)f2bf(bfhi(v.x) * r); d[2 * (PITCH / 2)] = (bf16_t)f2bf(bflo(v.y) * r); d[3 * (PITCH / 2)] = (bf16_t)f2bf(bfhi(v.y) * r);
            d[4 * (PITCH / 2)] = (bf16_t)f2bf(bflo(v.z) * r); d[5 * (PITCH / 2)] = (bf16_t)f2bf(bfhi(v.z) * r); d[6 * (PITCH / 2)] = (bf16_t)f2bf(bflo(v.w) * r); d[7 * (PITCH / 2)] = (bf16_t)f2bf(bfhi(v.w) * r); }
        __syncthreads();
        f32x4 acc[4] = {(f32x4){0.f, 0.f, 0.f, 0.f}, (f32x4){0.f, 0.f, 0.f, 0.f}, (f32x4){0.f, 0.f, 0.f, 0.f}, (f32x4){0.f, 0.f, 0.f, 0.f}};
        const int t0 = wave * 16;
#pragma unroll
        for (int ks = 0; ks < 4; ++ks) {
            const bf16x8 bfr = *(const LAS bf16x8*)(Wl + (t0 + fr) * PITCH + (ks * 32 + 8 * fq) * 2);
#pragma unroll
            for (int mb = 0; mb < 4; ++mb) { const bf16x8 afr = *(const LAS bf16x8*)(VT + (mb * 16 + fr) * PITCH + (ks * 32 + 8 * fq) * 2);
                acc[mb] = __builtin_amdgcn_mfma_f32_16x16x32_bf16(afr, bfr, acc[mb], 0, 0, 0); }
        }
        const int t = t0 + fr; const float bt = bs[h * 128 + t];
#pragma unroll
        for (int mb = 0; mb < 4; ++mb) { const int c = h * 64 + mb * 16 + 4 * fq; const f32x4 gg = *(const f32x4*)(gn + c);
            const u32x2 uu = *(const u32x2*)(gu + (tok0 + t) * 512 + c); u32x2 o;
            o.x = pk2(bflo(uu.x) * (acc[mb].x * gg.x + bt), bfhi(uu.x) * (acc[mb].y * gg.y + bt)); o.y = pk2(bflo(uu.y) * (acc[mb].z * gg.z + bt), bfhi(uu.y) * (acc[mb].w * gg.w + bt));
            *(u32x2*)(yo + (tok0 + t) * 512 + c) = o; }
    }
    __syncthreads();
}

__device__ __forceinline__ size_t carry_row(int b, int d, int q) { return (q < 16) ? (size_t)(2048 + b * 16 + (d ? 15 - q : q)) : (size_t)(b * 512 + (d ? 511 - (q - 16) : (q - 16))); }
__device__ __forceinline__ void phase_carry(const Params& p, ldsp_t lds) {
    const int tid = threadIdx.x, lane = tid & 63, wave = tid >> 6, G = gridDim.x;
    const float* APL = (const float*)(p.ws + WS_APL);
    LAS f32x2* seg = (LAS f32x2*)lds;
    LAS float* ectx = (LAS float*)(lds + 4096);
    for (int s = blockIdx.x; s < 256; s += G) {
        const int d = s & 1, g = (s >> 1) & 31, b = s >> 6;
        const float ar = APL[((d * 32 + g) * 64 + lane) * 2], ai = APL[((d * 32 + g) * 64 + lane) * 2 + 1];
        const float* Eg = (const float*)(p.ws + WS_E) + (size_t)g * UC_ROWS * 256 + d * 128 + lane;
        bf16_t* Ug = (bf16_t*)(p.ws + WS_UCAT) + (size_t)g * UC_ROWS * 512 + 256 + d * 128 + lane;
        const int q0 = wave * 66;
        __syncthreads();
        { const int fr = lane & 15, fq = lane >> 4; f32x4 acc = (f32x4){0.f, 0.f, 0.f, 0.f};
          const bf16_t* ua = (const bf16_t*)(p.ws + WS_UCAT) + ((size_t)g * UC_ROWS + 2048 + b * 16 + fr) * 512 + 8 * fq;
          const bf16_t* wb = (const bf16_t*)(p.ws + WS_WEND_T) + ((size_t)g * 256 + d * 128 + 16 * wave + fr) * 256 + 8 * fq;
          bf16x8 af[8], bfv[8];
#pragma unroll
          for (int ks = 0; ks < 8; ++ks) { af[ks] = *(const bf16x8*)(ua + ks * 32); bfv[ks] = *(const bf16x8*)(wb + ks * 32); }
#pragma unroll
          for (int ks = 0; ks < 8; ++ks) acc = __builtin_amdgcn_mfma_f32_16x16x32_bf16(af[ks], bfv[ks], acc, 0, 0, 0);
#pragma unroll
          for (int r = 0; r < 4; ++r) ectx[(4 * fq + r) * 128 + 16 * wave + fr] = acc[r]; }
        __syncthreads();
        float cr = 0.f, ci = 0.f;
#pragma unroll 1
        for (int j0 = 0; j0 < 66; j0 += 11) {
            float er[11], ei[11];
#pragma unroll
            for (int j = 0; j < 11; ++j) { const int q = q0 + j0 + j; if (q < 16) { const int cc = d ? 15 - q : q; er[j] = ectx[cc * 128 + lane]; ei[j] = ectx[cc * 128 + 64 + lane]; } else { const size_t row = carry_row(b, d, q); er[j] = Eg[row * 256]; ei[j] = Eg[row * 256 + 64]; } }
#pragma unroll
            for (int j = 0; j < 11; ++j) { const float nr = ar * cr - ai * ci + er[j], ni = ar * ci + ai * cr + ei[j]; cr = nr; ci = ni; }
        }
        __syncthreads();
        seg[wave * 64 + lane] = (f32x2){cr, ci};
        __syncthreads();
        float p2r = ar * ar - ai * ai, p2i = 2.f * ar * ai, pr = p2r, pi = p2i;
#pragma unroll
        for (int k = 0; k < 5; ++k) { const float nr = pr * pr - pi * pi, ni = 2.f * pr * pi; pr = nr; pi = ni; }
        const float Ar = pr * p2r - pi * p2i, Ai = pr * p2i + pi * p2r;
        cr = 0.f; ci = 0.f;
        for (int w = 0; w < wave; ++w) { const f32x2 e = seg[w * 64 + lane]; const float nr = Ar * cr - Ai * ci + e.x, ni = Ar * ci + Ai * cr + e.y; cr = nr; ci = ni; }
#pragma unroll 1
        for (int j0 = 0; j0 < 66; j0 += 11) {
            float er[11], ei[11];
#pragma unroll
            for (int j = 0; j < 11; ++j) { const int q = q0 + j0 + j; if (q < 16) { const int cc = d ? 15 - q : q; er[j] = ectx[cc * 128 + lane]; ei[j] = ectx[cc * 128 + 64 + lane]; } else { const size_t row = carry_row(b, d, q); er[j] = Eg[row * 256]; ei[j] = Eg[row * 256 + 64]; } }
#pragma unroll
            for (int j = 0; j < 11; ++j) { const int q = q0 + j0 + j;
                if (q >= 16) { const size_t row = carry_row(b, d, q); Ug[row * 512] = (bf16_t)f2bf(cr); Ug[row * 512 + 64] = (bf16_t)f2bf(ci); }
                const float nr = ar * cr - ai * ci + er[j], ni = ar * ci + ai * cr + ei[j]; cr = nr; ci = ni; }
        }
    }
    __syncthreads();
}

__device__ __forceinline__ void phase_r1(const Params& p) {
    const int tid = threadIdx.x, lane = tid & 63, wave = tid >> 6, G = gridDim.x;
    const float* mod = (const float*)(p.ws + WS_MOD); const float* gpm = p.in[7]; const float* gpf = p.in[8];
    for (int row = blockIdx.x * 8 + wave; row < NTOK; row += G * 8) {
        const float* mb = mod + (size_t)(row >> 13) * 6144;
        f32x4 xv[4], gt[4], gg[4]; u32x2 mv[4];
#pragma unroll
        for (int j = 0; j < 4; ++j) { const int c = 4 * lane + 256 * j; xv[j] = __builtin_nontemporal_load((const f32x4*)(p.in[0] + (size_t)row * DM + c));
            mv[j] = *(const u32x2*)((const bf16_t*)(p.ws + WS_MX) + (size_t)row * DM + c); gt[j] = *(const f32x4*)(mb + 2048 + c); gg[j] = *(const f32x4*)(gpm + c); }
        const float* sq = (const float*)(p.ws + WS_SSQM) + (size_t)row * 16; float s0 = 0.f;
#pragma unroll
        for (int j = 0; j < 4; ++j) { const f32x4 qq = *(const f32x4*)(sq + 4 * j); s0 += (qq.x + qq.y) + (qq.z + qq.w); }
        const float rm = rsqrtf(s0 * (1.0f / DM) + EPS);
        float s = 0.f;
#pragma unroll
        for (int j = 0; j < 4; ++j) { f32x4 x1;
            x1.x = xv[j].x + gt[j].x * (bflo(mv[j].x) * rm * gg[j].x); x1.y = xv[j].y + gt[j].y * (bfhi(mv[j].x) * rm * gg[j].y);
            x1.z = xv[j].z + gt[j].z * (bflo(mv[j].y) * rm * gg[j].z); x1.w = xv[j].w + gt[j].w * (bfhi(mv[j].y) * rm * gg[j].w);
            xv[j] = x1; s += (x1.x * x1.x + x1.y * x1.y) + (x1.z * x1.z + x1.w * x1.w); }
#pragma unroll
        for (int j = 0; j < 4; ++j) { const int c = 4 * lane + 256 * j; gg[j] = *(const f32x4*)(gpf + c); gt[j] = *(const f32x4*)(mb + 3072 + c); }
        f32x4 sc[4];
#pragma unroll
        for (int j = 0; j < 4; ++j) sc[j] = *(const f32x4*)(mb + 4096 + 4 * lane + 256 * j);
        const float r1 = rsqrtf(wave_sum(s) * (1.0f / DM) + EPS);
        u32x2 ov[4];
#pragma unroll
        for (int j = 0; j < 4; ++j) { ov[j].x = pk2(xv[j].x * r1 * gg[j].x * (1.f + sc[j].x) + gt[j].x, xv[j].y * r1 * gg[j].y * (1.f + sc[j].y) + gt[j].y);
            ov[j].y = pk2(xv[j].z * r1 * gg[j].z * (1.f + sc[j].z) + gt[j].z, xv[j].w * r1 * gg[j].w * (1.f + sc[j].w) + gt[j].w); }
        bf16_t* dst = (bf16_t*)(p.ws + WS_XN) + (size_t)row * DM;
#pragma unroll
        for (int j = 0; j < 4; ++j) *(u32x2*)(dst + 4 * lane + 256 * j) = ov[j];
    }
}

__device__ __forceinline__ void phase_route(const Params& p, ldsp_t lds) {
    const int tid = threadIdx.x, lane = tid & 63, wave = tid >> 6, G = gridDim.x, g = lane & 7;
    LAS int* hist = (LAS int*)lds;
    float bs[32];
    { const float* rb = p.in[28] + g * 32;
#pragma unroll
      for (int i = 0; i < 8; ++i) { const f32x4 b4 = *(const f32x4*)(rb + 4 * i); bs[4 * i] = b4.x; bs[4 * i + 1] = b4.y; bs[4 * i + 2] = b4.z; bs[4 * i + 3] = b4.w; } }
    const float NINF = -__builtin_inff();
    for (int tile = blockIdx.x; tile < 256; tile += G) {
        __syncthreads();
        if (tid < 256) hist[tid] = 0;
        __syncthreads();
#pragma unroll 1
        for (int pass = 0; pass < 2; ++pass) {
            const int row = tile * 128 + wave * 16 + pass * 8 + (lane >> 3);
            const float* lp = (const float*)(p.ws + WS_LOGITS) + (size_t)row * 256 + g * 32;
            float sc[32], sel[32];
#pragma unroll
            for (int i = 0; i < 8; ++i) { const f32x4 l4 = *(const f32x4*)(lp + 4 * i);
                sc[4 * i] = sigmoid_f(l4.x); sc[4 * i + 1] = sigmoid_f(l4.y); sc[4 * i + 2] = sigmoid_f(l4.z); sc[4 * i + 3] = sigmoid_f(l4.w); }
            float m1 = NINF, m2 = NINF;
#pragma unroll
            for (int i = 0; i < 32; ++i) { sel[i] = sc[i] + bs[i]; m2 = fmaxf(m2, fminf(m1, sel[i])); m1 = fmaxf(m1, sel[i]); }
            const float gs = m1 + m2; int rank = 0;
#pragma unroll
            for (int m = 1; m < 8; ++m) { const float o = __shfl_xor(gs, m); const int og = g ^ m; rank += (o > gs || (o == gs && og < g)) ? 1 : 0; }
            const bool gsel = rank < 4;
            float wsum = 0.f, myW = 0.f; int myE = 0, rem = -1;
#pragma unroll
            for (int k = 0; k < 8; ++k) {
                float bv = NINF, bsc = 0.f; int bi = 0;
#pragma unroll
                for (int i = 0; i < 32; ++i) { if (k > 0) sel[i] = (i == rem) ? NINF : sel[i]; const bool gt = sel[i] > bv; bv = gt ? sel[i] : bv; bi = gt ? i : bi; bsc = gt ? sc[i] : bsc; }
                if (!gsel) bv = NINF;
                float v = bv; int e = g * 32 + bi;
#pragma unroll
                for (int m = 1; m < 8; m <<= 1) { const float ov = __shfl_xor(v, m); const int oe = __shfl_xor(e, m); const bool tk = (ov > v) || (ov == v && oe < e); v = tk ? ov : v; e = tk ? oe : e; }
                const float s_w = __shfl(bsc, (lane & ~7) | (e >> 5));
                rem = ((e >> 5) == g) ? (e & 31) : -1;
                wsum += s_w; if (g == k) { myW = s_w; myE = e; }
            }
            const float w = myW / wsum * 2.5f;
            ((int*)(p.ws + WS_IDX))[(size_t)row * 8 + g] = myE; ((float*)(p.ws + WS_WT))[(size_t)row * 8 + g] = w;
            __hip_atomic_fetch_add(&hist[myE], 1, __ATOMIC_RELAXED, __HIP_MEMORY_SCOPE_WORKGROUP);
        }
        __syncthreads();
        if (tid < 256) ((int*)(p.ws + WS_BLKCNT))[tile * 256 + tid] = hist[tid];
    }
    __syncthreads();
}
__device__ __forceinline__ void phase_scan(const Params& p, ldsp_t lds) {
    const int tid = threadIdx.x, G = gridDim.x; LAS int* sm = (LAS int*)lds;
    for (int e = blockIdx.x; e < 256; e += G) {
        __syncthreads();
        int v = 0; if (tid < 256) { v = ((const int*)(p.ws + WS_BLKCNT))[tid * 256 + e]; sm[tid] = v; }
        __syncthreads();
        for (int o = 1; o < 256; o <<= 1) { int t = 0; if (tid < 256 && tid >= o) t = sm[tid - o]; __syncthreads(); if (tid < 256) sm[tid] += t; __syncthreads(); }
        if (tid < 256) { ((int*)(p.ws + WS_BLKOFF))[tid * 256 + e] = sm[tid] - v; if (tid == 255) ((int*)(p.ws + WS_TOTAL))[e] = sm[255]; }
    }
    __syncthreads();
}
__device__ __forceinline__ void phase_scatter(const Params& p, ldsp_t lds) {
    const int tid = threadIdx.x, G = gridDim.x; LAS int* pst = (LAS int*)lds; LAS int* cnt = (LAS int*)(lds + 2048); LAS int* tot = (LAS int*)(lds + 4096);
    int* tokslot = (int*)(p.ws + WS_TOKSLOT); float* wslot = (float*)(p.ws + WS_WSLOT); int* te = (int*)(p.ws + WS_TILEEXP);
    int mytot = 0, mypad = 0;
    if (tid < 256) { mytot = ((const int*)(p.ws + WS_TOTAL))[tid]; mypad = (mytot + 255) & ~255; pst[tid] = mypad; tot[tid] = mytot; }
    __syncthreads();
    for (int o = 1; o < 256; o <<= 1) { int t = 0; if (tid < 256 && tid >= o) t = pst[tid - o]; __syncthreads(); if (tid < 256) pst[tid] += t; __syncthreads(); }
    const int pend_all = pst[255];
    __syncthreads();
    if (tid < 256) pst[tid] -= mypad;
    __syncthreads();
    const int ntr = pend_all >> 8;
    if (blockIdx.x == 0 && tid == 0) te[1500] = ntr + 128;
    for (int e = blockIdx.x; e < 256; e += G) { const int s0 = pst[e], n = tot[e], pe = s0 + ((n + 255) & ~255);
        for (int t = (s0 >> 8) + tid; t < (pe >> 8); t += NT) te[t] = e;
        for (int s = s0 + n + tid; s < pe; s += NT) { tokslot[s] = 0; wslot[s] = 0.f; } }
    for (int t = blockIdx.x * NT + tid; t < NTOK; t += G * NT) { tokslot[pend_all + t] = t; wslot[pend_all + t] = 1.0f; if (t < 128) te[ntr + t] = NEXP; }
    for (int tile = blockIdx.x; tile < 256; tile += G) {
        __syncthreads();
        if (tid < 256) cnt[tid] = 0;
        __syncthreads();
        for (int q = tid; q < 1024; q += NT) { const int row = tile * 128 + (q >> 3), k = q & 7; const int e = ((const int*)(p.ws + WS_IDX))[(size_t)row * 8 + k];
            const int r = __hip_atomic_fetch_add(&cnt[e], 1, __ATOMIC_RELAXED, __HIP_MEMORY_SCOPE_WORKGROUP); const int slot = pst[e] + ((const int*)(p.ws + WS_BLKOFF))[tile * 256 + e] + r;
            tokslot[slot] = row; wslot[slot] = ((const float*)(p.ws + WS_WT))[(size_t)row * 8 + k]; ((int*)(p.ws + WS_SLOT))[(size_t)row * 8 + k] = slot; }
    }
    __syncthreads();
}

__device__ __forceinline__ void phase_r3(const Params& p) {
    const int tid = threadIdx.x, lane = tid & 63, wave = __builtin_amdgcn_readfirstlane(tid >> 6), G = gridDim.x;
    const unsigned char* ys = p.ws + WS_YSLOT + 16 * lane; const float* mod = (const float*)(p.ws + WS_MOD); const float* gpm = p.in[7] + 16 * lane; const float* gpo = p.in[9] + 16 * lane;
    int row = blockIdx.x * 8 + wave;
    int slv[8]; float wtv[8];
    if (row < NTOK) {
#pragma unroll
        for (int k = 0; k < 8; ++k) { slv[k] = ((const int*)(p.ws + WS_SLOT))[(size_t)row * 8 + k]; wtv[k] = ((const float*)(p.ws + WS_WT))[(size_t)row * 8 + k]; } }
    for (; row < NTOK; row += G * 8) {
        const float* xrow = p.in[0] + (size_t)row * DM + 16 * lane; float* orow = p.out + (size_t)row * DM + 16 * lane; const bf16_t* mrow = (const bf16_t*)(p.ws + WS_MX) + (size_t)row * DM + 16 * lane;
        u32x4 yv[8]; f32x4 f[4], xa[4]; float wk[8];
#pragma unroll
        for (int k = 0; k < 8; ++k) { yv[k] = __builtin_nontemporal_load((const u32x4*)(ys + (size_t)slv[k] * 1024)); wk[k] = wtv[k] * 0.125f; }
#pragma unroll
        for (int j = 0; j < 4; ++j) xa[j] = *(const f32x4*)(xrow + 4 * j);
        { const bf16_t* frow = (const bf16_t*)(p.ws + WS_MERGED) + (size_t)row * DM + 16 * lane;
          const u32x4 h0 = *(const u32x4*)frow, h1 = *(const u32x4*)(frow + 8);
          f[0] = (f32x4){bflo(h0.x), bfhi(h0.x), bflo(h0.y), bfhi(h0.y)}; f[1] = (f32x4){bflo(h0.z), bfhi(h0.z), bflo(h0.w), bfhi(h0.w)};
          f[2] = (f32x4){bflo(h1.x), bfhi(h1.x), bflo(h1.y), bfhi(h1.y)}; f[3] = (f32x4){bflo(h1.z), bfhi(h1.z), bflo(h1.w), bfhi(h1.w)}; }
        const u32x4 m0 = *(const u32x4*)mrow, m1 = *(const u32x4*)(mrow + 8);
        const float* sq = (const float*)(p.ws + WS_SSQM) + (size_t)row * 16;
        const f32x4 q0 = *(const f32x4*)sq, q1 = *(const f32x4*)(sq + 4), q2 = *(const f32x4*)(sq + 8), q3 = *(const f32x4*)(sq + 12);
        { const int nrow = row + G * 8;
          if (nrow < NTOK) {
#pragma unroll
              for (int k = 0; k < 8; ++k) { slv[k] = ((const int*)(p.ws + WS_SLOT))[(size_t)nrow * 8 + k]; wtv[k] = ((const float*)(p.ws + WS_WT))[(size_t)nrow * 8 + k]; } } }
#pragma unroll
        for (int k = 0; k < 8; ++k) { const float w = wk[k];
#pragma unroll
            for (int j = 0; j < 4; ++j) { const int wd = (int)yv[k][j]; const f32x2 lo = __builtin_amdgcn_cvt_pk_f32_fp8(wd, false), hi = __builtin_amdgcn_cvt_pk_f32_fp8(wd, true);
                f[j].x += w * lo.x; f[j].y += w * lo.y; f[j].z += w * hi.x; f[j].w += w * hi.y; } }
        float s = 0.f;
#pragma unroll
        for (int j = 0; j < 4; ++j) s += (f[j].x * f[j].x + f[j].y * f[j].y) + (f[j].z * f[j].z + f[j].w * f[j].w);
        const float rf = rsqrtf(wave_sum(s) * (1.0f / DM) + EPS);
        const float rm = rsqrtf((((q0.x + q0.y) + (q0.z + q0.w)) + ((q1.x + q1.y) + (q1.z + q1.w)) + ((q2.x + q2.y) + (q2.z + q2.w)) + ((q3.x + q3.y) + (q3.z + q3.w))) * (1.0f / DM) + EPS);
        const float* mb = mod + (size_t)(row >> 13) * 6144 + 16 * lane;
        const unsigned mw[8] = {m0.x, m0.y, m0.z, m0.w, m1.x, m1.y, m1.z, m1.w};
        f32x4 gma[4], gfa[4], pma[4], poa[4], oa[4];
#pragma unroll
        for (int j = 0; j < 4; ++j) { gma[j] = *(const f32x4*)(mb + 2048 + 4 * j); gfa[j] = *(const f32x4*)(mb + 5120 + 4 * j); pma[j] = *(const f32x4*)(gpm + 4 * j); poa[j] = *(const f32x4*)(gpo + 4 * j); }
#pragma unroll
        for (int j = 0; j < 4; ++j) {
            oa[j].x = xa[j].x + gma[j].x * (bflo(mw[2 * j]) * rm * pma[j].x) + gfa[j].x * (f[j].x * rf * poa[j].x); oa[j].y = xa[j].y + gma[j].y * (bfhi(mw[2 * j]) * rm * pma[j].y) + gfa[j].y * (f[j].y * rf * poa[j].y);
            oa[j].z = xa[j].z + gma[j].z * (bflo(mw[2 * j + 1]) * rm * pma[j].z) + gfa[j].z * (f[j].z * rf * poa[j].z); oa[j].w = xa[j].w + gma[j].w * (bfhi(mw[2 * j + 1]) * rm * pma[j].w) + gfa[j].w * (f[j].w * rf * poa[j].w); }
#pragma unroll
        for (int j = 0; j < 4; ++j) *(f32x4*)(orow + 4 * j) = oa[j];
    }
}

#define XB_TMO      128
#define XB_XCNT(j)  (256  + 64 * (j))
#define XB_XSUB(j)  (1280 + 64 * (j))
#define XB_XGEN(j)  (2304 + 64 * (j))
#define XB_TOP      3328
#define XB_TOPGEN   3392
#define XCD_BAR_WORDS 3456
#define XB_SPIN_CAP (1u << 18)
__device__ __forceinline__ unsigned xb_ld(unsigned* p)              { return __hip_atomic_load(p, __ATOMIC_RELAXED, __HIP_MEMORY_SCOPE_AGENT); }
__device__ __forceinline__ unsigned xb_add(unsigned* p, unsigned v) { return __hip_atomic_fetch_add(p, v, __ATOMIC_RELAXED, __HIP_MEMORY_SCOPE_AGENT); }
__device__ __forceinline__ unsigned xb_xcc_id() { return (unsigned)__builtin_amdgcn_s_getreg((3 << 11) | 20) & 0xFu; }
#define XB_SPIN(cond, bar) do { unsigned _sp = 0; while (cond) { __builtin_amdgcn_s_sleep(1); \
    if ((++_sp & 255u) == 0u) { if (xb_ld(&(bar)[XB_TMO])) break; if (_sp > XB_SPIN_CAP) { atomicAdd(&(bar)[XB_TMO], 1u); break; } } } } while (0)
struct XcdBarrier { unsigned* bar; unsigned x; volatile LAS unsigned* st; };
__device__ __forceinline__ XcdBarrier xcd_barrier_post(unsigned* bar, volatile LAS unsigned* st) {
    XcdBarrier b; b.bar = bar; b.x = xb_xcc_id(); b.st = st;
    if (threadIdx.x == 0) (void)xb_add(&bar[XB_XCNT(b.x)], 1u);
    return b;
}
__device__ __forceinline__ void xcd_barrier_complete(unsigned* bar, unsigned x, unsigned& nloc, unsigned& nx) {
    const unsigned G = gridDim.x * gridDim.y * gridDim.z;
    unsigned sum, cnt, mine, sp = 0u;
    for (;;) {
        sum = 0u; cnt = 0u; mine = 0u;
#pragma unroll
        for (unsigned j = 0; j < 16; ++j) { const unsigned c = xb_ld(&bar[XB_XCNT(j)]); sum += c; cnt += (c > 0u) ? 1u : 0u; mine = (j == x) ? c : mine; }
        if (sum == G) break;
        __builtin_amdgcn_s_sleep(1);
        if ((++sp & 255u) == 0u) { if (xb_ld(&bar[XB_TMO])) break; if (sp > XB_SPIN_CAP) { atomicAdd(&bar[XB_TMO], 1u); break; } }
    }
    nloc = mine > 0u ? mine : 1u; nx = cnt > 0u ? cnt : 1u;
}
__device__ __forceinline__ void xcd_barrier(const XcdBarrier& b) {
    asm volatile("s_waitcnt vmcnt(0)" ::: "memory");
    __syncthreads();
    if (threadIdx.x == 0) {
        unsigned* bar = b.bar;
        __builtin_amdgcn_s_waitcnt(0);
        unsigned nloc = b.st[0], nx = b.st[1];
        if (nloc == 0u) { xcd_barrier_complete(bar, b.x, nloc, nx); b.st[0] = nloc; b.st[1] = nx; }
        const unsigned old = xb_add(&bar[XB_XSUB(b.x)], 1u);
        const unsigned gen = old / nloc;
        if (old + 1u == (gen + 1u) * nloc) {
            __builtin_amdgcn_fence(__ATOMIC_RELEASE, "agent");
            asm volatile("s_waitcnt vmcnt(0)" ::: "memory");
            const unsigned og = xb_add(&bar[XB_TOP], 1u);
            const unsigned tg = og / nx;
            if (og + 1u == (tg + 1u) * nx) xb_add(&bar[XB_TOPGEN], 1u);
            else XB_SPIN(xb_ld(&bar[XB_TOPGEN]) == tg, bar);
            __builtin_amdgcn_fence(__ATOMIC_ACQUIRE, "agent");
            xb_add(&bar[XB_XGEN(b.x)], 1u);
            asm volatile("s_waitcnt vmcnt(0)" ::: "memory");
        } else {
            XB_SPIN(xb_ld(&bar[XB_XGEN(b.x)]) == gen, bar);
            __builtin_amdgcn_fence(__ATOMIC_ACQUIRE, "agent");
            asm volatile("s_waitcnt vmcnt(0)" ::: "memory");
        }
    }
    __syncthreads();
}

constexpr int N_PHASES = 17;
__global__ void __launch_bounds__(NT, 2) fwd_kernel(Params p) {
    extern __shared__ __attribute__((aligned(16))) unsigned char lds_raw[];
    ldsp_t lds = (ldsp_t)lds_raw;
    const int G = gridDim.x, c = (G % 8 == 0) ? (int)(blockIdx.x % 8) * (G / 8) + (int)(blockIdx.x / 8) : (int)blockIdx.x;
    const int lo = p.ph_lo, hi = p.ph_hi;
    volatile LAS unsigned* bst = (volatile LAS unsigned*)(lds + LDS_BYTES - 16);
    if (threadIdx.x < 4) bst[threadIdx.x] = 0u;
    __syncthreads();
    XcdBarrier bar = xcd_barrier_post((unsigned*)p.ws, bst);
    unsigned long long spin_acc = 0;
#ifdef ONLY_PHASE
#define IN(k) ((k) == ONLY_PHASE && lo <= (k) && (k) < hi)
#else
#define IN(k) (lo <= (k) && (k) < hi)
#endif
#define TS_BEGIN(k) unsigned long long ts0_ = 0; if (SPIN_PHASE == (k)) ts0_ = __builtin_amdgcn_s_memrealtime();
#define TS_END(k) if (SPIN_PHASE == (k)) spin_acc += __builtin_amdgcn_s_memrealtime() - ts0_;
#define PH(k, ...) if (IN(k)) { TS_BEGIN(k) const int nrep_ = (DUP_PHASE == (k)) ? (1 + DUP_REPS + lo) : 1; _Pragma("nounroll") for (int r_ = 0; r_ < nrep_; ++r_) { if (r_) xcd_barrier(bar); __VA_ARGS__ } SEAM(k); TS_END(k) }
#define PG(k, ...) if (IN(k)) { TS_BEGIN(k) __VA_ARGS__ SEAM(k); TS_END(k) }
#define MULT(k) ((DUP_PHASE == (k)) ? (1 + DUP_REPS) : 1)
#define SEAM(k) do { if (IN((k) + 1)) { if ((k) == 0 && lo < 0) cg::this_grid().sync(); else xcd_barrier(bar); } } while (0)
    PH(0, phase_prep(p, lds);)
    PH(1, phase_xn(p, lds);)
    PG(2, SchedG1 S{p.ws, G, c, MULT(2)}; EpiG1 E{p.ws}; pg8::gemm_phase<EpiG1, SchedG1, false>(lds, 1024, 2048u, 2048u, S, E);)
    PG(3, SchedG2 S{p.ws, G, c, MULT(3)}; EpiG2 E{p.ws}; pg8::gemm_phase<EpiG2, SchedG2, false>(lds, 256, 1024u, 512u, S, E);)
    PH(4, if (r_ == 0 || DUP_SUB != 1) phase_carry(p, lds); if (r_ == 0 || DUP_SUB != 0) phase_sgu(p, lds);)
    PG(5, SchedG3 S{p.ws, G, c, MULT(5)}; EpiG3 E{p.ws}; pg8::gemm_phase<EpiG3, SchedG3, false>(lds, 512, 1024u, 1024u, S, E);)
    PG(6, SchedG4 S{p.ws, G, c, MULT(6)}; EpiG4 E{p.ws, p.in[20]}; pg8::gemm_phase<EpiG4, SchedG4, false>(lds, 512, 1024u, 1024u, S, E);)
    PG(7, SchedG5 S{p.ws, G, c, MULT(7)}; EpiG5 E{p.ws}; pg8::gemm_phase<EpiG5, SchedG5, false>(lds, 512, 1024u, 1024u, S, E);)
    PG(8, SchedG6 S{p.ws, G, c, MULT(8)}; EpiG6 E{p.ws}; pg8::gemm_phase<EpiG6, SchedG6, false>(lds, 1024, 2048u, 2048u, S, E);)
    PH(9, phase_r1(p);)
    PG(10, SchedG7 S{p.ws, G, c, MULT(10)}; EpiG7 E{p.ws}; pg8::gemm_phase<EpiG7, SchedG7, false>(lds, 1024, 2048u, 2048u, S, E);)
    PH(11, phase_route(p, lds);)
    PH(12, phase_scan(p, lds);)
    PH(13, phase_scatter(p, lds);)
    PG(14, SchedG8 S{p.ws, G, c, MULT(14)}; EpiG8 E{p.ws}; pg8::gemm_phase<EpiG8, SchedG8, true>(lds, 1024, 2048u, 2048u, S, E);)
    PG(15, { SchedG9 S{p.ws, G, c, MULT(15)}; EpiG9 E{p.ws}; pg8::gemm_phase<EpiG9, SchedG9, false>(lds, 256, 512u, 512u, S, E); } { SchedG10 S{p.ws, G, c, MULT(19)}; EpiG10 E{p.ws}; pg8::gemm_phase<EpiG10, SchedG10, false>(lds, 256, 512u, 512u, S, E); })
    PH(16, phase_r3(p);)
    if (SPIN_PHASE >= 0) { const unsigned long long t0_ = __builtin_amdgcn_s_memrealtime(); while (__builtin_amdgcn_s_memrealtime() - t0_ < spin_acc * SPIN_MULT) __builtin_amdgcn_s_sleep(8); }
#undef IN
#undef SEAM
#undef PH
#undef PG
#undef MULT
}

extern "C" void kernel_launch(void* const* d_in, const int* in_sizes, int n_in, void* d_out, int out_size, void* d_ws, size_t ws_size, hipStream_t stream) {
    static int grid = 0;
    if (grid == 0) {
        if (n_in != 35 || out_size != NTOK * DM || ws_size < WS_NEED) { fprintf(stderr, "kernel_launch: unexpected shapes / workspace (%d inputs, out %d, ws %zu)\n", n_in, out_size, ws_size); grid = -1; return; }
        int dev = 0, cus = 0, per_cu = 0;
        hipGetDevice(&dev); hipDeviceGetAttribute(&cus, hipDeviceAttributeMultiprocessorCount, dev);
        hipFuncSetAttribute((const void*)fwd_kernel, hipFuncAttributeMaxDynamicSharedMemorySize, LDS_BYTES);
        hipOccupancyMaxActiveBlocksPerMultiprocessor(&per_cu, (const void*)fwd_kernel, NT, LDS_BYTES);
        if (per_cu < 1) { fprintf(stderr, "kernel_launch: occupancy query says %d blocks per CU\n", per_cu); per_cu = 1; }
        grid = cus * 1;
        (void)hipGetLastError();
    }
    if (grid < 0) return;
    Params p{};
    for (int i = 0; i < 35; ++i) p.in[i] = (const float*)d_in[i];
    p.out = (float*)d_out; p.ws = (unsigned char*)d_ws;
#if N_LAUNCH_MODE == 1
    hipMemsetAsync(d_ws, 0, 16384, stream);
    p.ph_lo = 0; p.ph_hi = N_PHASES;
    void* args[] = {&p};
    hipError_t e = hipLaunchCooperativeKernel((const void*)fwd_kernel, dim3(grid), dim3(NT), args, LDS_BYTES, stream);
    if (e != hipSuccess) fprintf(stderr, "cooperative launch failed: %s (grid %d)\n", hipGetErrorString(e), grid);
#else
    for (int k = 0; k < N_PHASES; ++k) { p.ph_lo = k; p.ph_hi = k + 1; hipLaunchKernelGGL(fwd_kernel, dim3(grid), dim3(NT), LDS_BYTES, stream, p); }
#endif
}
```
